# Optimizing an MI355X kernel written in HIP

```python
import jax
import jax.numpy as jnp
from jax import lax
import numpy as np

D_MODEL = 1024
BATCH = 32
SEQ = 2048
DEPTH = 1

MEM_LEN = 256
MIX_WIDTH = D_MODEL
MLSTM_WIDTH = MIX_WIDTH // 2
GMLP_WIDTH = MIX_WIDTH - MLSTM_WIDTH
MLSTM_HEADS = 4
MLSTM_DV = MLSTM_WIDTH // MLSTM_HEADS
MLSTM_DK = MLSTM_DV // 2
MLSTM_CHUNK = 128
GATE_SOFTCAP = 15.0
GMLP_GROUPS = 4
GMLP_DG = GMLP_WIDTH // GMLP_GROUPS
GMLP_CHUNK = 128
XATTN_HEADS = 4
XATTN_HD = D_MODEL // XATTN_HEADS
N_EXPERTS = 32
TOP_K = 4
D_FF = D_MODEL
SWIGLU_LIMIT = 7.0
SWIGLU_ALPHA = 1.702
MOE_BLOCK = 256
NORM_EPS = 1e-6
IN_SIZES = (MLSTM_HEADS * MLSTM_DK, MLSTM_HEADS * MLSTM_DK, MLSTM_WIDTH, MLSTM_WIDTH, MLSTM_HEADS, MLSTM_HEADS, GMLP_WIDTH, GMLP_WIDTH)
IN_WIDTH = sum(IN_SIZES)

kernel_name = 'hybrid_mlstm_gmlp_moe_layer'


def rmsnorm(x, g):
    xf = x.astype(jnp.float32)
    y = xf * lax.rsqrt(jnp.mean(xf * xf, axis=-1, keepdims=True) + NORM_EPS)
    return (y * g.astype(jnp.float32)).astype(x.dtype)


def softcap(a, cap):
    return cap * jnp.tanh(a / cap)


def mlstm_chunkwise(q, k, v, i_pre, f_pre):
    B, S, H, DK = q.shape
    DV = v.shape[-1]
    L = MLSTM_CHUNK
    NC = S // L

    def to_chunks(a):
        a = a.astype(jnp.float32).reshape((B, NC, L, H) + a.shape[3:])
        return jnp.moveaxis(a, (1, 3), (0, 2))

    qc = to_chunks(q) * (DK ** -0.5)
    kc = to_chunks(k)
    vc = to_chunks(v)
    log_i = to_chunks(softcap(i_pre.astype(jnp.float32), GATE_SOFTCAP))
    log_f = to_chunks(jax.nn.log_sigmoid(softcap(f_pre.astype(jnp.float32), GATE_SOFTCAP)))
    causal = jnp.tril(jnp.ones((L, L), dtype=bool))

    def chunk_step(carry, xs):
        C, n, m = carry
        qb, kb, vb, ib, fb = xs
        b = jnp.cumsum(fb, axis=-1)
        d = b[..., :, None] - b[..., None, :] + ib[..., None, :]
        d = jnp.where(causal, d, -jnp.inf)
        inter = b + m[..., None]
        m_t = jnp.maximum(inter, jnp.max(d, axis=-1))
        w_intra = jnp.exp(d - m_t[..., None])
        w_inter = jnp.exp(inter - m_t)
        s = jnp.einsum('bhtd,bhsd->bhts', qb, kb) * w_intra
        num = jnp.einsum('bhts,bhsv->bhtv', s, vb) + w_inter[..., None] * jnp.einsum('bhvd,bhtd->bhtv', C, qb)
        den = jnp.sum(s, axis=-1) + w_inter * jnp.einsum('bhd,bhtd->bht', n, qb)
        h = num / jnp.maximum(jnp.abs(den), jnp.exp(-m_t))[..., None]
        g = b[..., -1:] - b + ib
        m_new = jnp.maximum(b[..., -1] + m, jnp.max(g, axis=-1))
        wk = jnp.exp(g - m_new[..., None])
        decay = jnp.exp(b[..., -1] + m - m_new)
        C_new = decay[..., None, None] * C + jnp.einsum('bhs,bhsv,bhsd->bhvd', wk, vb, kb)
        n_new = decay[..., None] * n + jnp.einsum('bhs,bhsd->bhd', wk, kb)
        return (C_new, n_new, m_new), h

    init = (jnp.zeros((B, H, DV, DK), jnp.float32), jnp.zeros((B, H, DK), jnp.float32), jnp.zeros((B, H), jnp.float32))
    _, hc = lax.scan(chunk_step, init, (qc, kc, vc, log_i, log_f))
    return jnp.moveaxis(hc, (0, 2), (1, 3)).reshape(B, S, H, DV)


def hybrid_mixer(xn, w_in, b_gates, g_mlstm_head, w_spatial, b_spatial, g_gmlp_v, g_gmlp_out, w_out):
    B, S, _ = xn.shape
    H, G = MLSTM_HEADS, GMLP_GROUPS
    proj = xn @ w_in
    cuts = [sum(IN_SIZES[:j]) for j in range(1, len(IN_SIZES))]
    q, k, v, o, i_pre, f_pre, gu, gv = jnp.split(proj, cuts, axis=-1)
    i_pre = i_pre + b_gates[:H]
    f_pre = f_pre + b_gates[H:]
    h = mlstm_chunkwise(q.reshape(B, S, H, MLSTM_DK), k.reshape(B, S, H, MLSTM_DK), v.reshape(B, S, H, MLSTM_DV), i_pre, f_pre)
    h = rmsnorm(h, g_mlstm_head.reshape(H, MLSTM_DV)).astype(xn.dtype)
    y_mlstm = jax.nn.sigmoid(o) * h.reshape(B, S, MLSTM_WIDTH)
    L = GMLP_CHUNK
    NC = S // L
    u = jax.nn.gelu(gu).reshape(B, S, G, GMLP_DG)
    z = rmsnorm(jax.nn.gelu(gv).reshape(B, S, G, GMLP_DG), g_gmlp_v.reshape(G, GMLP_DG))
    causal = jnp.tril(jnp.ones((L, L), dtype=bool))
    w_sp = jnp.where(causal, w_spatial, jnp.zeros_like(w_spatial))
    mixed = jnp.einsum('gts,bcsgd->bctgd', w_sp, z.reshape(B, NC, L, G, GMLP_DG)) + b_spatial.T[None, None, :, :, None]
    y_gmlp = rmsnorm(u * mixed.reshape(B, S, G, GMLP_DG), g_gmlp_out.reshape(G, GMLP_DG)).reshape(B, S, GMLP_WIDTH)
    return jnp.concatenate([y_mlstm, y_gmlp], axis=-1) @ w_out


def memory_cross_attention(xn, memn, w_q, w_kv, w_xo):
    B, S, D = xn.shape
    M = memn.shape[1]
    q = (xn @ w_q).reshape(B, S, XATTN_HEADS, XATTN_HD)
    k, v = jnp.split(memn @ w_kv, 2, axis=-1)
    k = k.reshape(B, M, XATTN_HEADS, XATTN_HD)
    v = v.reshape(B, M, XATTN_HEADS, XATTN_HD)
    scores = jnp.einsum('bshd,bmhd->bhsm', q, k).astype(jnp.float32) * (XATTN_HD ** -0.5)
    p = jax.nn.softmax(scores, axis=-1).astype(v.dtype)
    o = jnp.einsum('bhsm,bmhd->bshd', p, v).reshape(B, S, D)
    return o @ w_xo


def moe_ffn(xn, w_router, b_router, w_gate, b_gate, w_up, b_up, w_down, b_down):
    B, S, D = xn.shape
    T = B * S
    A = T * TOP_K
    R = MOE_BLOCK
    n_blocks = -(-A // R) + N_EXPERTS
    n_slots = n_blocks * R
    xf = xn.reshape(T, D)
    logits = (xf @ w_router + b_router).astype(jnp.float32)
    top_logit, top_idx = lax.top_k(logits, TOP_K)
    gate = jax.nn.softmax(top_logit, axis=-1)
    flat_e = top_idx.reshape(A)
    order = jnp.argsort(flat_e)
    sorted_e = flat_e[order]
    counts = jnp.bincount(flat_e, length=N_EXPERTS)
    padded = (counts + R - 1) // R * R
    pad_end = jnp.cumsum(padded)
    pad_start = pad_end - padded
    grp_start = jnp.cumsum(counts) - counts
    dest = pad_start[sorted_e] + (jnp.arange(A) - grp_start[sorted_e])
    slot_tok = jnp.zeros((n_slots,), jnp.int32).at[dest].set((order // TOP_K).astype(jnp.int32))
    slot_w = jnp.zeros((n_slots,), jnp.float32).at[dest].set(gate.reshape(A)[order])
    block_e = jnp.minimum(jnp.searchsorted(pad_end, jnp.arange(n_blocks) * R, side='right'), N_EXPERTS - 1)

    def expert_block(args):
        tok, w, e = args
        xb = xf[tok]
        g = jnp.minimum(xb @ w_gate[e] + b_gate[e], SWIGLU_LIMIT)
        u = jnp.clip(xb @ w_up[e] + b_up[e], -SWIGLU_LIMIT, SWIGLU_LIMIT)
        hdn = (u + 1) * (g * jax.nn.sigmoid(SWIGLU_ALPHA * g))
        y = hdn @ w_down[e] + b_down[e]
        return y * w[:, None].astype(y.dtype)

    y = lax.map(expert_block, (slot_tok.reshape(n_blocks, R), slot_w.reshape(n_blocks, R), block_e))
    out = jax.ops.segment_sum(y.reshape(n_slots, D), slot_tok, num_segments=T)
    return out.reshape(B, S, D)


def setup_inputs(seed: int = 0) -> dict:
    key = jax.random.key(seed)
    ks = jax.random.split(key, 32)

    def nrm(k, shape, scale):
        return scale * jax.random.normal(k, shape, jnp.float32)

    def gain(k, shape):
        return 1.0 + nrm(k, shape, 0.02)

    Lr, H, D, E, F = DEPTH, MLSTM_HEADS, D_MODEL, N_EXPERTS, D_FF
    b_gates = jnp.concatenate([nrm(ks[4], (Lr, H), 0.1),
                               jnp.broadcast_to(jnp.linspace(3.0, 6.0, H), (Lr, H)) + nrm(ks[5], (Lr, H), 0.1)], axis=-1)
    return {
        'x': nrm(ks[0], (BATCH, SEQ, D), 1.0),
        'mem': nrm(ks[1], (BATCH, MEM_LEN, D), 1.0),
        'g_mix': gain(ks[2], (Lr, D)),
        'w_in': nrm(ks[3], (Lr, D, IN_WIDTH), D ** -0.5),
        'b_gates': b_gates,
        'g_mlstm_head': gain(ks[6], (Lr, MLSTM_WIDTH)),
        'w_spatial': nrm(ks[7], (Lr, GMLP_GROUPS, GMLP_CHUNK, GMLP_CHUNK), 0.5 * GMLP_CHUNK ** -0.5),
        'b_spatial': 1.0 + nrm(ks[8], (Lr, GMLP_GROUPS, GMLP_CHUNK), 0.1),
        'g_gmlp_v': gain(ks[9], (Lr, GMLP_WIDTH)),
        'g_gmlp_out': gain(ks[10], (Lr, GMLP_WIDTH)),
        'w_out': nrm(ks[11], (Lr, MIX_WIDTH, D), MIX_WIDTH ** -0.5),
        'g_xattn': gain(ks[12], (Lr, D)),
        'g_mem': gain(ks[13], (Lr, D)),
        'w_q': nrm(ks[14], (Lr, D, D), D ** -0.5),
        'w_kv': nrm(ks[15], (Lr, D, 2 * D), D ** -0.5),
        'w_xo': nrm(ks[16], (Lr, D, D), D ** -0.5),
        'g_moe': gain(ks[17], (Lr, D)),
        'w_router': nrm(ks[18], (Lr, D, E), D ** -0.5),
        'b_router': nrm(ks[19], (Lr, E), 0.01),
        'w_gate': nrm(ks[20], (Lr, E, D, F), D ** -0.5),
        'b_gate': nrm(ks[21], (Lr, E, F), 0.01),
        'w_up': nrm(ks[22], (Lr, E, D, F), D ** -0.5),
        'b_up': nrm(ks[23], (Lr, E, F), 0.01),
        'w_down': nrm(ks[24], (Lr, E, F, D), F ** -0.5),
        'b_down': nrm(ks[25], (Lr, E, D), 0.01),
        'g_final': gain(ks[26], (D,)),
    }


def reference(x, mem, g_mix, w_in, b_gates, g_mlstm_head, w_spatial, b_spatial, g_gmlp_v, g_gmlp_out, w_out,
              g_xattn, g_mem, w_q, w_kv, w_xo, g_moe, w_router, b_router, w_gate, b_gate, w_up, b_up,
              w_down, b_down, g_final):
    for l in range(DEPTH):
        x = x + hybrid_mixer(rmsnorm(x, g_mix[l]), w_in[l], b_gates[l], g_mlstm_head[l], w_spatial[l],
                             b_spatial[l], g_gmlp_v[l], g_gmlp_out[l], w_out[l])
        x = x + memory_cross_attention(rmsnorm(x, g_xattn[l]), rmsnorm(mem, g_mem[l]), w_q[l], w_kv[l], w_xo[l])
        x = x + moe_ffn(rmsnorm(x, g_moe[l]), w_router[l], b_router[l], w_gate[l], b_gate[l], w_up[l], b_up[l],
                        w_down[l], b_down[l])
    return rmsnorm(x, g_final)
```

```cpp
#include <hip/hip_runtime.h>
#include <cstdio>
#include <cstdint>

#ifndef MK_PER_PHASE
#define MK_PER_PHASE 1
#endif

#define GAS __attribute__((address_space(1)))
#define LAS __attribute__((address_space(3)))
typedef unsigned short bf16;
typedef short bf16x8 __attribute__((ext_vector_type(8)));
typedef float f32x4 __attribute__((ext_vector_type(4)));
typedef float f32x2 __attribute__((ext_vector_type(2)));
typedef unsigned u32x4 __attribute__((ext_vector_type(4)));
typedef unsigned u32x2 __attribute__((ext_vector_type(2)));

constexpr int BATCH = 32, SEQ = 2048, T = BATCH * SEQ, D = 1024;
constexpr int MEMLEN = 256, TM = BATCH * MEMLEN;
constexpr int NP = 2560, INW = 2568;
constexpr int NE = 32, TOPK = 4, FF = 1024, NPAIR = T * TOPK;
constexpr int MAXTILES = NPAIR / 256 + NE;
constexpr int LISTCAP = 65536;
constexpr float EPS = 1e-6f;
constexpr int NWAVES = 8, NTHREADS = 512;

constexpr size_t MiB = 1u << 20;
constexpr size_t WS_CTL = 0, CTL_ZERO_BYTES = 1 * MiB;
constexpr size_t WS_WIN = 1 * MiB;
constexpr size_t WS_WOUT = 6 * MiB;
constexpr size_t WS_WQ = 8 * MiB;
constexpr size_t WS_WKV = 10 * MiB;
constexpr size_t WS_WXO = 14 * MiB;
constexpr size_t WS_WD = 16 * MiB;
constexpr size_t WS_R2 = 80 * MiB;
constexpr size_t WS_WGU = 208 * MiB;
constexpr size_t WS_R1 = 336 * MiB;
constexpr size_t WS_R3 = 464 * MiB;
constexpr size_t WS_KM = 592 * MiB;
constexpr size_t WS_VT = 608 * MiB;
constexpr size_t WS_PROJ = 624 * MiB;
constexpr size_t WS_Y = 208 * MiB;
constexpr size_t WS_H2 = 720 * MiB;
constexpr size_t WS_MISC = 992 * MiB;
constexpr size_t WS_GATES = WS_MISC;
constexpr size_t WS_SSQ1 = WS_MISC + 2 * MiB;
constexpr size_t WS_SSQ2 = WS_MISC + 6 * MiB;
constexpr size_t WS_RR2 = WS_MISC + 10 * MiB;
constexpr size_t WS_WR = WS_MISC + 11 * MiB;
constexpr size_t WS_LPID = WS_MISC + 12 * MiB;
constexpr size_t WS_LW = WS_MISC + 20 * MiB;
constexpr size_t WS_END = 1024 * MiB;
static_assert(WS_LW + 8 * MiB <= WS_END && WS_H2 + (size_t)(MAXTILES - 512) * 256 * 1024 * 2 <= WS_MISC && WS_Y + (size_t)NPAIR * 1024 * 2 <= WS_H2, "ws map");
static_assert(WS_PROJ + (size_t)T * NP * 2 <= WS_MISC, "ws map 2");
constexpr int CW_TMO = 0, CW_CODE = 1, CW_CNT = 1024  , CW_BAR = 4096;

constexpr int RING_OFF = 0, RING_BYTES = 131072;
constexpr int LDSCTL_OFF = RING_BYTES, MISC_OFF = LDSCTL_OFF + 320;
constexpr int LDS_X_OFF = LDSCTL_OFF + 1024;
constexpr int LDS_G_OFF = LDS_X_OFF + 1024;
constexpr int LDS_BYTES = 147456;

#define LDS_WAIT() asm volatile("s_waitcnt lgkmcnt(0)" ::: "memory")
#define VM_WAIT() asm volatile("s_waitcnt vmcnt(0)" ::: "memory")
typedef GAS unsigned gu32;
#define RLX_AGENT __ATOMIC_RELAXED, __HIP_MEMORY_SCOPE_AGENT

__device__ __forceinline__ unsigned f2bf(float f) { unsigned u = __builtin_bit_cast(unsigned, f); return (u + 0x7fffu + ((u >> 16) & 1u)) >> 16; }
__device__ __forceinline__ unsigned pk2(float lo, float hi) { return f2bf(lo) | (f2bf(hi) << 16); }
__device__ __forceinline__ float bf2f(unsigned b) { return __builtin_bit_cast(float, b << 16); }
__device__ __forceinline__ float bflo(unsigned w) { return __builtin_bit_cast(float, w << 16); }
__device__ __forceinline__ float bfhi(unsigned w) { return __builtin_bit_cast(float, w & 0xffff0000u); }
__device__ __forceinline__ unsigned cvt_pk_bf16(float lo, float hi) { unsigned r; asm volatile("v_cvt_pk_bf16_f32 %0, %1, %2" : "=v"(r) : "v"(lo), "v"(hi)); return r; }
__device__ __forceinline__ float wave_sum(float v) {
#pragma unroll
    for (int o = 1; o < 64; o <<= 1) v += __shfl_xor(v, o);
    return v;
}
__device__ __forceinline__ float gelu_tanh(float x) {
    const float z = x * (1.0f + 0.044715f * x * x) * (-2.0f * 0.7978845608028654f * 1.4426950408889634f);
    return x * __builtin_amdgcn_rcpf(1.0f + __builtin_amdgcn_exp2f(z));
}
__device__ __forceinline__ float sigmoidf_fast(float x) { return __builtin_amdgcn_rcpf(1.0f + __builtin_amdgcn_exp2f(-1.4426950408889634f * x)); }

namespace pg8 {
constexpr int BM = 256, BK = 64, HALF = 128, HTB = HALF * BK * 2, STAGE_BYTES = 8 * HTB;
__host__ __device__ __forceinline__ int lds_byte(int r, int c) { const int st = (r >> 4) * 2 + (c >> 5), rr = r & 15, cc = c & 31, ob = rr * 64 + cc * 2; return st * 1024 + (ob ^ (((ob >> 9) & 1) << 5)); }
__host__ __device__ __forceinline__ void stage_rc(int b, int& R, int& C) { const int st = b / 1024, sb = b % 1024, swz = sb ^ (((sb >> 9) & 1) << 5); R = (st >> 1) * 16 + swz / 64; C = (st & 1) * 32 + (swz % 64) / 2; }
__host__ __device__ __forceinline__ int perm32(int rho) { const int n = rho >> 4, i = rho & 15; return 8 * (i >> 2) + 4 * n + (i & 3); }
struct Unit { int pm, pn, aux; };
__device__ __forceinline__ void tile_remap(int L, int nM, int nN, int& pm, int& pn) {
    const int nwg = nM * nN; int wgid = L;
    { const int q = nwg / 8, r = nwg % 8, xcd = wgid % 8, off = wgid / 8; wgid = (xcd < r ? xcd * (q + 1) : r * (q + 1) + (xcd - r) * q) + off; }
    const int nig = 8 * nN, gid = wgid / nig, fm = gid * 8, gsz = (nM - fm) < 8 ? (nM - fm) : 8;
    pm = fm + ((wgid % nig) % gsz); pn = (wgid % nig) / gsz;
}
template <class Epi, class Sched>
__device__ __forceinline__ void gemm_phase(LAS unsigned char* lds, LAS unsigned char* xlds, const int K, const Sched& S, const Epi& E) {
    int tid_ = threadIdx.x; asm volatile("" : "+v"(tid_));
    const int tid = tid_, wid = __builtin_amdgcn_readfirstlane(tid >> 6), lane = tid & 63, wr = wid >> 2, wc = wid & 3, fr = lane & 15, fq = lane >> 4;
    const int nt = K / BK;
    int Rr[2], Cc[2]; unsigned voffB[2];
#pragma unroll
    for (int i = 0; i < 2; ++i) { int R, C; stage_rc(tid * 16 + i * 8192, R, C); Rr[i] = R; Cc[i] = C; const int Rb = Epi::PERM ? ((R & ~31) + perm32(R & 31)) : R; voffB[i] = (unsigned)(Rb * K + C) * 2u; }
    const size_t kstep = (size_t)(BK * 2);
    const size_t hstep = (size_t)HALF * K * 2;
    const unsigned ldsw = (unsigned)wid * 1024u;
    const int aoff = lds_byte(wr * 64 + fr, fq * 8), boff = lds_byte(wc * 32 + fr, fq * 8);
#define PG8_SA(b, h) (((b) * 2 + (h)) * HTB)
#define PG8_SB(b, h) ((4 + (b) * 2 + (h)) * HTB)
#define PG8_STAGE(bufoff, gbase, voff) do { _Pragma("unroll") for (int _i = 0; _i < 2; ++_i) \
        __builtin_amdgcn_global_load_lds((const unsigned*)((const char*)(gbase) + (voff)[_i]), (LAS unsigned*)(lds + (bufoff) + ldsw + _i * 8192), 16, 0, 0); } while (0)
#define PG8_STAGEA(bufoff, gbase, o0, o1) do { \
        __builtin_amdgcn_global_load_lds((const unsigned*)((const char*)(gbase) + (o0)), (LAS unsigned*)(lds + (bufoff) + ldsw), 16, 0, 0); \
        __builtin_amdgcn_global_load_lds((const unsigned*)((const char*)(gbase) + (o1)), (LAS unsigned*)(lds + (bufoff) + ldsw + 8192), 16, 0, 0); } while (0)
#define PG8_LDA(dst, b, h) do { _Pragma("unroll") for (int m = 0; m < 4; ++m) _Pragma("unroll") for (int k = 0; k < 2; ++k) dst[m][k] = *(const LAS bf16x8*)(lds + PG8_SA(b, h) + aoff + m * 2048 + k * 1024); } while (0)
#define PG8_LDB(dst, b, h) do { _Pragma("unroll") for (int n = 0; n < 2; ++n) _Pragma("unroll") for (int k = 0; k < 2; ++k) dst[n][k] = *(const LAS bf16x8*)(lds + PG8_SB(b, h) + boff + n * 2048 + k * 1024); } while (0)
#define PG8_MMA(ai, bj, At, Bt) do { __builtin_amdgcn_s_setprio(1); _Pragma("unroll") for (int m = 0; m < 4; ++m) _Pragma("unroll") for (int n = 0; n < 2; ++n) _Pragma("unroll") for (int k = 0; k < 2; ++k) \
        acc[ai][bj][m][n] = __builtin_amdgcn_mfma_f32_16x16x32_bf16(Bt[n][k], At[m][k], acc[ai][bj][m][n], 0, 0, 0); __builtin_amdgcn_s_setprio(0); } while (0)
#define PG8_WAIT_V(n) asm volatile("s_waitcnt vmcnt(" #n ")" ::: "memory")
#define PG8_WAIT_L(n) asm volatile("s_waitcnt lgkmcnt(" #n ")" ::: "memory")
#define PG8_BAR __builtin_amdgcn_s_barrier()
#define PG8_SCHED __builtin_amdgcn_sched_barrier(0)
    Unit cur, nxt; int ui = 0;
    if (!S.next(0, cur)) return;
    f32x4 acc[2][2][4][2];
    bf16x8 At[4][2], B0[2][2], B1[2][2];
    unsigned vA0, vA1, vA2, vA3;
    { unsigned v[4]; S.a_offsets(cur, Rr, Cc, K, v); vA0 = v[0]; vA1 = v[1]; vA2 = v[2]; vA3 = v[3]; }
    const char* cA = S.Abase(cur); const char* cB = S.Bbase(cur);
    bool has_next = S.next(1, nxt);
    const char* nA = cA; const char* nB = cB;
    LAS u32x4* nslot = (LAS u32x4*)(xlds) + tid;
    if (has_next) { nA = S.Abase(nxt); nB = S.Bbase(nxt); }
    if (Sched::GATHER) { unsigned v[4] = {vA0, vA1, vA2, vA3}; if (has_next) S.a_offsets(nxt, Rr, Cc, K, v); *nslot = (u32x4){v[0], v[1], v[2], v[3]}; }
#pragma unroll
    for (int a = 0; a < 2; ++a)
#pragma unroll
        for (int b = 0; b < 2; ++b)
#pragma unroll
            for (int m = 0; m < 4; ++m)
#pragma unroll
                for (int n = 0; n < 2; ++n) acc[a][b][m][n] = (f32x4){0.f, 0.f, 0.f, 0.f};
    PG8_STAGE(PG8_SB(0, 0), cB, voffB); PG8_STAGE(PG8_SB(0, 1), cB + hstep, voffB); PG8_STAGEA(PG8_SA(0, 0), cA, vA0, vA1); PG8_STAGEA(PG8_SA(0, 1), cA, vA2, vA3);
    if (wr == 1) PG8_BAR;
    PG8_WAIT_V(2); PG8_BAR;
    PG8_STAGE(PG8_SB(1, 0), cB + kstep, voffB); PG8_STAGEA(PG8_SA(1, 0), cA + kstep, vA0, vA1); PG8_STAGE(PG8_SB(1, 1), cB + hstep + kstep, voffB);
    PG8_WAIT_V(6); PG8_BAR;
    for (;;) {
        for (int t = 0; t < nt; t += 2) {
            const bool last = (t == nt - 2);
            const char* a1 = cA + (size_t)(t + 1) * kstep;
            const char* a2 = last ? nA : cA + (size_t)(t + 2) * kstep; const char* b2 = last ? nB : cB + (size_t)(t + 2) * kstep;
            const char* a3 = a2 + kstep; const char* b3 = b2 + kstep;
            PG8_LDB(B0, 0, 0); PG8_LDB(B1, 0, 1); PG8_SCHED; PG8_LDA(At, 0, 0); PG8_STAGEA(PG8_SA(1, 1), a1, vA2, vA3);
            if (Sched::GATHER) { if (last) { const u32x4 nv = *nslot; vA0 = nv.x; vA1 = nv.y; vA2 = nv.z; vA3 = nv.w; } }
            PG8_WAIT_V(8); PG8_WAIT_L(0); PG8_BAR; PG8_MMA(0, 0, At, B0); PG8_MMA(0, 1, At, B1); PG8_BAR; PG8_SCHED;
            PG8_LDA(At, 0, 1); PG8_STAGE(PG8_SB(0, 0), b2, voffB); PG8_STAGE(PG8_SB(0, 1), b2 + hstep, voffB); PG8_STAGEA(PG8_SA(0, 0), a2, vA0, vA1);
            PG8_WAIT_V(8); PG8_WAIT_L(0); PG8_BAR; PG8_MMA(1, 0, At, B0); PG8_MMA(1, 1, At, B1); PG8_BAR; PG8_SCHED;
            PG8_LDB(B0, 1, 0); PG8_LDB(B1, 1, 1); PG8_SCHED; PG8_LDA(At, 1, 0); PG8_STAGEA(PG8_SA(0, 1), a2, vA2, vA3);
            PG8_WAIT_V(8); PG8_WAIT_L(0); PG8_BAR; PG8_MMA(0, 0, At, B0); PG8_MMA(0, 1, At, B1); PG8_BAR; PG8_SCHED;
            PG8_LDA(At, 1, 1); PG8_STAGE(PG8_SB(1, 0), b3, voffB); PG8_STAGE(PG8_SB(1, 1), b3 + hstep, voffB); PG8_STAGEA(PG8_SA(1, 0), a3, vA0, vA1);
            PG8_WAIT_V(8); PG8_WAIT_L(0); PG8_BAR; PG8_MMA(1, 0, At, B0); PG8_MMA(1, 1, At, B1); PG8_BAR; PG8_SCHED;
        }
        if (wr == 0) PG8_BAR;
        E(acc, cur, wr, wc, fr, fq);
        if (!has_next) break;
        cur = nxt; cA = nA; cB = nB; ++ui;
        has_next = S.next(ui + 1, nxt);
        if (has_next) { nA = S.Abase(nxt); nB = S.Bbase(nxt); }
        if (Sched::GATHER) { unsigned v[4] = {vA0, vA1, vA2, vA3}; if (has_next) S.a_offsets(nxt, Rr, Cc, K, v); *nslot = (u32x4){v[0], v[1], v[2], v[3]}; asm volatile("" ::: "memory"); }
#pragma unroll
        for (int a = 0; a < 2; ++a)
#pragma unroll
            for (int b = 0; b < 2; ++b)
#pragma unroll
                for (int m = 0; m < 4; ++m)
#pragma unroll
                    for (int n = 0; n < 2; ++n) acc[a][b][m][n] = (f32x4){0.f, 0.f, 0.f, 0.f};
        if (wr == 1) PG8_BAR;
    }
    PG8_WAIT_V(0);
    PG8_BAR;
#undef PG8_SA
#undef PG8_SB
#undef PG8_STAGE
#undef PG8_STAGEA
#undef PG8_LDA
#undef PG8_LDB
#undef PG8_MMA
#undef PG8_WAIT_V
#undef PG8_WAIT_L
#undef PG8_BAR
#undef PG8_SCHED
}
}

#define XB_TMO      128
#define XB_XCNT(j)  (256  + 64 * (j))
#define XB_XSUB(j)  (1280 + 64 * (j))
#define XB_XGEN(j)  (2304 + 64 * (j))
#define XB_TOP      3328
#define XB_TOPGEN   3392
#define XCD_BAR_WORDS 3456
#define XB_SPIN_CAP (1u << 18)
__device__ __forceinline__ unsigned xb_ld(unsigned* p)              { return __hip_atomic_load(p, __ATOMIC_RELAXED, __HIP_MEMORY_SCOPE_AGENT); }
__device__ __forceinline__ unsigned xb_add(unsigned* p, unsigned v) { return __hip_atomic_fetch_add(p, v, __ATOMIC_RELAXED, __HIP_MEMORY_SCOPE_AGENT); }
__device__ __forceinline__ unsigned xb_xcc_id() { return (unsigned)__builtin_amdgcn_s_getreg((3 << 11) | 20) & 0xFu; }
#define XB_SPIN(cond, bar) do { unsigned _sp = 0; while (cond) { __builtin_amdgcn_s_sleep(1); \
    if ((++_sp & 255u) == 0u) { if (xb_ld(&(bar)[XB_TMO])) break; if (_sp > XB_SPIN_CAP) { atomicAdd(&(bar)[XB_TMO], 1u); break; } } } } while (0)
struct XcdBarrier { unsigned* bar; unsigned x; volatile LAS unsigned* st; };
__device__ __forceinline__ XcdBarrier xcd_barrier_post(unsigned* bar, volatile LAS unsigned* st) {
    XcdBarrier b; b.bar = bar; b.x = xb_xcc_id(); b.st = st;
    if (threadIdx.x == 0) (void)xb_add(&bar[XB_XCNT(b.x)], 1u);
    return b;
}
__device__ __forceinline__ void xcd_barrier_complete(unsigned* bar, unsigned x, unsigned& nloc, unsigned& nx) {
    const unsigned G = gridDim.x * gridDim.y * gridDim.z;
    unsigned sum, cnt, mine, sp = 0u;
    for (;;) {
        sum = 0u; cnt = 0u; mine = 0u;
#pragma unroll
        for (unsigned j = 0; j < 16; ++j) { const unsigned c = xb_ld(&bar[XB_XCNT(j)]); sum += c; cnt += (c > 0u) ? 1u : 0u; mine = (j == x) ? c : mine; }
        if (sum == G) break;
        __builtin_amdgcn_s_sleep(1);
        if ((++sp & 255u) == 0u) { if (xb_ld(&bar[XB_TMO])) break; if (sp > XB_SPIN_CAP) { atomicAdd(&bar[XB_TMO], 1u); break; } }
    }
    nloc = mine > 0u ? mine : 1u; nx = cnt > 0u ? cnt : 1u;
}
__device__ __forceinline__ void xcd_barrier(const XcdBarrier& b) {
    asm volatile("s_waitcnt vmcnt(0)" ::: "memory");
    __syncthreads();
    if (threadIdx.x == 0) {
        unsigned* bar = b.bar;
        __builtin_amdgcn_s_waitcnt(0);
        unsigned nloc = b.st[0], nx = b.st[1];
        if (nloc == 0u) { xcd_barrier_complete(bar, b.x, nloc, nx); b.st[0] = nloc; b.st[1] = nx; }
        const unsigned old = xb_add(&bar[XB_XSUB(b.x)], 1u);
        const unsigned gen = old / nloc;
        if (old + 1u == (gen + 1u) * nloc) {
            __builtin_amdgcn_fence(__ATOMIC_RELEASE, "agent");
            asm volatile("s_waitcnt vmcnt(0)" ::: "memory");
            const unsigned og = xb_add(&bar[XB_TOP], 1u);
            const unsigned tg = og / nx;
            if (og + 1u == (tg + 1u) * nx) xb_add(&bar[XB_TOPGEN], 1u);
            else XB_SPIN(xb_ld(&bar[XB_TOPGEN]) == tg, bar);
            __builtin_amdgcn_fence(__ATOMIC_ACQUIRE, "agent");
            xb_add(&bar[XB_XGEN(b.x)], 1u);
            asm volatile("s_waitcnt vmcnt(0)" ::: "memory");
        } else {
            XB_SPIN(xb_ld(&bar[XB_XGEN(b.x)]) == gen, bar);
            __builtin_amdgcn_fence(__ATOMIC_ACQUIRE, "agent");
            asm volatile("s_waitcnt vmcnt(0)" ::: "memory");
        }
    }
    __syncthreads();
}

struct Frame {
    LAS unsigned char* lds;
    volatile LAS unsigned* MISC;
    gu32* ctl;
    int tid, lane, wave, G, c;
    unsigned char* ws;
};
struct Args { const float* in[26]; float* out; unsigned char* ws; int ph_lo, ph_hi; };

__device__ __forceinline__ void p0_transpose_item(const float* W, int ldw, int csrc0, int k0, const float* gain, bf16* WT, int Kd, int drow0, LAS float* scr, int lane) {
#pragma unroll 8
    for (int i = 0; i < 32; ++i) { const int kk = 2 * i + (lane >> 5); float v = W[(size_t)(k0 + kk) * ldw + csrc0 + (lane & 31)]; if (gain) v *= gain[k0 + kk]; scr[kk * 33 + (lane & 31)] = v; }
    LDS_WAIT(); asm volatile("" ::: "memory");
    const int c = lane & 7;
#pragma unroll
    for (int j = 0; j < 4; ++j) { const int n = (lane >> 3) + 8 * j; const LAS float* s = scr + (8 * c) * 33 + n;
        u32x4 o; o.x = pk2(s[0 * 33], s[1 * 33]); o.y = pk2(s[2 * 33], s[3 * 33]); o.z = pk2(s[4 * 33], s[5 * 33]); o.w = pk2(s[6 * 33], s[7 * 33]);
        *(GAS u32x4*)(WT + (size_t)(drow0 + n) * Kd + k0 + 8 * c) = o; }
    LDS_WAIT(); asm volatile("" ::: "memory");
}

__device__ __forceinline__ void p0_prologue(Frame& F, const Args& A) {
    LAS float* scr = (LAS float*)(F.lds + RING_OFF + F.wave * 16384);
    const int gw = F.c * NWAVES + F.wave, NGW = F.G * NWAVES, lane = F.lane;
    unsigned char* ws = F.ws;
    constexpr int I_IN = 16 * (NP / 32), I_SQ = 16 * 32, I_KV = 16 * 64, I_EXP = 16 * 32;
    constexpr int NITEMS = I_IN + 3 * I_SQ + I_KV + 3 * NE * I_EXP;
    for (int it = gw; it < NITEMS; it += NGW) {
        int r = it;
        if (r < I_IN) { const int kb = r / (NP / 32), nb = r % (NP / 32), n0 = nb * 32; p0_transpose_item(A.in[3], INW, n0 + (n0 >= 1536 ? 8 : 0), kb * 64, nullptr, (bf16*)(ws + WS_WIN), D, n0, scr, lane); continue; } r -= I_IN;
        if (r < I_SQ) { p0_transpose_item(A.in[10], D, (r % 32) * 32, (r / 32) * 64, nullptr, (bf16*)(ws + WS_WOUT), D, (r % 32) * 32, scr, lane); continue; } r -= I_SQ;
        if (r < I_SQ) { p0_transpose_item(A.in[13], D, (r % 32) * 32, (r / 32) * 64, A.in[11], (bf16*)(ws + WS_WQ), D, (r % 32) * 32, scr, lane); continue; } r -= I_SQ;
        if (r < I_KV) { p0_transpose_item(A.in[14], 2 * D, (r % 64) * 32, (r / 64) * 64, nullptr, (bf16*)(ws + WS_WKV), D, (r % 64) * 32, scr, lane); continue; } r -= I_KV;
        if (r < I_SQ) { p0_transpose_item(A.in[15], D, (r % 32) * 32, (r / 32) * 64, nullptr, (bf16*)(ws + WS_WXO), D, (r % 32) * 32, scr, lane); continue; } r -= I_SQ;
        const int which = r / (NE * I_EXP); r -= which * (NE * I_EXP);
        const int e = r / I_EXP, q = r % I_EXP, kb = q / 32, nb = q % 32, n0 = nb * 32;
        if (which == 2) p0_transpose_item(A.in[23] + (size_t)e * FF * D, D, n0, kb * 64, nullptr, (bf16*)(ws + WS_WD), FF, e * D + n0, scr, lane);
        else { const int p = n0 >> 7, drow = e * 2048 + p * 256 + which * 128 + (n0 & 127);
               p0_transpose_item(A.in[which == 0 ? 19 : 21] + (size_t)e * D * FF, FF, n0, kb * 64, A.in[16], (bf16*)(ws + WS_WGU), D, drow, scr, lane); }
    }
    { const float* wr = A.in[17]; const float* gm = A.in[16]; float* o = (float*)(ws + WS_WR);
      for (int i = (F.c * NTHREADS + F.tid); i < D * NE; i += F.G * NTHREADS) o[i] = wr[i] * gm[i >> 5]; }
    __syncthreads();
    LAS float* wgs = (LAS float*)(F.lds + RING_OFF);
    for (int i = F.tid; i < 8 * D; i += NTHREADS) { const int k = i >> 3, j = i & 7; wgs[j * D + k] = A.in[3][(size_t)k * INW + 1536 + j]; }
    __syncthreads();
    {
        const float* x = A.in[0]; const float* gmix = A.in[2]; const float* bg = A.in[4];
        bf16* xn = (bf16*)(ws + WS_R1); float* gates = (float*)(ws + WS_GATES);
        f32x4 g[4];
#pragma unroll
        for (int j = 0; j < 4; ++j) g[j] = *(const f32x4*)(gmix + 4 * lane + 256 * j);
        for (int m = gw; m < T; m += NGW) {
            const GAS f32x4* xr = (const GAS f32x4*)(x + (size_t)m * D) + lane;
            f32x4 v[4]; float s = 0.f;
#pragma unroll
            for (int j = 0; j < 4; ++j) { v[j] = xr[64 * j]; s += (v[j].x * v[j].x + v[j].y * v[j].y) + (v[j].z * v[j].z + v[j].w * v[j].w); }
            const float r = rsqrtf(wave_sum(s) * (1.f / D) + EPS);
#pragma unroll
            for (int j = 0; j < 4; ++j) v[j] = v[j] * r * g[j];
            GAS unsigned long long* o8 = (GAS unsigned long long*)(xn + (size_t)m * D) + lane;
#pragma unroll
            for (int j = 0; j < 4; ++j) o8[64 * j] = (unsigned long long)pk2(v[j].x, v[j].y) | ((unsigned long long)pk2(v[j].z, v[j].w) << 32);
            float gs[8];
#pragma unroll
            for (int jg = 0; jg < 8; ++jg) { float a = 0.f;
#pragma unroll
                for (int j = 0; j < 4; ++j) { const f32x4 w = *(const LAS f32x4*)(wgs + jg * D + 4 * lane + 256 * j); a += (v[j].x * w.x + v[j].y * w.y) + (v[j].z * w.z + v[j].w * w.w); }
                gs[jg] = wave_sum(a); }
            if (lane < 8) { float pre = 0.f;
#pragma unroll
                for (int jg = 0; jg < 8; ++jg) pre = (lane == jg) ? gs[jg] : pre;
                pre += bg[lane];
                const float sc = 15.0f * tanhf(pre * (1.0f / 15.0f));
                float o = sc;
                if (lane >= 4) o = -log1pf(expf(-sc));
                gates[(size_t)m * 8 + lane] = o; }
        }
    }
    {
        const float* x = A.in[1]; const float* gmem = A.in[12]; bf16* mn = (bf16*)(ws + WS_R3);
        f32x4 g[4];
#pragma unroll
        for (int j = 0; j < 4; ++j) g[j] = *(const f32x4*)(gmem + 4 * lane + 256 * j);
        for (int m = gw; m < TM; m += NGW) {
            const GAS f32x4* xr = (const GAS f32x4*)(x + (size_t)m * D) + lane;
            f32x4 v[4]; float s = 0.f;
#pragma unroll
            for (int j = 0; j < 4; ++j) { v[j] = xr[64 * j]; s += (v[j].x * v[j].x + v[j].y * v[j].y) + (v[j].z * v[j].z + v[j].w * v[j].w); }
            const float r = rsqrtf(wave_sum(s) * (1.f / D) + EPS);
#pragma unroll
            for (int j = 0; j < 4; ++j) v[j] = v[j] * r * g[j];
            GAS unsigned long long* o8 = (GAS unsigned long long*)(mn + (size_t)m * D) + lane;
#pragma unroll
            for (int j = 0; j < 4; ++j) o8[64 * j] = (unsigned long long)pk2(v[j].x, v[j].y) | ((unsigned long long)pk2(v[j].z, v[j].w) << 32);
        }
    }
}

constexpr size_t TS1K = (size_t)256 * 1024 * 2;
struct P1Order {
    static constexpr bool GATHER = false;
    int G, c; const char* ws;
    __device__ __forceinline__ bool next(int i, pg8::Unit& u) const {
        const int L = i * G + c; if (L >= 2816) return false;
        if (L < 2560) { pg8::tile_remap(L, 256, 10, u.pm, u.pn); u.aux = 0; }
        else { const int Lp = L - 2560; if (Lp < 128) { u.aux = 1; u.pm = Lp >> 2; u.pn = Lp & 3; } else { const int Lq = Lp - 128; u.aux = 2; u.pm = Lq & 3; u.pn = Lq >> 2; } }
        return true;
    }
    __device__ __forceinline__ const char* Abase(const pg8::Unit& u) const { size_t o = WS_R1; if (u.aux == 1) o = WS_R3; if (u.aux == 2) o = WS_WKV + 4 * TS1K; return ws + o + (size_t)u.pm * TS1K; }
    __device__ __forceinline__ const char* Bbase(const pg8::Unit& u) const { size_t o = WS_WIN; if (u.aux == 1) o = WS_WKV; if (u.aux == 2) o = WS_R3; return ws + o + (size_t)u.pn * TS1K; }
    __device__ __forceinline__ void a_offsets(const pg8::Unit&, const int (&R)[2], const int (&C)[2], int K, unsigned (&v)[4]) const {
#pragma unroll
        for (int h = 0; h < 2; ++h)
#pragma unroll
            for (int i = 0; i < 2; ++i) v[h * 2 + i] = (unsigned)((h * 128 + R[i]) * K + C[i]) * 2u; }
};
struct PlainOrder {
    static constexpr bool GATHER = false;
    int G, c, nM, nN; const char *A, *Bt;
    __device__ __forceinline__ bool next(int i, pg8::Unit& u) const { const int L = i * G + c; if (L >= nM * nN) return false; pg8::tile_remap(L, nM, nN, u.pm, u.pn); u.aux = 0; return true; }
    __device__ __forceinline__ const char* Abase(const pg8::Unit& u) const { return A + (size_t)u.pm * TS1K; }
    __device__ __forceinline__ const char* Bbase(const pg8::Unit& u) const { return Bt + (size_t)u.pn * TS1K; }
    __device__ __forceinline__ void a_offsets(const pg8::Unit&, const int (&R)[2], const int (&C)[2], int K, unsigned (&v)[4]) const {
#pragma unroll
        for (int h = 0; h < 2; ++h)
#pragma unroll
            for (int i = 0; i < 2; ++i) v[h * 2 + i] = (unsigned)((h * 128 + R[i]) * K + C[i]) * 2u; }
};
template <bool GATH, int NN>
struct MoeOrder {
    static constexpr bool GATHER = GATH;
    int G, c, NT; const LAS int* tpre; const LAS int* cnts; const char* A; const char* A2; const char* Bt; const int* lpid;
    __device__ __forceinline__ bool next(int i, pg8::Unit& u) const {
        const int L = i * G + c; if (L >= NT * NN) return false; pg8::tile_remap(L, NT, NN, u.pm, u.pn);
        int e = 0;
#pragma unroll 1
        for (int j = 1; j < NE; ++j) e += (tpre[j] <= u.pm) ? 1 : 0;
        u.aux = __builtin_amdgcn_readfirstlane(e); return true; }
    __device__ __forceinline__ const char* Abase(const pg8::Unit& u) const { if (GATH) return A; return u.pm < 512 ? A + (size_t)u.pm * TS1K : A2 + (size_t)(u.pm - 512) * TS1K; }
    __device__ __forceinline__ const char* Bbase(const pg8::Unit& u) const { return Bt + (size_t)(u.aux * NN + u.pn) * TS1K; }
    __device__ __forceinline__ void a_offsets(const pg8::Unit& u, const int (&R)[2], const int (&C)[2], int K, unsigned (&v)[4]) const {
        if (GATH) { const int base = (u.pm - tpre[u.aux]) * 256, cnt = cnts[u.aux];
#pragma unroll
            for (int h = 0; h < 2; ++h)
#pragma unroll
                for (int i = 0; i < 2; ++i) { const int pos = base + h * 128 + R[i]; int pid = 0; if (pos < cnt) pid = lpid[(size_t)u.aux * LISTCAP + pos]; v[h * 2 + i] = (unsigned)((pid >> 2) * K + C[i]) * 2u; }
        } else {
#pragma unroll
            for (int h = 0; h < 2; ++h)
#pragma unroll
                for (int i = 0; i < 2; ++i) v[h * 2 + i] = (unsigned)((h * 128 + R[i]) * K + C[i]) * 2u; } }
};

struct EpiP1 {
    static constexpr bool PERM = true;
    unsigned char* ws;
    __device__ __forceinline__ void operator()(const f32x4 (&acc)[2][2][4][2], const pg8::Unit& u, int wr, int wc, int fr, int fq) const {
        const int row0 = u.pm * 256 + wr * 64 + fr, col0 = u.pn * 256 + wc * 32 + 8 * fq;
        size_t bo = WS_PROJ; int ld = NP; if (u.aux == 1) { bo = WS_KM; ld = D; } if (u.aux == 2) { bo = WS_VT; ld = TM; }
        bf16* base = (bf16*)(ws + bo);
        const bool act = (u.aux == 0 && u.pn >= 6);
#pragma unroll
        for (int ai = 0; ai < 2; ++ai)
#pragma unroll
            for (int m = 0; m < 4; ++m) { bf16* rowp = base + (size_t)(row0 + ai * 128 + m * 16) * ld + col0;
#pragma unroll
                for (int bj = 0; bj < 2; ++bj) { f32x4 v0 = acc[ai][bj][m][0], v1 = acc[ai][bj][m][1];
                    if (act) {
#pragma unroll
                        for (int j = 0; j < 4; ++j) { v0[j] = gelu_tanh(v0[j]); v1[j] = gelu_tanh(v1[j]); } }
                    u32x4 w; w.x = cvt_pk_bf16(v0[0], v0[1]); w.y = cvt_pk_bf16(v0[2], v0[3]); w.z = cvt_pk_bf16(v1[0], v1[1]); w.w = cvt_pk_bf16(v1[2], v1[3]);
                    *(u32x4*)(rowp + bj * 128) = w; } }
    }
};
template <bool BASE_F32> struct EpiResid {
    static constexpr bool PERM = true;
    const void* base; bf16* out; float* ssq;
    __device__ __forceinline__ void operator()(const f32x4 (&acc)[2][2][4][2], const pg8::Unit& u, int wr, int wc, int fr, int fq) const {
        const int row0 = u.pm * 256 + wr * 64 + fr, col0 = u.pn * 256 + wc * 32 + 8 * fq;
#pragma unroll
        for (int ai = 0; ai < 2; ++ai)
#pragma unroll
            for (int m = 0; m < 4; ++m) { const int row = row0 + ai * 128 + m * 16; float ss = 0.f;
#pragma unroll
                for (int bj = 0; bj < 2; ++bj) { const size_t off = (size_t)row * D + col0 + bj * 128; f32x4 b0, b1;
                    if (BASE_F32) { b0 = *(const f32x4*)((const float*)base + off); b1 = *(const f32x4*)((const float*)base + off + 4); }
                    else { const u32x4 w = *(const u32x4*)((const bf16*)base + off); b0 = (f32x4){bflo(w.x), bfhi(w.x), bflo(w.y), bfhi(w.y)}; b1 = (f32x4){bflo(w.z), bfhi(w.z), bflo(w.w), bfhi(w.w)}; }
                    const f32x4 v0 = acc[ai][bj][m][0] + b0, v1 = acc[ai][bj][m][1] + b1;
                    ss += (v0[0] * v0[0] + v0[1] * v0[1]) + (v0[2] * v0[2] + v0[3] * v0[3]) + (v1[0] * v1[0] + v1[1] * v1[1]) + (v1[2] * v1[2] + v1[3] * v1[3]);
                    u32x4 w; w.x = cvt_pk_bf16(v0[0], v0[1]); w.y = cvt_pk_bf16(v0[2], v0[3]); w.z = cvt_pk_bf16(v1[0], v1[1]); w.w = cvt_pk_bf16(v1[2], v1[3]);
                    *(u32x4*)(out + off) = w; }
                ss += __shfl_xor(ss, 16); ss += __shfl_xor(ss, 32);
                if (fq == 0) ssq[(size_t)row * 16 + u.pn * 4 + wc] = ss; }
    }
};
__device__ __forceinline__ float row_rms_from_ssq(const float* ssq, int row) {
    const f32x4* p = (const f32x4*)(ssq + (size_t)row * 16); const f32x4 a = p[0], b = p[1], c = p[2], d = p[3];
    const float s = (((a[0] + a[1]) + (a[2] + a[3])) + ((b[0] + b[1]) + (b[2] + b[3]))) + (((c[0] + c[1]) + (c[2] + c[3])) + ((d[0] + d[1]) + (d[2] + d[3])));
    return rsqrtf(s * (1.0f / D) + EPS);
}
struct EpiQ {
    static constexpr bool PERM = true;
    bf16* out; const float* ssq;
    __device__ __forceinline__ void operator()(const f32x4 (&acc)[2][2][4][2], const pg8::Unit& u, int wr, int wc, int fr, int fq) const {
        const int row0 = u.pm * 256 + wr * 64 + fr, col0 = u.pn * 256 + wc * 32 + 8 * fq;
#pragma unroll
        for (int ai = 0; ai < 2; ++ai)
#pragma unroll
            for (int m = 0; m < 4; ++m) { const int row = row0 + ai * 128 + m * 16; const float r = row_rms_from_ssq(ssq, row) * (1.0f / 16.0f);
#pragma unroll
                for (int bj = 0; bj < 2; ++bj) { const f32x4 v0 = acc[ai][bj][m][0] * r, v1 = acc[ai][bj][m][1] * r;
                    u32x4 w; w.x = cvt_pk_bf16(v0[0], v0[1]); w.y = cvt_pk_bf16(v0[2], v0[3]); w.z = cvt_pk_bf16(v1[0], v1[1]); w.w = cvt_pk_bf16(v1[2], v1[3]);
                    *(u32x4*)(out + (size_t)row * D + col0 + bj * 128) = w; } }
    }
};
struct EpiG1 {
    static constexpr bool PERM = true;
    bf16* H1; bf16* H2; const int* lpid; const float* rr2; const float* bgate; const float* bup; const LAS int* tpre; const LAS int* cnts;
    __device__ __forceinline__ void operator()(const f32x4 (&acc)[2][2][4][2], const pg8::Unit& u, int wr, int wc, int fr, int fq) const {
        const int e = u.aux, base = (u.pm - tpre[e]) * 256, cnt = cnts[e];
        bf16* Ht = u.pm < 512 ? H1 + (size_t)u.pm * 256 * 1024 : H2 + (size_t)(u.pm - 512) * 256 * 1024;
        const int hc = u.pn * 128 + wc * 32 + 8 * fq;
        const f32x4 bg0 = *(const f32x4*)(bgate + e * FF + hc), bg1 = *(const f32x4*)(bgate + e * FF + hc + 4);
        const f32x4 bu0 = *(const f32x4*)(bup + e * FF + hc), bu1 = *(const f32x4*)(bup + e * FF + hc + 4);
#pragma unroll
        for (int ai = 0; ai < 2; ++ai)
#pragma unroll
            for (int m = 0; m < 4; ++m) { const int rl = ai * 128 + wr * 64 + m * 16 + fr; const int pos = base + rl; int pid = 0; if (pos < cnt) pid = lpid[(size_t)e * LISTCAP + pos];
                const float r = rr2[pid >> 2];
                f32x4 g0 = acc[ai][0][m][0] * r + bg0, g1 = acc[ai][0][m][1] * r + bg1, u0 = acc[ai][1][m][0] * r + bu0, u1 = acc[ai][1][m][1] * r + bu1;
                float h[8];
#pragma unroll
                for (int j = 0; j < 4; ++j) { float g = fminf(g0[j], 7.0f), uu = fminf(fmaxf(u0[j], -7.0f), 7.0f); h[j] = (uu + 1.0f) * g * sigmoidf_fast(1.702f * g);
                    g = fminf(g1[j], 7.0f); uu = fminf(fmaxf(u1[j], -7.0f), 7.0f); h[4 + j] = (uu + 1.0f) * g * sigmoidf_fast(1.702f * g); }
                u32x4 w; w.x = cvt_pk_bf16(h[0], h[1]); w.y = cvt_pk_bf16(h[2], h[3]); w.z = cvt_pk_bf16(h[4], h[5]); w.w = cvt_pk_bf16(h[6], h[7]);
                *(u32x4*)(Ht + (size_t)rl * FF + hc) = w; }
    }
};
struct EpiG2 {
    static constexpr bool PERM = true;
    bf16* Y; const int* lpid; const float* lw; const float* bdown; const LAS int* tpre; const LAS int* cnts;
    __device__ __forceinline__ void operator()(const f32x4 (&acc)[2][2][4][2], const pg8::Unit& u, int wr, int wc, int fr, int fq) const {
        const int e = u.aux, base = (u.pm - tpre[e]) * 256, cnt = cnts[e];
        const int col0 = u.pn * 256 + wc * 32 + 8 * fq;
        f32x4 bd[2][2];
#pragma unroll
        for (int bj = 0; bj < 2; ++bj) { bd[bj][0] = *(const f32x4*)(bdown + e * D + col0 + bj * 128); bd[bj][1] = *(const f32x4*)(bdown + e * D + col0 + bj * 128 + 4); }
#pragma unroll
        for (int ai = 0; ai < 2; ++ai)
#pragma unroll
            for (int m = 0; m < 4; ++m) { const int rl = ai * 128 + wr * 64 + m * 16 + fr; const int pos = base + rl;
                if (pos < cnt) { const int pid = lpid[(size_t)e * LISTCAP + pos]; const float w8 = lw[(size_t)e * LISTCAP + pos];
#pragma unroll
                    for (int bj = 0; bj < 2; ++bj) { const f32x4 v0 = (acc[ai][bj][m][0] + bd[bj][0]) * w8, v1 = (acc[ai][bj][m][1] + bd[bj][1]) * w8;
                        u32x4 w; w.x = cvt_pk_bf16(v0[0], v0[1]); w.y = cvt_pk_bf16(v0[2], v0[3]); w.z = cvt_pk_bf16(v1[0], v1[1]); w.w = cvt_pk_bf16(v1[2], v1[3]);
                        *(u32x4*)(Y + (size_t)pid * D + col0 + bj * 128) = w; } } }
    }
};


__device__ __forceinline__ void ld16_to_lds(LAS bf16* dst, const bf16* src) { *(LAS u32x4*)dst = *(const GAS u32x4*)src; }

__device__ __forceinline__ void p2_mlstm_chain_simple(Frame& F, const Args& A, int ch) {
    const int b = ch >> 2, h = ch & 3, tid = F.tid, t = tid >> 2, p = tid & 3;
    const bf16* proj = (const bf16*)(F.ws + WS_PROJ); const float* gates = (const float*)(F.ws + WS_GATES); bf16* ycat = (bf16*)(F.ws + WS_R2);
    const float* ghead = A.in[5];
    LAS bf16* qs = (LAS bf16*)(F.lds + 0); LAS bf16* ks = (LAS bf16*)(F.lds + 16384); LAS bf16* vs = (LAS bf16*)(F.lds + 32768);
    LAS float* Cs = (LAS float*)(F.lds + 65536); LAS float* ns = (LAS float*)(F.lds + 98304);
    LAS float* ibs = ns + 64; LAS float* fbs = ibs + 128; LAS float* As = fbs + 128; LAS float* Mts = As + 128; LAS float* bcs = Mts + 128; LAS float* wks = bcs + 128; LAS float* scal = wks + 128;
    for (int i = tid; i < 128 * 64; i += NTHREADS) Cs[i] = 0.f;
    if (tid < 64) ns[tid] = 0.f;
    float mstate = 0.f;
    for (int c = 0; c < 16; ++c) {
        const int tg0 = b * SEQ + c * 128;
        __syncthreads();
#pragma unroll
        for (int j = 0; j < 2; ++j) { const int i = tid + 512 * j, row = i >> 3, part = i & 7; const bf16* src = proj + (size_t)(tg0 + row) * NP + h * 64 + part * 8;
            ld16_to_lds(qs + row * 64 + part * 8, src); ld16_to_lds(ks + row * 64 + part * 8, src + 256); }
#pragma unroll
        for (int j = 0; j < 4; ++j) { const int i = tid + 512 * j, row = i >> 4, part = i & 15; ld16_to_lds(vs + row * 128 + part * 8, proj + (size_t)(tg0 + row) * NP + 512 + h * 128 + part * 8); }
        if (tid < 128) { ibs[tid] = gates[(size_t)(tg0 + tid) * 8 + h]; fbs[tid] = gates[(size_t)(tg0 + tid) * 8 + 4 + h]; }
        __syncthreads();
        if (tid == 0) { float bs = 0.f, pm = -3.0e38f;
            for (int s = 0; s < 128; ++s) { bs += fbs[s]; bcs[s] = bs; const float a = ibs[s] - bs; As[s] = a; pm = fmaxf(pm, a); Mts[s] = fmaxf(mstate, pm); }
            scal[0] = fmaxf(mstate, pm); scal[1] = bs; }
        __syncthreads();
        const float Mnew = scal[0], bL = scal[1];
        if (tid < 128) wks[tid] = expf(As[tid] - Mnew);
        {
            const float Mt = Mts[t];
            float qd[16];
#pragma unroll
            for (int j = 0; j < 16; ++j) qd[j] = bf2f(qs[t * 64 + 16 * p + j]) * 0.125f;
            float acc[32]; float den = 0.f;
#pragma unroll
            for (int j = 0; j < 32; ++j) acc[j] = 0.f;
            for (int s = 0; s <= t; ++s) {
                float dot = 0.f;
#pragma unroll
                for (int j = 0; j < 16; ++j) dot += qd[j] * bf2f(ks[s * 64 + 16 * p + j]);
                dot += __shfl_xor(dot, 1); dot += __shfl_xor(dot, 2);
                const float val = dot * expf(As[s] - Mt);
                den += val;
#pragma unroll
                for (int j = 0; j < 32; ++j) acc[j] += val * bf2f(vs[s * 128 + 32 * p + j]);
            }
            const float winter = expf(mstate - Mt);
            float acc2[32]; float nq = 0.f;
#pragma unroll
            for (int j = 0; j < 32; ++j) acc2[j] = 0.f;
            for (int d = 0; d < 64; d += 4) {
                float q4[4];
#pragma unroll
                for (int e = 0; e < 4; ++e) q4[e] = bf2f(qs[t * 64 + d + e]) * 0.125f;
#pragma unroll
                for (int j = 0; j < 32; ++j) { const f32x4 c4 = *(const LAS f32x4*)(Cs + (32 * p + j) * 64 + d); acc2[j] += (c4[0] * q4[0] + c4[1] * q4[1]) + (c4[2] * q4[2] + c4[3] * q4[3]); }
                const f32x4 n4 = *(const LAS f32x4*)(ns + d); nq += (n4[0] * q4[0] + n4[1] * q4[1]) + (n4[2] * q4[2] + n4[3] * q4[3]);
            }
            den += winter * nq;
            const float dn = fmaxf(fabsf(den), expf(-(bcs[t] + Mt)));
            const float inv = 1.0f / dn; float ss = 0.f;
#pragma unroll
            for (int j = 0; j < 32; ++j) { acc[j] = (acc[j] + winter * acc2[j]) * inv; ss += acc[j] * acc[j]; }
            ss += __shfl_xor(ss, 1); ss += __shfl_xor(ss, 2);
            const float r = rsqrtf(ss * (1.0f / 128.0f) + EPS);
            const bf16* og = proj + (size_t)(tg0 + t) * NP + 1024 + h * 128 + 32 * p; bf16* yo = ycat + (size_t)(tg0 + t) * D + h * 128 + 32 * p; const float* gh = ghead + h * 128 + 32 * p;
#pragma unroll
            for (int j8 = 0; j8 < 4; ++j8) { const u32x4 ow = *(const GAS u32x4*)(og + j8 * 8); const unsigned oww[4] = {ow.x, ow.y, ow.z, ow.w}; unsigned res[4];
#pragma unroll
                for (int e = 0; e < 4; ++e) { const int j = j8 * 8 + 2 * e; const float o0 = bflo(oww[e]), o1 = bfhi(oww[e]);
                    const float y0 = acc[j] * r * gh[j] * (1.0f / (1.0f + expf(-o0))), y1 = acc[j + 1] * r * gh[j + 1] * (1.0f / (1.0f + expf(-o1))); res[e] = pk2(y0, y1); }
                *(GAS u32x4*)(yo + j8 * 8) = (u32x4){res[0], res[1], res[2], res[3]}; }
        }
        __syncthreads();
        {
            const float decay = expf(mstate - Mnew); const int v = tid >> 2, d0 = 16 * (tid & 3);
            float cn[16];
#pragma unroll
            for (int j = 0; j < 16; ++j) cn[j] = decay * Cs[v * 64 + d0 + j];
            for (int s = 0; s < 128; ++s) { const float wv = wks[s] * bf2f(vs[s * 128 + v]);
#pragma unroll
                for (int j = 0; j < 16; ++j) cn[j] += wv * bf2f(ks[s * 64 + d0 + j]); }
#pragma unroll
            for (int j = 0; j < 16; ++j) Cs[v * 64 + d0 + j] = cn[j];
            if (tid < 64) { float a = decay * ns[tid]; for (int s = 0; s < 128; ++s) a += wks[s] * bf2f(ks[s * 64 + tid]); ns[tid] = a; }
            mstate = bL + Mnew;
        }
    }
    __syncthreads();
}

__device__ __forceinline__ void p2_gmlp_unit_simple(Frame& F, const Args& A, int u) {
    const int b = u >> 6, c = (u >> 2) & 15, g = u & 3, tid = F.tid, t = tid >> 2, p = tid & 3, tg0 = b * SEQ + c * 128;
    const bf16* proj = (const bf16*)(F.ws + WS_PROJ); bf16* ycat = (bf16*)(F.ws + WS_R2);
    const float* wsp = A.in[6] + (size_t)g * 128 * 128; const float* bsp = A.in[7] + g * 128; const float* gv = A.in[8] + g * 128; const float* go = A.in[9] + g * 128;
    LAS float* zs = (LAS float*)(F.lds + 0);
    __syncthreads();
    {
        const bf16* src = proj + (size_t)(tg0 + t) * NP + 2048 + g * 128 + 32 * p; float z[32]; float ss = 0.f;
#pragma unroll
        for (int j8 = 0; j8 < 4; ++j8) { const u32x4 w = *(const GAS u32x4*)(src + j8 * 8); const unsigned ww[4] = {w.x, w.y, w.z, w.w};
#pragma unroll
            for (int e = 0; e < 4; ++e) { z[j8 * 8 + 2 * e] = bflo(ww[e]); z[j8 * 8 + 2 * e + 1] = bfhi(ww[e]); } }
#pragma unroll
        for (int j = 0; j < 32; ++j) ss += z[j] * z[j];
        ss += __shfl_xor(ss, 1); ss += __shfl_xor(ss, 2);
        const float r = rsqrtf(ss * (1.0f / 128.0f) + EPS);
#pragma unroll
        for (int j = 0; j < 32; ++j) zs[t * 128 + 32 * p + j] = z[j] * r * gv[32 * p + j];
    }
    __syncthreads();
    {
        float acc[32];
#pragma unroll
        for (int j = 0; j < 32; ++j) acc[j] = 0.f;
        for (int s = 0; s <= t; ++s) { const float w = wsp[t * 128 + s];
#pragma unroll
            for (int j = 0; j < 32; ++j) acc[j] += w * zs[s * 128 + 32 * p + j]; }
        const float bias = bsp[t];
        const bf16* us = proj + (size_t)(tg0 + t) * NP + 1536 + g * 128 + 32 * p; float ss = 0.f;
#pragma unroll
        for (int j8 = 0; j8 < 4; ++j8) { const u32x4 w = *(const GAS u32x4*)(us + j8 * 8); const unsigned ww[4] = {w.x, w.y, w.z, w.w};
#pragma unroll
            for (int e = 0; e < 4; ++e) { const int j = j8 * 8 + 2 * e; acc[j] = bflo(ww[e]) * (acc[j] + bias); acc[j + 1] = bfhi(ww[e]) * (acc[j + 1] + bias); ss += acc[j] * acc[j] + acc[j + 1] * acc[j + 1]; } }
        ss += __shfl_xor(ss, 1); ss += __shfl_xor(ss, 2);
        const float r = rsqrtf(ss * (1.0f / 128.0f) + EPS);
        bf16* yo = ycat + (size_t)(tg0 + t) * D + 512 + g * 128 + 32 * p;
#pragma unroll
        for (int j8 = 0; j8 < 4; ++j8) { unsigned res[4];
#pragma unroll
            for (int e = 0; e < 4; ++e) { const int j = j8 * 8 + 2 * e; res[e] = pk2(acc[j] * r * go[32 * p + j], acc[j + 1] * r * go[32 * p + j + 1]); }
            *(GAS u32x4*)(yo + j8 * 8) = (u32x4){res[0], res[1], res[2], res[3]}; }
    }
}

__device__ __forceinline__ void p5_attn_unit_simple(Frame& F, int u) {
    const int b = u >> 7, h = (u >> 5) & 3, qt = u & 31, tid = F.tid, ql = tid >> 3, p = tid & 7;
    const bf16* Q = (const bf16*)(F.ws + WS_R2); const bf16* Km = (const bf16*)(F.ws + WS_KM); const bf16* Vt = (const bf16*)(F.ws + WS_VT); bf16* O = (bf16*)(F.ws + WS_R3);
    LAS bf16* Ks = (LAS bf16*)(F.lds + 0); LAS bf16* Vs = (LAS bf16*)(F.lds + 32768);
    const size_t tq = (size_t)b * SEQ + qt * 64 + ql;
    float qf[32], acc[32];
    { const bf16* src = Q + tq * D + h * 256 + 32 * p;
#pragma unroll
      for (int j8 = 0; j8 < 4; ++j8) { const u32x4 w = *(const GAS u32x4*)(src + j8 * 8); const unsigned ww[4] = {w.x, w.y, w.z, w.w};
#pragma unroll
          for (int e = 0; e < 4; ++e) { qf[j8 * 8 + 2 * e] = bflo(ww[e]); qf[j8 * 8 + 2 * e + 1] = bfhi(ww[e]); } } }
#pragma unroll
    for (int j = 0; j < 32; ++j) acc[j] = 0.f;
    float mrun = -1.0e30f, l = 0.f;
    for (int kt = 0; kt < 4; ++kt) {
        __syncthreads();
#pragma unroll
        for (int j = 0; j < 4; ++j) { const int i = tid + 512 * j, row = i >> 5, part = i & 31; ld16_to_lds(Ks + row * 256 + part * 8, Km + (size_t)(b * 256 + kt * 64 + row) * D + h * 256 + part * 8); }
#pragma unroll
        for (int j = 0; j < 4; ++j) { const int i = tid + 512 * j, d = i >> 3, part = i & 7; const u32x4 w = *(const GAS u32x4*)(Vt + (size_t)(h * 256 + d) * TM + b * 256 + kt * 64 + part * 8); const unsigned ww[4] = {w.x, w.y, w.z, w.w};
#pragma unroll
            for (int e = 0; e < 4; ++e) { Vs[(part * 8 + 2 * e) * 256 + d] = (bf16)(ww[e] & 0xffffu); Vs[(part * 8 + 2 * e + 1) * 256 + d] = (bf16)(ww[e] >> 16); } }
        __syncthreads();
        for (int mb = 0; mb < 8; ++mb) {
            float s8[8]; float mx = mrun;
#pragma unroll
            for (int e = 0; e < 8; ++e) { const int m = mb * 8 + e; float dot = 0.f;
#pragma unroll
                for (int j8 = 0; j8 < 4; ++j8) { const u32x4 w = *(const LAS u32x4*)(Ks + m * 256 + 32 * p + j8 * 8); const unsigned ww[4] = {w.x, w.y, w.z, w.w};
#pragma unroll
                    for (int q = 0; q < 4; ++q) dot += qf[j8 * 8 + 2 * q] * bflo(ww[q]) + qf[j8 * 8 + 2 * q + 1] * bfhi(ww[q]); }
                dot += __shfl_xor(dot, 1); dot += __shfl_xor(dot, 2); dot += __shfl_xor(dot, 4); s8[e] = dot; mx = fmaxf(mx, dot); }
            const float corr = expf(mrun - mx); mrun = mx; l *= corr;
#pragma unroll
            for (int j = 0; j < 32; ++j) acc[j] *= corr;
#pragma unroll
            for (int e = 0; e < 8; ++e) { const int m = mb * 8 + e; const float pe = expf(s8[e] - mx); l += pe;
#pragma unroll
                for (int j8 = 0; j8 < 4; ++j8) { const u32x4 w = *(const LAS u32x4*)(Vs + m * 256 + 32 * p + j8 * 8); const unsigned ww[4] = {w.x, w.y, w.z, w.w};
#pragma unroll
                    for (int q = 0; q < 4; ++q) { acc[j8 * 8 + 2 * q] += pe * bflo(ww[q]); acc[j8 * 8 + 2 * q + 1] += pe * bfhi(ww[q]); } } }
        }
    }
    const float inv = 1.0f / l; bf16* dst = O + tq * D + h * 256 + 32 * p;
#pragma unroll
    for (int j8 = 0; j8 < 4; ++j8) { u32x4 w; w.x = pk2(acc[j8 * 8] * inv, acc[j8 * 8 + 1] * inv); w.y = pk2(acc[j8 * 8 + 2] * inv, acc[j8 * 8 + 3] * inv); w.z = pk2(acc[j8 * 8 + 4] * inv, acc[j8 * 8 + 5] * inv); w.w = pk2(acc[j8 * 8 + 6] * inv, acc[j8 * 8 + 7] * inv);
        *(GAS u32x4*)(dst + j8 * 8) = w; }
}

__device__ __forceinline__ void p7_router(Frame& F, const Args& A) {
    const int tid = F.tid, lane = F.lane, w = F.wave, tl = lane & 31, kh = lane >> 5;
    const bf16* x2b = (const bf16*)(F.ws + WS_R2); const float* ssq2 = (const float*)(F.ws + WS_SSQ2); float* rr2 = (float*)(F.ws + WS_RR2);
    const float* brt = A.in[18]; int* lpid = (int*)(F.ws + WS_LPID); float* lw = (float*)(F.ws + WS_LW);
    LAS float* wr = (LAS float*)(F.lds + 0);
    LAS int* hist = (LAS int*)(F.lds + LDS_X_OFF); LAS int* basee = hist + 32; LAS int* pinfo = basee + 32; LAS float* pw = (LAS float*)(pinfo + 1024);
    { const float* src = (const float*)(F.ws + WS_WR); for (int i = tid; i < D * NE / 4; i += NTHREADS) ((LAS f32x4*)wr)[i] = ((const GAS f32x4*)src)[i]; }
    if (tid < 32) hist[tid] = 0;
    __syncthreads();
    for (int chunk = F.c; chunk < T / 256; chunk += F.G) {
        const int t = chunk * 256 + 32 * w + tl;
        float acc[32];
#pragma unroll
        for (int e = 0; e < 32; ++e) acc[e] = 0.f;
        const bf16* xr = x2b + (size_t)t * D + 512 * kh;
        for (int k8 = 0; k8 < 64; ++k8) {
            const u32x4 xw = *(const GAS u32x4*)(xr + k8 * 8); const unsigned xx[4] = {xw.x, xw.y, xw.z, xw.w};
#pragma unroll
            for (int q = 0; q < 8; ++q) { const float xv = (q & 1) ? bfhi(xx[q >> 1]) : bflo(xx[q >> 1]); const LAS f32x4* wp = (const LAS f32x4*)(wr + (512 * kh + k8 * 8 + q) * 32);
#pragma unroll
                for (int e4 = 0; e4 < 8; ++e4) { const f32x4 w4 = wp[e4]; acc[e4 * 4] += xv * w4[0]; acc[e4 * 4 + 1] += xv * w4[1]; acc[e4 * 4 + 2] += xv * w4[2]; acc[e4 * 4 + 3] += xv * w4[3]; } }
        }
#pragma unroll
        for (int e = 0; e < 32; ++e) acc[e] += __shfl_xor(acc[e], 32);
        const float r = row_rms_from_ssq(ssq2, t);
#pragma unroll
        for (int e = 0; e < 32; ++e) acc[e] = acc[e] * r + brt[e];
        int idx[4]; float val[4]; unsigned taken = 0u;
#pragma unroll
        for (int k = 0; k < 4; ++k) { float best = -3.0e38f; int bi = 0;
#pragma unroll
            for (int e = 0; e < 32; ++e) { const bool ok = !((taken >> e) & 1u) && (acc[e] > best); best = ok ? acc[e] : best; bi = ok ? e : bi; }
            idx[k] = bi; val[k] = best; taken |= 1u << bi; }
        float ex[4], sum = 0.f;
#pragma unroll
        for (int k = 0; k < 4; ++k) { ex[k] = expf(val[k] - val[0]); sum += ex[k]; }
        const float inv = 1.0f / sum;
        if (kh == 0) { rr2[t] = r;
#pragma unroll
            for (int k = 0; k < 4; ++k) { const int rank = __hip_atomic_fetch_add(hist + idx[k], 1, __ATOMIC_RELAXED, __HIP_MEMORY_SCOPE_WORKGROUP); pinfo[(32 * w + tl) * 4 + k] = idx[k] | (rank << 5); pw[(32 * w + tl) * 4 + k] = ex[k] * inv; } }
        __syncthreads();
        if (tid < 32) { basee[tid] = (int)__hip_atomic_fetch_add((unsigned*)(F.ctl + CW_CNT + tid), (unsigned)hist[tid], RLX_AGENT); hist[tid] = 0; }
        __syncthreads();
#pragma unroll
        for (int j = 0; j < 2; ++j) { const int i = tid + 512 * j, info = pinfo[i], e = info & 31, pos = basee[e] + (info >> 5); lpid[(size_t)e * LISTCAP + pos] = chunk * 1024 + i; lw[(size_t)e * LISTCAP + pos] = pw[i]; }
        __syncthreads();
    }
}
__device__ __forceinline__ int moe_tables(Frame& F, LAS int*& tpre, LAS int*& cnts) {
    tpre = (LAS int*)(F.lds + LDS_X_OFF); cnts = tpre + 40;
    __syncthreads();
    if (F.tid < 32) cnts[F.tid] = (int)__hip_atomic_load((unsigned*)(F.ctl + CW_CNT + F.tid), RLX_AGENT);
    __syncthreads();
    if (F.tid == 0) { int s = 0; for (int e = 0; e < 32; ++e) { tpre[e] = s; s += (cnts[e] + 255) >> 8; } tpre[32] = s; }
    __syncthreads();
    return __builtin_amdgcn_readfirstlane(tpre[32]);
}
__device__ __forceinline__ void p10_final(Frame& F, const Args& A) {
    const int gw = F.c * NWAVES + F.wave, NGW = F.G * NWAVES, lane = F.lane;
    const bf16* x2b = (const bf16*)(F.ws + WS_R2); const bf16* Y = (const bf16*)(F.ws + WS_Y); const float* gf = A.in[25]; float* out = A.out;
    f32x4 g[4];
#pragma unroll
    for (int hh = 0; hh < 2; ++hh) { g[2 * hh] = *(const f32x4*)(gf + 512 * hh + 8 * lane); g[2 * hh + 1] = *(const f32x4*)(gf + 512 * hh + 8 * lane + 4); }
    for (int t = gw; t < T; t += NGW) {
        float v[16];
#pragma unroll
        for (int hh = 0; hh < 2; ++hh) { const u32x4 w = *(const GAS u32x4*)(x2b + (size_t)t * D + 512 * hh + 8 * lane); const unsigned ww[4] = {w.x, w.y, w.z, w.w};
#pragma unroll
            for (int e = 0; e < 4; ++e) { v[8 * hh + 2 * e] = bflo(ww[e]); v[8 * hh + 2 * e + 1] = bfhi(ww[e]); } }
#pragma unroll
        for (int k = 0; k < 4; ++k)
#pragma unroll
            for (int hh = 0; hh < 2; ++hh) { const u32x4 w = *(const GAS u32x4*)(Y + ((size_t)t * 4 + k) * D + 512 * hh + 8 * lane); const unsigned ww[4] = {w.x, w.y, w.z, w.w};
#pragma unroll
                for (int e = 0; e < 4; ++e) { v[8 * hh + 2 * e] += bflo(ww[e]); v[8 * hh + 2 * e + 1] += bfhi(ww[e]); } }
        float s = 0.f;
#pragma unroll
        for (int j = 0; j < 16; ++j) s += v[j] * v[j];
        const float r = rsqrtf(wave_sum(s) * (1.0f / D) + EPS);
#pragma unroll
        for (int hh = 0; hh < 2; ++hh) { float* o = out + (size_t)t * D + 512 * hh + 8 * lane;
            *(GAS f32x4*)o = (f32x4){v[8 * hh] * r * g[2 * hh][0], v[8 * hh + 1] * r * g[2 * hh][1], v[8 * hh + 2] * r * g[2 * hh][2], v[8 * hh + 3] * r * g[2 * hh][3]};
            *(GAS f32x4*)(o + 4) = (f32x4){v[8 * hh + 4] * r * g[2 * hh + 1][0], v[8 * hh + 5] * r * g[2 * hh + 1][1], v[8 * hh + 6] * r * g[2 * hh + 1][2], v[8 * hh + 7] * r * g[2 * hh + 1][3]}; }
    }
}

constexpr int NPHASES = 11;
__global__ void __launch_bounds__(NTHREADS, 2) fwd_kernel(Args args) {
    extern __shared__ __attribute__((aligned(16))) unsigned char lds_raw[];
    Frame F;
    F.lds = (LAS unsigned char*)lds_raw;
    F.MISC = (volatile LAS unsigned*)(F.lds + MISC_OFF);
    F.tid = threadIdx.x; F.lane = F.tid & 63; F.wave = __builtin_amdgcn_readfirstlane(F.tid >> 6);
    F.G = gridDim.x; F.c = blockIdx.x; F.ws = args.ws; F.ctl = (gu32*)(args.ws + WS_CTL);
    for (int u = F.tid; u < 1024 / 4; u += NTHREADS) ((LAS unsigned*)(F.lds + LDSCTL_OFF))[u] = 0u;
    __syncthreads();
    const int lo = args.ph_lo, hi = args.ph_hi;
    XcdBarrier bar; bar.bar = (unsigned*)(F.ctl + CW_BAR); bar.x = 0; bar.st = nullptr;
    if (hi - lo > 1) bar = xcd_barrier_post((unsigned*)(F.ctl + CW_BAR), F.MISC + 8);
#ifndef PH_MASK
#define PH_MASK 0x7ff
#endif
#define IN(k) (((PH_MASK >> (k)) & 1) && lo <= (k) && (k) < hi)
#define SEAM(k) do { if (IN(k) && IN((k) + 1)) xcd_barrier(bar); } while (0)
    unsigned char* ws = args.ws;
    if (IN(0)) { p0_prologue(F, args); SEAM(0); }
    if (IN(1)) {
        P1Order S{F.G, F.c, (const char*)ws};
        EpiP1 E{ws};
        pg8::gemm_phase<EpiP1, P1Order>(F.lds + RING_OFF, F.lds + LDS_G_OFF, D, S, E);
        SEAM(1);
    }
    if (IN(2)) {
        for (int ch = F.c; ch < BATCH * 4; ch += F.G) p2_mlstm_chain_simple(F, args, ch);
        for (int u = (F.c + F.G - (128 % F.G)) % F.G; u < BATCH * 16 * 4; u += F.G) p2_gmlp_unit_simple(F, args, u);
        SEAM(2);
    }
    if (IN(3)) {
        PlainOrder S{F.G, F.c, T / 256, 4, (const char*)(ws + WS_R2), (const char*)(ws + WS_WOUT)};
        EpiResid<true> E{(const void*)args.in[0], (bf16*)(ws + WS_R1), (float*)(ws + WS_SSQ1)};
        pg8::gemm_phase<EpiResid<true>, PlainOrder>(F.lds + RING_OFF, F.lds + LDS_G_OFF, D, S, E);
        SEAM(3);
    }
    if (IN(4)) {
        PlainOrder S{F.G, F.c, T / 256, 4, (const char*)(ws + WS_R1), (const char*)(ws + WS_WQ)};
        EpiQ E{(bf16*)(ws + WS_R2), (const float*)(ws + WS_SSQ1)};
        pg8::gemm_phase<EpiQ, PlainOrder>(F.lds + RING_OFF, F.lds + LDS_G_OFF, D, S, E);
        SEAM(4);
    }
    if (IN(5)) {
        for (int u = F.c; u < BATCH * 4 * 32; u += F.G) p5_attn_unit_simple(F, u);
        SEAM(5);
    }
    if (IN(6)) {
        PlainOrder S{F.G, F.c, T / 256, 4, (const char*)(ws + WS_R3), (const char*)(ws + WS_WXO)};
        EpiResid<false> E{(const void*)(ws + WS_R1), (bf16*)(ws + WS_R2), (float*)(ws + WS_SSQ2)};
        pg8::gemm_phase<EpiResid<false>, PlainOrder>(F.lds + RING_OFF, F.lds + LDS_G_OFF, D, S, E);
        SEAM(6);
    }
    if (IN(7)) { p7_router(F, args); SEAM(7); }
    if (IN(8)) {
        LAS int *tpre, *cnts; const int NT = moe_tables(F, tpre, cnts);
        MoeOrder<true, 8> S{F.G, F.c, NT, tpre, cnts, (const char*)(ws + WS_R2), nullptr, (const char*)(ws + WS_WGU), (const int*)(ws + WS_LPID)};
        EpiG1 E{(bf16*)args.out, (bf16*)(ws + WS_H2), (const int*)(ws + WS_LPID), (const float*)(ws + WS_RR2), args.in[20], args.in[22], tpre, cnts};
        pg8::gemm_phase<EpiG1, MoeOrder<true, 8>>(F.lds + RING_OFF, F.lds + LDS_G_OFF, D, S, E);
        SEAM(8);
    }
    if (IN(9)) {
        LAS int *tpre, *cnts; const int NT = moe_tables(F, tpre, cnts);
        MoeOrder<false, 4> S{F.G, F.c, NT, tpre, cnts, (const char*)args.out, (const char*)(ws + WS_H2), (const char*)(ws + WS_WD), nullptr};
        EpiG2 E{(bf16*)(ws + WS_Y), (const int*)(ws + WS_LPID), (const float*)(ws + WS_LW), args.in[24], tpre, cnts};
        pg8::gemm_phase<EpiG2, MoeOrder<false, 4>>(F.lds + RING_OFF, F.lds + LDS_G_OFF, FF, S, E);
        SEAM(9);
    }
    if (IN(10)) p10_final(F, args);
#undef IN
#undef SEAM
}

extern "C" void kernel_launch(void* const* d_in, const int* in_sizes, int n_in, void* d_out, int out_size, void* d_ws, size_t ws_size, hipStream_t stream) {
    static int grid = 0;
    if (grid == 0) {
        if (n_in != 26 || in_sizes[0] != T * D || out_size != T * D || ws_size < WS_END) { fprintf(stderr, "kernel_launch: unexpected shapes (n_in %d, in0 %d, out %d, ws %zu)\n", n_in, n_in > 0 ? in_sizes[0] : -1, out_size, ws_size); grid = -1; return; }
        int dev = 0, cus = 0, per_cu = 0;
        if (hipGetDevice(&dev) != hipSuccess || hipDeviceGetAttribute(&cus, hipDeviceAttributeMultiprocessorCount, dev) != hipSuccess) { grid = -1; return; }
        if (hipFuncSetAttribute((const void*)fwd_kernel, hipFuncAttributeMaxDynamicSharedMemorySize, LDS_BYTES) != hipSuccess) { fprintf(stderr, "kernel_launch: hipFuncSetAttribute failed\n"); grid = -1; return; }
        if (hipOccupancyMaxActiveBlocksPerMultiprocessor(&per_cu, (const void*)fwd_kernel, NTHREADS, LDS_BYTES) != hipSuccess || per_cu < 1) { fprintf(stderr, "kernel_launch: occupancy query says %d\n", per_cu); }
        (void)hipGetLastError();
        grid = cus;
    }
    if (grid < 0) return;
    (void)hipMemsetAsync((char*)d_ws + WS_CTL, 0, CTL_ZERO_BYTES, stream);
    Args a{};
    for (int i = 0; i < 26; ++i) a.in[i] = (const float*)d_in[i];
    a.out = (float*)d_out; a.ws = (unsigned char*)d_ws;
#if MK_PER_PHASE
    for (int ph = 0; ph < NPHASES; ++ph) { a.ph_lo = ph; a.ph_hi = ph + 1; hipLaunchKernelGGL(fwd_kernel, dim3(grid), dim3(NTHREADS), LDS_BYTES, stream, a); }
#else
    a.ph_lo = 0; a.ph_hi = NPHASES; hipLaunchKernelGGL(fwd_kernel, dim3(grid), dim3(NTHREADS), LDS_BYTES, stream, a);
#endif
}
```

```cpp
#include <hip/hip_runtime.h>
#include <cstdio>
#include <cstdint>

#ifndef MK_PER_PHASE
#define MK_PER_PHASE 0
#endif

#define GAS __attribute__((address_space(1)))
#define LAS __attribute__((address_space(3)))
typedef unsigned short bf16;
typedef short bf16x8 __attribute__((ext_vector_type(8)));
typedef float f32x4 __attribute__((ext_vector_type(4)));
typedef float f32x2 __attribute__((ext_vector_type(2)));
typedef unsigned u32x4 __attribute__((ext_vector_type(4)));
typedef unsigned u32x2 __attribute__((ext_vector_type(2)));

constexpr int BATCH = 32, SEQ = 2048, T = BATCH * SEQ, D = 1024;
constexpr int MEMLEN = 256, TM = BATCH * MEMLEN;
constexpr int NP = 2560, INW = 2568;
constexpr int NE = 32, TOPK = 4, FF = 1024, NPAIR = T * TOPK;
constexpr int MAXTILES = NPAIR / 256 + NE;
constexpr int LISTCAP = 65536;
constexpr float EPS = 1e-6f;
constexpr int NWAVES = 8, NTHREADS = 512;

constexpr size_t MiB = 1u << 20;
constexpr size_t WS_CTL = 0, CTL_ZERO_BYTES = 1 * MiB;
constexpr size_t WS_WIN = 1 * MiB;
constexpr size_t WS_WOUT = 6 * MiB;
constexpr size_t WS_WQ = 8 * MiB;
constexpr size_t WS_WKV = 10 * MiB;
constexpr size_t WS_WXO = 14 * MiB;
constexpr size_t WS_WD = 16 * MiB;
constexpr size_t WS_R2 = 80 * MiB;
constexpr size_t WS_WGU = 208 * MiB;
constexpr size_t WS_R1 = 336 * MiB;
constexpr size_t WS_R3 = 464 * MiB;
constexpr size_t WS_KM = 592 * MiB;
constexpr size_t WS_VT = 608 * MiB;
constexpr size_t WS_PROJ = 624 * MiB;
constexpr size_t WS_Y = 208 * MiB;
constexpr size_t WS_H2 = 720 * MiB;
constexpr size_t WS_MISC = 992 * MiB;
constexpr size_t WS_GATES = WS_MISC;
constexpr size_t WS_SSQ1 = WS_MISC + 2 * MiB;
constexpr size_t WS_SSQ2 = WS_MISC + 6 * MiB;
constexpr size_t WS_RR2 = WS_MISC + 10 * MiB;
constexpr size_t WS_WR = WS_MISC + 11 * MiB;
constexpr size_t WS_LPID = WS_MISC + 12 * MiB;
constexpr size_t WS_LW = WS_MISC + 20 * MiB;
constexpr size_t WS_END = 1024 * MiB;
static_assert(WS_LW + 8 * MiB <= WS_END && WS_H2 + (size_t)(MAXTILES - 512) * 256 * 1024 * 2 <= WS_MISC && WS_Y + (size_t)NPAIR * 1024 * 2 <= WS_H2, "ws map");
static_assert(WS_PROJ + (size_t)T * NP * 2 <= WS_MISC, "ws map 2");
constexpr int CW_TMO = 0, CW_CODE = 1, CW_CNT = 1024  , CW_BAR = 4096;

constexpr int RING_OFF = 0, RING_BYTES = 131072;
constexpr int LDSCTL_OFF = RING_BYTES, MISC_OFF = LDSCTL_OFF + 320;
constexpr int LDS_X_OFF = LDSCTL_OFF + 1024;
constexpr int LDS_G_OFF = LDS_X_OFF + 1024;
constexpr int LDS_BYTES = 147456;

#define LDS_WAIT() asm volatile("s_waitcnt lgkmcnt(0)" ::: "memory")
#define VM_WAIT() asm volatile("s_waitcnt vmcnt(0)" ::: "memory")
typedef GAS unsigned gu32;
#define RLX_AGENT __ATOMIC_RELAXED, __HIP_MEMORY_SCOPE_AGENT

__device__ __forceinline__ unsigned f2bf(float f) { unsigned u = __builtin_bit_cast(unsigned, f); return (u + 0x7fffu + ((u >> 16) & 1u)) >> 16; }
__device__ __forceinline__ unsigned pk2(float lo, float hi) { return f2bf(lo) | (f2bf(hi) << 16); }
__device__ __forceinline__ float bf2f(unsigned b) { return __builtin_bit_cast(float, b << 16); }
__device__ __forceinline__ float bflo(unsigned w) { return __builtin_bit_cast(float, w << 16); }
__device__ __forceinline__ float bfhi(unsigned w) { return __builtin_bit_cast(float, w & 0xffff0000u); }
__device__ __forceinline__ unsigned cvt_pk_bf16(float lo, float hi) { unsigned r; asm volatile("v_cvt_pk_bf16_f32 %0, %1, %2" : "=v"(r) : "v"(lo), "v"(hi)); return r; }
__device__ __forceinline__ float wave_sum(float v) {
#pragma unroll
    for (int o = 1; o < 64; o <<= 1) v += __shfl_xor(v, o);
    return v;
}
__device__ __forceinline__ float gelu_tanh(float x) {
    const float z = x * (1.0f + 0.044715f * x * x) * (-2.0f * 0.7978845608028654f * 1.4426950408889634f);
    return x * __builtin_amdgcn_rcpf(1.0f + __builtin_amdgcn_exp2f(z));
}
__device__ __forceinline__ float sigmoidf_fast(float x) { return __builtin_amdgcn_rcpf(1.0f + __builtin_amdgcn_exp2f(-1.4426950408889634f * x)); }

namespace pg8 {
constexpr int BM = 256, BK = 64, HALF = 128, HTB = HALF * BK * 2, STAGE_BYTES = 8 * HTB;
__host__ __device__ __forceinline__ int lds_byte(int r, int c) { const int st = (r >> 4) * 2 + (c >> 5), rr = r & 15, cc = c & 31, ob = rr * 64 + cc * 2; return st * 1024 + (ob ^ (((ob >> 9) & 1) << 5)); }
__host__ __device__ __forceinline__ void stage_rc(int b, int& R, int& C) { const int st = b / 1024, sb = b % 1024, swz = sb ^ (((sb >> 9) & 1) << 5); R = (st >> 1) * 16 + swz / 64; C = (st & 1) * 32 + (swz % 64) / 2; }
__host__ __device__ __forceinline__ int perm32(int rho) { const int n = rho >> 4, i = rho & 15; return 8 * (i >> 2) + 4 * n + (i & 3); }
struct Unit { int pm, pn, aux; };
__device__ __forceinline__ void tile_remap(int L, int nM, int nN, int& pm, int& pn) {
    const int nwg = nM * nN; int wgid = L;
    { const int q = nwg / 8, r = nwg % 8, xcd = wgid % 8, off = wgid / 8; wgid = (xcd < r ? xcd * (q + 1) : r * (q + 1) + (xcd - r) * q) + off; }
    const int nig = 8 * nN, gid = wgid / nig, fm = gid * 8, gsz = (nM - fm) < 8 ? (nM - fm) : 8;
    pm = fm + ((wgid % nig) % gsz); pn = (wgid % nig) / gsz;
}
template <class Epi, class Sched>
__device__ __forceinline__ void gemm_phase(LAS unsigned char* lds, LAS unsigned char* xlds, const int K, const Sched& S, const Epi& E) {
    int tid_ = threadIdx.x; asm volatile("" : "+v"(tid_));
    const int tid = tid_, wid = __builtin_amdgcn_readfirstlane(tid >> 6), lane = tid & 63, wr = wid >> 2, wc = wid & 3, fr = lane & 15, fq = lane >> 4;
    const int nt = K / BK;
    int Rr[2], Cc[2]; unsigned voffB[2];
#pragma unroll
    for (int i = 0; i < 2; ++i) { int R, C; stage_rc(tid * 16 + i * 8192, R, C); Rr[i] = R; Cc[i] = C; const int Rb = Epi::PERM ? ((R & ~31) + perm32(R & 31)) : R; voffB[i] = (unsigned)(Rb * K + C) * 2u; }
    const size_t kstep = (size_t)(BK * 2);
    const size_t hstep = (size_t)HALF * K * 2;
    const unsigned ldsw = (unsigned)wid * 1024u;
    const int aoff = lds_byte(wr * 64 + fr, fq * 8), boff = lds_byte(wc * 32 + fr, fq * 8);
#define PG8_SA(b, h) (((b) * 2 + (h)) * HTB)
#define PG8_SB(b, h) ((4 + (b) * 2 + (h)) * HTB)
#define PG8_STAGE(bufoff, gbase, voff) do { _Pragma("unroll") for (int _i = 0; _i < 2; ++_i) \
        __builtin_amdgcn_global_load_lds((const unsigned*)((const char*)(gbase) + (voff)[_i]), (LAS unsigned*)(lds + (bufoff) + ldsw + _i * 8192), 16, 0, 0); } while (0)
#define PG8_STAGEA(bufoff, gbase, o0, o1) do { \
        __builtin_amdgcn_global_load_lds((const unsigned*)((const char*)(gbase) + (o0)), (LAS unsigned*)(lds + (bufoff) + ldsw), 16, 0, 0); \
        __builtin_amdgcn_global_load_lds((const unsigned*)((const char*)(gbase) + (o1)), (LAS unsigned*)(lds + (bufoff) + ldsw + 8192), 16, 0, 0); } while (0)
#define PG8_LDA(dst, b, h) do { _Pragma("unroll") for (int m = 0; m < 4; ++m) _Pragma("unroll") for (int k = 0; k < 2; ++k) dst[m][k] = *(const LAS bf16x8*)(lds + PG8_SA(b, h) + aoff + m * 2048 + k * 1024); } while (0)
#define PG8_LDB(dst, b, h) do { _Pragma("unroll") for (int n = 0; n < 2; ++n) _Pragma("unroll") for (int k = 0; k < 2; ++k) dst[n][k] = *(const LAS bf16x8*)(lds + PG8_SB(b, h) + boff + n * 2048 + k * 1024); } while (0)
#define PG8_MMA(ai, bj, At, Bt) do { __builtin_amdgcn_s_setprio(1); _Pragma("unroll") for (int m = 0; m < 4; ++m) _Pragma("unroll") for (int n = 0; n < 2; ++n) _Pragma("unroll") for (int k = 0; k < 2; ++k) \
        acc[ai][bj][m][n] = __builtin_amdgcn_mfma_f32_16x16x32_bf16(Bt[n][k], At[m][k], acc[ai][bj][m][n], 0, 0, 0); __builtin_amdgcn_s_setprio(0); } while (0)
#define PG8_WAIT_V(n) asm volatile("s_waitcnt vmcnt(" #n ")" ::: "memory")
#define PG8_WAIT_L(n) asm volatile("s_waitcnt lgkmcnt(" #n ")" ::: "memory")
#define PG8_BAR __builtin_amdgcn_s_barrier()
#define PG8_SCHED __builtin_amdgcn_sched_barrier(0)
    Unit cur, nxt; int ui = 0;
    if (!S.next(0, cur)) return;
    f32x4 acc[2][2][4][2];
    bf16x8 At[4][2], B0[2][2], B1[2][2];
    unsigned vA0, vA1, vA2, vA3;
    { unsigned v[4]; S.a_offsets(cur, Rr, Cc, K, v); vA0 = v[0]; vA1 = v[1]; vA2 = v[2]; vA3 = v[3]; }
    const char* cA = S.Abase(cur); const char* cB = S.Bbase(cur);
    bool has_next = S.next(1, nxt);
    const char* nA = cA; const char* nB = cB;
    LAS u32x4* nslot = (LAS u32x4*)(xlds) + tid;
    if (has_next) { nA = S.Abase(nxt); nB = S.Bbase(nxt); }
    if (Sched::GATHER) { unsigned v[4] = {vA0, vA1, vA2, vA3}; if (has_next) S.a_offsets(nxt, Rr, Cc, K, v); *nslot = (u32x4){v[0], v[1], v[2], v[3]}; }
#pragma unroll
    for (int a = 0; a < 2; ++a)
#pragma unroll
        for (int b = 0; b < 2; ++b)
#pragma unroll
            for (int m = 0; m < 4; ++m)
#pragma unroll
                for (int n = 0; n < 2; ++n) acc[a][b][m][n] = (f32x4){0.f, 0.f, 0.f, 0.f};
    PG8_STAGE(PG8_SB(0, 0), cB, voffB); PG8_STAGE(PG8_SB(0, 1), cB + hstep, voffB); PG8_STAGEA(PG8_SA(0, 0), cA, vA0, vA1); PG8_STAGEA(PG8_SA(0, 1), cA, vA2, vA3);
    if (wr == 1) PG8_BAR;
    PG8_WAIT_V(2); PG8_BAR;
    PG8_STAGE(PG8_SB(1, 0), cB + kstep, voffB); PG8_STAGEA(PG8_SA(1, 0), cA + kstep, vA0, vA1); PG8_STAGE(PG8_SB(1, 1), cB + hstep + kstep, voffB);
    PG8_WAIT_V(6); PG8_BAR;
    for (;;) {
        for (int t = 0; t < nt; t += 2) {
            const bool last = (t == nt - 2);
            const char* a1 = cA + (size_t)(t + 1) * kstep;
            const char* a2 = last ? nA : cA + (size_t)(t + 2) * kstep; const char* b2 = last ? nB : cB + (size_t)(t + 2) * kstep;
            const char* a3 = a2 + kstep; const char* b3 = b2 + kstep;
            PG8_LDB(B0, 0, 0); PG8_LDB(B1, 0, 1); PG8_SCHED; PG8_LDA(At, 0, 0); PG8_STAGEA(PG8_SA(1, 1), a1, vA2, vA3);
            if (Sched::GATHER) { if (last) { const u32x4 nv = *nslot; vA0 = nv.x; vA1 = nv.y; vA2 = nv.z; vA3 = nv.w; } }
            PG8_WAIT_V(8); PG8_WAIT_L(0); PG8_BAR; PG8_MMA(0, 0, At, B0); PG8_MMA(0, 1, At, B1); PG8_BAR; PG8_SCHED;
            PG8_LDA(At, 0, 1); PG8_STAGE(PG8_SB(0, 0), b2, voffB); PG8_STAGE(PG8_SB(0, 1), b2 + hstep, voffB); PG8_STAGEA(PG8_SA(0, 0), a2, vA0, vA1);
            PG8_WAIT_V(8); PG8_WAIT_L(0); PG8_BAR; PG8_MMA(1, 0, At, B0); PG8_MMA(1, 1, At, B1); PG8_BAR; PG8_SCHED;
            PG8_LDB(B0, 1, 0); PG8_LDB(B1, 1, 1); PG8_SCHED; PG8_LDA(At, 1, 0); PG8_STAGEA(PG8_SA(0, 1), a2, vA2, vA3);
            PG8_WAIT_V(8); PG8_WAIT_L(0); PG8_BAR; PG8_MMA(0, 0, At, B0); PG8_MMA(0, 1, At, B1); PG8_BAR; PG8_SCHED;
            PG8_LDA(At, 1, 1); PG8_STAGE(PG8_SB(1, 0), b3, voffB); PG8_STAGE(PG8_SB(1, 1), b3 + hstep, voffB); PG8_STAGEA(PG8_SA(1, 0), a3, vA0, vA1);
            PG8_WAIT_V(8); PG8_WAIT_L(0); PG8_BAR; PG8_MMA(1, 0, At, B0); PG8_MMA(1, 1, At, B1); PG8_BAR; PG8_SCHED;
        }
        if (wr == 0) PG8_BAR;
        E(acc, cur, wr, wc, fr, fq);
        if (!has_next) break;
        cur = nxt; cA = nA; cB = nB; ++ui;
        has_next = S.next(ui + 1, nxt);
        if (has_next) { nA = S.Abase(nxt); nB = S.Bbase(nxt); }
        if (Sched::GATHER) { unsigned v[4] = {vA0, vA1, vA2, vA3}; if (has_next) S.a_offsets(nxt, Rr, Cc, K, v); *nslot = (u32x4){v[0], v[1], v[2], v[3]}; asm volatile("" ::: "memory"); }
#pragma unroll
        for (int a = 0; a < 2; ++a)
#pragma unroll
            for (int b = 0; b < 2; ++b)
#pragma unroll
                for (int m = 0; m < 4; ++m)
#pragma unroll
                    for (int n = 0; n < 2; ++n) acc[a][b][m][n] = (f32x4){0.f, 0.f, 0.f, 0.f};
        if (wr == 1) PG8_BAR;
    }
    PG8_WAIT_V(0);
    PG8_BAR;
#undef PG8_SA
#undef PG8_SB
#undef PG8_STAGE
#undef PG8_STAGEA
#undef PG8_LDA
#undef PG8_LDB
#undef PG8_MMA
#undef PG8_WAIT_V
#undef PG8_WAIT_L
#undef PG8_BAR
#undef PG8_SCHED
}
}

#define XB_TMO      128
#define XB_XCNT(j)  (256  + 64 * (j))
#define XB_XSUB(j)  (1280 + 64 * (j))
#define XB_XGEN(j)  (2304 + 64 * (j))
#define XB_TOP      3328
#define XB_TOPGEN   3392
#define XCD_BAR_WORDS 3456
#define XB_SPIN_CAP (1u << 18)
__device__ __forceinline__ unsigned xb_ld(unsigned* p)              { return __hip_atomic_load(p, __ATOMIC_RELAXED, __HIP_MEMORY_SCOPE_AGENT); }
__device__ __forceinline__ unsigned xb_add(unsigned* p, unsigned v) { return __hip_atomic_fetch_add(p, v, __ATOMIC_RELAXED, __HIP_MEMORY_SCOPE_AGENT); }
__device__ __forceinline__ unsigned xb_xcc_id() { return (unsigned)__builtin_amdgcn_s_getreg((3 << 11) | 20) & 0xFu; }
#define XB_SPIN(cond, bar) do { unsigned _sp = 0; while (cond) { __builtin_amdgcn_s_sleep(1); \
    if ((++_sp & 255u) == 0u) { if (xb_ld(&(bar)[XB_TMO])) break; if (_sp > XB_SPIN_CAP) { atomicAdd(&(bar)[XB_TMO], 1u); break; } } } } while (0)
struct XcdBarrier { unsigned* bar; unsigned x; volatile LAS unsigned* st; };
__device__ __forceinline__ XcdBarrier xcd_barrier_post(unsigned* bar, volatile LAS unsigned* st) {
    XcdBarrier b; b.bar = bar; b.x = xb_xcc_id(); b.st = st;
    if (threadIdx.x == 0) (void)xb_add(&bar[XB_XCNT(b.x)], 1u);
    return b;
}
__device__ __forceinline__ void xcd_barrier_complete(unsigned* bar, unsigned x, unsigned& nloc, unsigned& nx) {
    const unsigned G = gridDim.x * gridDim.y * gridDim.z;
    unsigned sum, cnt, mine, sp = 0u;
    for (;;) {
        sum = 0u; cnt = 0u; mine = 0u;
#pragma unroll
        for (unsigned j = 0; j < 16; ++j) { const unsigned c = xb_ld(&bar[XB_XCNT(j)]); sum += c; cnt += (c > 0u) ? 1u : 0u; mine = (j == x) ? c : mine; }
        if (sum == G) break;
        __builtin_amdgcn_s_sleep(1);
        if ((++sp & 255u) == 0u) { if (xb_ld(&bar[XB_TMO])) break; if (sp > XB_SPIN_CAP) { atomicAdd(&bar[XB_TMO], 1u); break; } }
    }
    nloc = mine > 0u ? mine : 1u; nx = cnt > 0u ? cnt : 1u;
}
__device__ __forceinline__ void xcd_barrier(const XcdBarrier& b) {
    asm volatile("s_waitcnt vmcnt(0)" ::: "memory");
    __syncthreads();
    if (threadIdx.x == 0) {
        unsigned* bar = b.bar;
        __builtin_amdgcn_s_waitcnt(0);
        unsigned nloc = b.st[0], nx = b.st[1];
        if (nloc == 0u) { xcd_barrier_complete(bar, b.x, nloc, nx); b.st[0] = nloc; b.st[1] = nx; }
        const unsigned old = xb_add(&bar[XB_XSUB(b.x)], 1u);
        const unsigned gen = old / nloc;
        if (old + 1u == (gen + 1u) * nloc) {
            __builtin_amdgcn_fence(__ATOMIC_RELEASE, "agent");
            asm volatile("s_waitcnt vmcnt(0)" ::: "memory");
            const unsigned og = xb_add(&bar[XB_TOP], 1u);
            const unsigned tg = og / nx;
            if (og + 1u == (tg + 1u) * nx) xb_add(&bar[XB_TOPGEN], 1u);
            else XB_SPIN(xb_ld(&bar[XB_TOPGEN]) == tg, bar);
            __builtin_amdgcn_fence(__ATOMIC_ACQUIRE, "agent");
            xb_add(&bar[XB_XGEN(b.x)], 1u);
            asm volatile("s_waitcnt vmcnt(0)" ::: "memory");
        } else {
            XB_SPIN(xb_ld(&bar[XB_XGEN(b.x)]) == gen, bar);
            __builtin_amdgcn_fence(__ATOMIC_ACQUIRE, "agent");
            asm volatile("s_waitcnt vmcnt(0)" ::: "memory");
        }
    }
    __syncthreads();
}

struct Frame {
    LAS unsigned char* lds;
    volatile LAS unsigned* MISC;
    gu32* ctl;
    int tid, lane, wave, G, c;
    unsigned char* ws;
};
struct Args { const float* in[26]; float* out; unsigned char* ws; int ph_lo, ph_hi; };

__device__ __forceinline__ void p0_transpose_item(const float* W, int ldw, int csrc0, int k0, const float* gain, bf16* WT, int Kd, int drow0, LAS float* scr, int lane) {
#pragma unroll 8
    for (int i = 0; i < 32; ++i) { const int kk = 2 * i + (lane >> 5); float v = W[(size_t)(k0 + kk) * ldw + csrc0 + (lane & 31)]; if (gain) v *= gain[k0 + kk]; scr[kk * 33 + (lane & 31)] = v; }
    LDS_WAIT(); asm volatile("" ::: "memory");
    const int c = lane & 7;
#pragma unroll
    for (int j = 0; j < 4; ++j) { const int n = (lane >> 3) + 8 * j; const LAS float* s = scr + (8 * c) * 33 + n;
        u32x4 o; o.x = pk2(s[0 * 33], s[1 * 33]); o.y = pk2(s[2 * 33], s[3 * 33]); o.z = pk2(s[4 * 33], s[5 * 33]); o.w = pk2(s[6 * 33], s[7 * 33]);
        *(GAS u32x4*)(WT + (size_t)(drow0 + n) * Kd + k0 + 8 * c) = o; }
    LDS_WAIT(); asm volatile("" ::: "memory");
}

__device__ __forceinline__ void p0_prologue(Frame& F, const Args& A) {
    LAS float* scr = (LAS float*)(F.lds + RING_OFF + F.wave * 16384);
    const int gw = F.c * NWAVES + F.wave, NGW = F.G * NWAVES, lane = F.lane;
    unsigned char* ws = F.ws;
    constexpr int I_IN = 16 * (NP / 32), I_SQ = 16 * 32, I_KV = 16 * 64, I_EXP = 16 * 32;
    constexpr int NITEMS = I_IN + 3 * I_SQ + I_KV + 3 * NE * I_EXP;
    for (int it = gw; it < NITEMS; it += NGW) {
        int r = it;
        if (r < I_IN) { const int kb = r / (NP / 32), nb = r % (NP / 32), n0 = nb * 32; p0_transpose_item(A.in[3], INW, n0 + (n0 >= 1536 ? 8 : 0), kb * 64, nullptr, (bf16*)(ws + WS_WIN), D, n0, scr, lane); continue; } r -= I_IN;
        if (r < I_SQ) { p0_transpose_item(A.in[10], D, (r % 32) * 32, (r / 32) * 64, nullptr, (bf16*)(ws + WS_WOUT), D, (r % 32) * 32, scr, lane); continue; } r -= I_SQ;
        if (r < I_SQ) { p0_transpose_item(A.in[13], D, (r % 32) * 32, (r / 32) * 64, A.in[11], (bf16*)(ws + WS_WQ), D, (r % 32) * 32, scr, lane); continue; } r -= I_SQ;
        if (r < I_KV) { p0_transpose_item(A.in[14], 2 * D, (r % 64) * 32, (r / 64) * 64, nullptr, (bf16*)(ws + WS_WKV), D, (r % 64) * 32, scr, lane); continue; } r -= I_KV;
        if (r < I_SQ) { p0_transpose_item(A.in[15], D, (r % 32) * 32, (r / 32) * 64, nullptr, (bf16*)(ws + WS_WXO), D, (r % 32) * 32, scr, lane); continue; } r -= I_SQ;
        const int which = r / (NE * I_EXP); r -= which * (NE * I_EXP);
        const int e = r / I_EXP, q = r % I_EXP, kb = q / 32, nb = q % 32, n0 = nb * 32;
        if (which == 2) p0_transpose_item(A.in[23] + (size_t)e * FF * D, D, n0, kb * 64, nullptr, (bf16*)(ws + WS_WD), FF, e * D + n0, scr, lane);
        else { const int p = n0 >> 7, drow = e * 2048 + p * 256 + which * 128 + (n0 & 127);
               p0_transpose_item(A.in[which == 0 ? 19 : 21] + (size_t)e * D * FF, FF, n0, kb * 64, A.in[16], (bf16*)(ws + WS_WGU), D, drow, scr, lane); }
    }
    { const float* wr = A.in[17]; const float* gm = A.in[16]; float* o = (float*)(ws + WS_WR);
      for (int i = (F.c * NTHREADS + F.tid); i < D * NE; i += F.G * NTHREADS) o[i] = wr[i] * gm[i >> 5]; }
    __syncthreads();
    LAS float* wgs = (LAS float*)(F.lds + RING_OFF);
    for (int i = F.tid; i < 8 * D; i += NTHREADS) { const int k = i >> 3, j = i & 7; wgs[j * D + k] = A.in[3][(size_t)k * INW + 1536 + j]; }
    __syncthreads();
    {
        const float* x = A.in[0]; const float* gmix = A.in[2]; const float* bg = A.in[4];
        bf16* xn = (bf16*)(ws + WS_R1); float* gates = (float*)(ws + WS_GATES);
        f32x4 g[4];
#pragma unroll
        for (int j = 0; j < 4; ++j) g[j] = *(const f32x4*)(gmix + 4 * lane + 256 * j);
        for (int m = gw; m < T; m += NGW) {
            const GAS f32x4* xr = (const GAS f32x4*)(x + (size_t)m * D) + lane;
            f32x4 v[4]; float s = 0.f;
#pragma unroll
            for (int j = 0; j < 4; ++j) { v[j] = xr[64 * j]; s += (v[j].x * v[j].x + v[j].y * v[j].y) + (v[j].z * v[j].z + v[j].w * v[j].w); }
            const float r = rsqrtf(wave_sum(s) * (1.f / D) + EPS);
#pragma unroll
            for (int j = 0; j < 4; ++j) v[j] = v[j] * r * g[j];
            GAS unsigned long long* o8 = (GAS unsigned long long*)(xn + (size_t)m * D) + lane;
#pragma unroll
            for (int j = 0; j < 4; ++j) o8[64 * j] = (unsigned long long)pk2(v[j].x, v[j].y) | ((unsigned long long)pk2(v[j].z, v[j].w) << 32);
            float gs[8];
#pragma unroll
            for (int jg = 0; jg < 8; ++jg) { float a = 0.f;
#pragma unroll
                for (int j = 0; j < 4; ++j) { const f32x4 w = *(const LAS f32x4*)(wgs + jg * D + 4 * lane + 256 * j); a += (v[j].x * w.x + v[j].y * w.y) + (v[j].z * w.z + v[j].w * w.w); }
                gs[jg] = wave_sum(a); }
            if (lane < 8) { float pre = 0.f;
#pragma unroll
                for (int jg = 0; jg < 8; ++jg) pre = (lane == jg) ? gs[jg] : pre;
                pre += bg[lane];
                const float sc = 15.0f * tanhf(pre * (1.0f / 15.0f));
                float o = sc;
                if (lane >= 4) o = -log1pf(expf(-sc));
                gates[(size_t)m * 8 + lane] = o; }
        }
    }
    {
        const float* x = A.in[1]; const float* gmem = A.in[12]; bf16* mn = (bf16*)(ws + WS_R3);
        f32x4 g[4];
#pragma unroll
        for (int j = 0; j < 4; ++j) g[j] = *(const f32x4*)(gmem + 4 * lane + 256 * j);
        for (int m = gw; m < TM; m += NGW) {
            const GAS f32x4* xr = (const GAS f32x4*)(x + (size_t)m * D) + lane;
            f32x4 v[4]; float s = 0.f;
#pragma unroll
            for (int j = 0; j < 4; ++j) { v[j] = xr[64 * j]; s += (v[j].x * v[j].x + v[j].y * v[j].y) + (v[j].z * v[j].z + v[j].w * v[j].w); }
            const float r = rsqrtf(wave_sum(s) * (1.f / D) + EPS);
#pragma unroll
            for (int j = 0; j < 4; ++j) v[j] = v[j] * r * g[j];
            GAS unsigned long long* o8 = (GAS unsigned long long*)(mn + (size_t)m * D) + lane;
#pragma unroll
            for (int j = 0; j < 4; ++j) o8[64 * j] = (unsigned long long)pk2(v[j].x, v[j].y) | ((unsigned long long)pk2(v[j].z, v[j].w) << 32);
        }
    }
}

constexpr size_t TS1K = (size_t)256 * 1024 * 2;
struct P1Order {
    static constexpr bool GATHER = false;
    int G, c; const char* ws;
    __device__ __forceinline__ bool next(int i, pg8::Unit& u) const {
        const int L = i * G + c; if (L >= 2816) return false;
        if (L < 2560) { pg8::tile_remap(L, 256, 10, u.pm, u.pn); u.aux = 0; }
        else { const int Lp = L - 2560; if (Lp < 128) { u.aux = 1; u.pm = Lp >> 2; u.pn = Lp & 3; } else { const int Lq = Lp - 128; u.aux = 2; u.pm = Lq & 3; u.pn = Lq >> 2; } }
        return true;
    }
    __device__ __forceinline__ const char* Abase(const pg8::Unit& u) const { size_t o = WS_R1; if (u.aux == 1) o = WS_R3; if (u.aux == 2) o = WS_WKV + 4 * TS1K; return ws + o + (size_t)u.pm * TS1K; }
    __device__ __forceinline__ const char* Bbase(const pg8::Unit& u) const { size_t o = WS_WIN; if (u.aux == 1) o = WS_WKV; if (u.aux == 2) o = WS_R3; return ws + o + (size_t)u.pn * TS1K; }
    __device__ __forceinline__ void a_offsets(const pg8::Unit&, const int (&R)[2], const int (&C)[2], int K, unsigned (&v)[4]) const {
#pragma unroll
        for (int h = 0; h < 2; ++h)
#pragma unroll
            for (int i = 0; i < 2; ++i) v[h * 2 + i] = (unsigned)((h * 128 + R[i]) * K + C[i]) * 2u; }
};
struct PlainOrder {
    static constexpr bool GATHER = false;
    int G, c, nM, nN; const char *A, *Bt;
    __device__ __forceinline__ bool next(int i, pg8::Unit& u) const { const int L = i * G + c; if (L >= nM * nN) return false; pg8::tile_remap(L, nM, nN, u.pm, u.pn); u.aux = 0; return true; }
    __device__ __forceinline__ const char* Abase(const pg8::Unit& u) const { return A + (size_t)u.pm * TS1K; }
    __device__ __forceinline__ const char* Bbase(const pg8::Unit& u) const { return Bt + (size_t)u.pn * TS1K; }
    __device__ __forceinline__ void a_offsets(const pg8::Unit&, const int (&R)[2], const int (&C)[2], int K, unsigned (&v)[4]) const {
#pragma unroll
        for (int h = 0; h < 2; ++h)
#pragma unroll
            for (int i = 0; i < 2; ++i) v[h * 2 + i] = (unsigned)((h * 128 + R[i]) * K + C[i]) * 2u; }
};
template <bool GATH, int NN>
struct MoeOrder {
    static constexpr bool GATHER = GATH;
    int G, c, NT; const LAS int* tpre; const LAS int* cnts; const char* A; const char* A2; const char* Bt; const int* lpid;
    __device__ __forceinline__ bool next(int i, pg8::Unit& u) const {
        const int L = i * G + c; if (L >= NT * NN) return false; pg8::tile_remap(L, NT, NN, u.pm, u.pn);
        int e = 0;
#pragma unroll 1
        for (int j = 1; j < NE; ++j) e += (tpre[j] <= u.pm) ? 1 : 0;
        u.aux = __builtin_amdgcn_readfirstlane(e); return true; }
    __device__ __forceinline__ const char* Abase(const pg8::Unit& u) const { if (GATH) return A; return u.pm < 512 ? A + (size_t)u.pm * TS1K : A2 + (size_t)(u.pm - 512) * TS1K; }
    __device__ __forceinline__ const char* Bbase(const pg8::Unit& u) const { return Bt + (size_t)(u.aux * NN + u.pn) * TS1K; }
    __device__ __forceinline__ void a_offsets(const pg8::Unit& u, const int (&R)[2], const int (&C)[2], int K, unsigned (&v)[4]) const {
        if (GATH) { const int base = (u.pm - tpre[u.aux]) * 256, cnt = cnts[u.aux];
#pragma unroll
            for (int h = 0; h < 2; ++h)
#pragma unroll
                for (int i = 0; i < 2; ++i) { const int pos = base + h * 128 + R[i]; int pid = 0; if (pos < cnt) pid = lpid[(size_t)u.aux * LISTCAP + pos]; v[h * 2 + i] = (unsigned)((pid >> 2) * K + C[i]) * 2u; }
        } else {
#pragma unroll
            for (int h = 0; h < 2; ++h)
#pragma unroll
                for (int i = 0; i < 2; ++i) v[h * 2 + i] = (unsigned)((h * 128 + R[i]) * K + C[i]) * 2u; } }
};

struct EpiP1 {
    static constexpr bool PERM = true;
    unsigned char* ws;
    __device__ __forceinline__ void operator()(const f32x4 (&acc)[2][2][4][2], const pg8::Unit& u, int wr, int wc, int fr, int fq) const {
        const int row0 = u.pm * 256 + wr * 64 + fr, col0 = u.pn * 256 + wc * 32 + 8 * fq;
        size_t bo = WS_PROJ; int ld = NP; if (u.aux == 1) { bo = WS_KM; ld = D; } if (u.aux == 2) { bo = WS_VT; ld = TM; }
        bf16* base = (bf16*)(ws + bo);
        const bool act = (u.aux == 0 && u.pn >= 6);
#pragma unroll
        for (int ai = 0; ai < 2; ++ai)
#pragma unroll
            for (int m = 0; m < 4; ++m) { bf16* rowp = base + (size_t)(row0 + ai * 128 + m * 16) * ld + col0;
#pragma unroll
                for (int bj = 0; bj < 2; ++bj) { f32x4 v0 = acc[ai][bj][m][0], v1 = acc[ai][bj][m][1];
                    if (act) {
#pragma unroll
                        for (int j = 0; j < 4; ++j) { v0[j] = gelu_tanh(v0[j]); v1[j] = gelu_tanh(v1[j]); } }
                    u32x4 w; w.x = cvt_pk_bf16(v0[0], v0[1]); w.y = cvt_pk_bf16(v0[2], v0[3]); w.z = cvt_pk_bf16(v1[0], v1[1]); w.w = cvt_pk_bf16(v1[2], v1[3]);
                    *(u32x4*)(rowp + bj * 128) = w; } }
    }
};
template <bool BASE_F32> struct EpiResid {
    static constexpr bool PERM = true;
    const void* base; bf16* out; float* ssq;
    __device__ __forceinline__ void operator()(const f32x4 (&acc)[2][2][4][2], const pg8::Unit& u, int wr, int wc, int fr, int fq) const {
        const int row0 = u.pm * 256 + wr * 64 + fr, col0 = u.pn * 256 + wc * 32 + 8 * fq;
#pragma unroll
        for (int ai = 0; ai < 2; ++ai)
#pragma unroll
            for (int m = 0; m < 4; ++m) { const int row = row0 + ai * 128 + m * 16; float ss = 0.f;
#pragma unroll
                for (int bj = 0; bj < 2; ++bj) { const size_t off = (size_t)row * D + col0 + bj * 128; f32x4 b0, b1;
                    if (BASE_F32) { b0 = *(const f32x4*)((const float*)base + off); b1 = *(const f32x4*)((const float*)base + off + 4); }
                    else { const u32x4 w = *(const u32x4*)((const bf16*)base + off); b0 = (f32x4){bflo(w.x), bfhi(w.x), bflo(w.y), bfhi(w.y)}; b1 = (f32x4){bflo(w.z), bfhi(w.z), bflo(w.w), bfhi(w.w)}; }
                    const f32x4 v0 = acc[ai][bj][m][0] + b0, v1 = acc[ai][bj][m][1] + b1;
                    ss += (v0[0] * v0[0] + v0[1] * v0[1]) + (v0[2] * v0[2] + v0[3] * v0[3]) + (v1[0] * v1[0] + v1[1] * v1[1]) + (v1[2] * v1[2] + v1[3] * v1[3]);
                    u32x4 w; w.x = cvt_pk_bf16(v0[0], v0[1]); w.y = cvt_pk_bf16(v0[2], v0[3]); w.z = cvt_pk_bf16(v1[0], v1[1]); w.w = cvt_pk_bf16(v1[2], v1[3]);
                    *(u32x4*)(out + off) = w; }
                ss += __shfl_xor(ss, 16); ss += __shfl_xor(ss, 32);
                if (fq == 0) ssq[(size_t)row * 16 + u.pn * 4 + wc] = ss; }
    }
};
__device__ __forceinline__ float row_rms_from_ssq(const float* ssq, int row) {
    const f32x4* p = (const f32x4*)(ssq + (size_t)row * 16); const f32x4 a = p[0], b = p[1], c = p[2], d = p[3];
    const float s = (((a[0] + a[1]) + (a[2] + a[3])) + ((b[0] + b[1]) + (b[2] + b[3]))) + (((c[0] + c[1]) + (c[2] + c[3])) + ((d[0] + d[1]) + (d[2] + d[3])));
    return rsqrtf(s * (1.0f / D) + EPS);
}
struct EpiQ {
    static constexpr bool PERM = true;
    bf16* out; const float* ssq;
    __device__ __forceinline__ void operator()(const f32x4 (&acc)[2][2][4][2], const pg8::Unit& u, int wr, int wc, int fr, int fq) const {
        const int row0 = u.pm * 256 + wr * 64 + fr, col0 = u.pn * 256 + wc * 32 + 8 * fq;
#pragma unroll
        for (int ai = 0; ai < 2; ++ai)
#pragma unroll
            for (int m = 0; m < 4; ++m) { const int row = row0 + ai * 128 + m * 16; const float r = row_rms_from_ssq(ssq, row) * (1.0f / 16.0f);
#pragma unroll
                for (int bj = 0; bj < 2; ++bj) { const f32x4 v0 = acc[ai][bj][m][0] * r, v1 = acc[ai][bj][m][1] * r;
                    u32x4 w; w.x = cvt_pk_bf16(v0[0], v0[1]); w.y = cvt_pk_bf16(v0[2], v0[3]); w.z = cvt_pk_bf16(v1[0], v1[1]); w.w = cvt_pk_bf16(v1[2], v1[3]);
                    *(u32x4*)(out + (size_t)row * D + col0 + bj * 128) = w; } }
    }
};
struct EpiG1 {
    static constexpr bool PERM = true;
    bf16* H1; bf16* H2; const int* lpid; const float* rr2; const float* bgate; const float* bup; const LAS int* tpre; const LAS int* cnts;
    __device__ __forceinline__ void operator()(const f32x4 (&acc)[2][2][4][2], const pg8::Unit& u, int wr, int wc, int fr, int fq) const {
        const int e = u.aux, base = (u.pm - tpre[e]) * 256, cnt = cnts[e];
        bf16* Ht = u.pm < 512 ? H1 + (size_t)u.pm * 256 * 1024 : H2 + (size_t)(u.pm - 512) * 256 * 1024;
        const int hc = u.pn * 128 + wc * 32 + 8 * fq;
        const f32x4 bg0 = *(const f32x4*)(bgate + e * FF + hc), bg1 = *(const f32x4*)(bgate + e * FF + hc + 4);
        const f32x4 bu0 = *(const f32x4*)(bup + e * FF + hc), bu1 = *(const f32x4*)(bup + e * FF + hc + 4);
#pragma unroll
        for (int ai = 0; ai < 2; ++ai)
#pragma unroll
            for (int m = 0; m < 4; ++m) { const int rl = ai * 128 + wr * 64 + m * 16 + fr; const int pos = base + rl; int pid = 0; if (pos < cnt) pid = lpid[(size_t)e * LISTCAP + pos];
                const float r = rr2[pid >> 2];
                f32x4 g0 = acc[ai][0][m][0] * r + bg0, g1 = acc[ai][0][m][1] * r + bg1, u0 = acc[ai][1][m][0] * r + bu0, u1 = acc[ai][1][m][1] * r + bu1;
                float h[8];
#pragma unroll
                for (int j = 0; j < 4; ++j) { float g = fminf(g0[j], 7.0f), uu = fminf(fmaxf(u0[j], -7.0f), 7.0f); h[j] = (uu + 1.0f) * g * sigmoidf_fast(1.702f * g);
                    g = fminf(g1[j], 7.0f); uu = fminf(fmaxf(u1[j], -7.0f), 7.0f); h[4 + j] = (uu + 1.0f) * g * sigmoidf_fast(1.702f * g); }
                u32x4 w; w.x = cvt_pk_bf16(h[0], h[1]); w.y = cvt_pk_bf16(h[2], h[3]); w.z = cvt_pk_bf16(h[4], h[5]); w.w = cvt_pk_bf16(h[6], h[7]);
                *(u32x4*)(Ht + (size_t)rl * FF + hc) = w; }
    }
};
struct EpiG2 {
    static constexpr bool PERM = true;
    bf16* Y; const int* lpid; const float* lw; const float* bdown; const LAS int* tpre; const LAS int* cnts;
    __device__ __forceinline__ void operator()(const f32x4 (&acc)[2][2][4][2], const pg8::Unit& u, int wr, int wc, int fr, int fq) const {
        const int e = u.aux, base = (u.pm - tpre[e]) * 256, cnt = cnts[e];
        const int col0 = u.pn * 256 + wc * 32 + 8 * fq;
        f32x4 bd[2][2];
#pragma unroll
        for (int bj = 0; bj < 2; ++bj) { bd[bj][0] = *(const f32x4*)(bdown + e * D + col0 + bj * 128); bd[bj][1] = *(const f32x4*)(bdown + e * D + col0 + bj * 128 + 4); }
#pragma unroll
        for (int ai = 0; ai < 2; ++ai)
#pragma unroll
            for (int m = 0; m < 4; ++m) { const int rl = ai * 128 + wr * 64 + m * 16 + fr; const int pos = base + rl;
                if (pos < cnt) { const int pid = lpid[(size_t)e * LISTCAP + pos]; const float w8 = lw[(size_t)e * LISTCAP + pos];
#pragma unroll
                    for (int bj = 0; bj < 2; ++bj) { const f32x4 v0 = (acc[ai][bj][m][0] + bd[bj][0]) * w8, v1 = (acc[ai][bj][m][1] + bd[bj][1]) * w8;
                        u32x4 w; w.x = cvt_pk_bf16(v0[0], v0[1]); w.y = cvt_pk_bf16(v0[2], v0[3]); w.z = cvt_pk_bf16(v1[0], v1[1]); w.w = cvt_pk_bf16(v1[2], v1[3]);
                        *(u32x4*)(Y + (size_t)pid * D + col0 + bj * 128) = w; } } }
    }
};


__device__ __forceinline__ void ld16_to_lds(LAS bf16* dst, const bf16* src) { *(LAS u32x4*)dst = *(const GAS u32x4*)src; }

__device__ __forceinline__ void p2_mlstm_chain_simple(Frame& F, const Args& A, int ch) {
    const int b = ch >> 2, h = ch & 3, tid = F.tid, t = tid >> 2, p = tid & 3;
    const bf16* proj = (const bf16*)(F.ws + WS_PROJ); const float* gates = (const float*)(F.ws + WS_GATES); bf16* ycat = (bf16*)(F.ws + WS_R2);
    const float* ghead = A.in[5];
    LAS bf16* qs = (LAS bf16*)(F.lds + 0); LAS bf16* ks = (LAS bf16*)(F.lds + 16384); LAS bf16* vs = (LAS bf16*)(F.lds + 32768);
    LAS float* Cs = (LAS float*)(F.lds + 65536); LAS float* ns = (LAS float*)(F.lds + 98304);
    LAS float* ibs = ns + 64; LAS float* fbs = ibs + 128; LAS float* As = fbs + 128; LAS float* Mts = As + 128; LAS float* bcs = Mts + 128; LAS float* wks = bcs + 128; LAS float* scal = wks + 128;
    for (int i = tid; i < 128 * 64; i += NTHREADS) Cs[i] = 0.f;
    if (tid < 64) ns[tid] = 0.f;
    float mstate = 0.f;
    for (int c = 0; c < 16; ++c) {
        const int tg0 = b * SEQ + c * 128;
        __syncthreads();
#pragma unroll
        for (int j = 0; j < 2; ++j) { const int i = tid + 512 * j, row = i >> 3, part = i & 7; const bf16* src = proj + (size_t)(tg0 + row) * NP + h * 64 + part * 8;
            ld16_to_lds(qs + row * 64 + part * 8, src); ld16_to_lds(ks + row * 64 + part * 8, src + 256); }
#pragma unroll
        for (int j = 0; j < 4; ++j) { const int i = tid + 512 * j, row = i >> 4, part = i & 15; ld16_to_lds(vs + row * 128 + part * 8, proj + (size_t)(tg0 + row) * NP + 512 + h * 128 + part * 8); }
        if (tid < 128) { ibs[tid] = gates[(size_t)(tg0 + tid) * 8 + h]; fbs[tid] = gates[(size_t)(tg0 + tid) * 8 + 4 + h]; }
        __syncthreads();
        if (tid == 0) { float bs = 0.f, pm = -3.0e38f;
            for (int s = 0; s < 128; ++s) { bs += fbs[s]; bcs[s] = bs; const float a = ibs[s] - bs; As[s] = a; pm = fmaxf(pm, a); Mts[s] = fmaxf(mstate, pm); }
            scal[0] = fmaxf(mstate, pm); scal[1] = bs; }
        __syncthreads();
        const float Mnew = scal[0], bL = scal[1];
        if (tid < 128) wks[tid] = expf(As[tid] - Mnew);
        {
            const float Mt = Mts[t];
            float qd[16];
#pragma unroll
            for (int j = 0; j < 16; ++j) qd[j] = bf2f(qs[t * 64 + 16 * p + j]) * 0.125f;
            float acc[32]; float den = 0.f;
#pragma unroll
            for (int j = 0; j < 32; ++j) acc[j] = 0.f;
            for (int s = 0; s <= t; ++s) {
                float dot = 0.f;
#pragma unroll
                for (int j = 0; j < 16; ++j) dot += qd[j] * bf2f(ks[s * 64 + 16 * p + j]);
                dot += __shfl_xor(dot, 1); dot += __shfl_xor(dot, 2);
                const float val = dot * expf(As[s] - Mt);
                den += val;
#pragma unroll
                for (int j = 0; j < 32; ++j) acc[j] += val * bf2f(vs[s * 128 + 32 * p + j]);
            }
            const float winter = expf(mstate - Mt);
            float acc2[32]; float nq = 0.f;
#pragma unroll
            for (int j = 0; j < 32; ++j) acc2[j] = 0.f;
            for (int d = 0; d < 64; d += 4) {
                float q4[4];
#pragma unroll
                for (int e = 0; e < 4; ++e) q4[e] = bf2f(qs[t * 64 + d + e]) * 0.125f;
#pragma unroll
                for (int j = 0; j < 32; ++j) { const f32x4 c4 = *(const LAS f32x4*)(Cs + (32 * p + j) * 64 + d); acc2[j] += (c4[0] * q4[0] + c4[1] * q4[1]) + (c4[2] * q4[2] + c4[3] * q4[3]); }
                const f32x4 n4 = *(const LAS f32x4*)(ns + d); nq += (n4[0] * q4[0] + n4[1] * q4[1]) + (n4[2] * q4[2] + n4[3] * q4[3]);
            }
            den += winter * nq;
            const float dn = fmaxf(fabsf(den), expf(-(bcs[t] + Mt)));
            const float inv = 1.0f / dn; float ss = 0.f;
#pragma unroll
            for (int j = 0; j < 32; ++j) { acc[j] = (acc[j] + winter * acc2[j]) * inv; ss += acc[j] * acc[j]; }
            ss += __shfl_xor(ss, 1); ss += __shfl_xor(ss, 2);
            const float r = rsqrtf(ss * (1.0f / 128.0f) + EPS);
            const bf16* og = proj + (size_t)(tg0 + t) * NP + 1024 + h * 128 + 32 * p; bf16* yo = ycat + (size_t)(tg0 + t) * D + h * 128 + 32 * p; const float* gh = ghead + h * 128 + 32 * p;
#pragma unroll
            for (int j8 = 0; j8 < 4; ++j8) { const u32x4 ow = *(const GAS u32x4*)(og + j8 * 8); const unsigned oww[4] = {ow.x, ow.y, ow.z, ow.w}; unsigned res[4];
#pragma unroll
                for (int e = 0; e < 4; ++e) { const int j = j8 * 8 + 2 * e; const float o0 = bflo(oww[e]), o1 = bfhi(oww[e]);
                    const float y0 = acc[j] * r * gh[j] * (1.0f / (1.0f + expf(-o0))), y1 = acc[j + 1] * r * gh[j + 1] * (1.0f / (1.0f + expf(-o1))); res[e] = pk2(y0, y1); }
                *(GAS u32x4*)(yo + j8 * 8) = (u32x4){res[0], res[1], res[2], res[3]}; }
        }
        __syncthreads();
        {
            const float decay = expf(mstate - Mnew); const int v = tid >> 2, d0 = 16 * (tid & 3);
            float cn[16];
#pragma unroll
            for (int j = 0; j < 16; ++j) cn[j] = decay * Cs[v * 64 + d0 + j];
            for (int s = 0; s < 128; ++s) { const float wv = wks[s] * bf2f(vs[s * 128 + v]);
#pragma unroll
                for (int j = 0; j < 16; ++j) cn[j] += wv * bf2f(ks[s * 64 + d0 + j]); }
#pragma unroll
            for (int j = 0; j < 16; ++j) Cs[v * 64 + d0 + j] = cn[j];
            if (tid < 64) { float a = decay * ns[tid]; for (int s = 0; s < 128; ++s) a += wks[s] * bf2f(ks[s * 64 + tid]); ns[tid] = a; }
            mstate = bL + Mnew;
        }
    }
    __syncthreads();
}

__device__ __forceinline__ void p2_gmlp_unit_simple(Frame& F, const Args& A, int u) {
    const int b = u >> 6, c = (u >> 2) & 15, g = u & 3, tid = F.tid, t = tid >> 2, p = tid & 3, tg0 = b * SEQ + c * 128;
    const bf16* proj = (const bf16*)(F.ws + WS_PROJ); bf16* ycat = (bf16*)(F.ws + WS_R2);
    const float* wsp = A.in[6] + (size_t)g * 128 * 128; const float* bsp = A.in[7] + g * 128; const float* gv = A.in[8] + g * 128; const float* go = A.in[9] + g * 128;
    LAS float* zs = (LAS float*)(F.lds + 0);
    __syncthreads();
    {
        const bf16* src = proj + (size_t)(tg0 + t) * NP + 2048 + g * 128 + 32 * p; float z[32]; float ss = 0.f;
#pragma unroll
        for (int j8 = 0; j8 < 4; ++j8) { const u32x4 w = *(const GAS u32x4*)(src + j8 * 8); const unsigned ww[4] = {w.x, w.y, w.z, w.w};
#pragma unroll
            for (int e = 0; e < 4; ++e) { z[j8 * 8 + 2 * e] = bflo(ww[e]); z[j8 * 8 + 2 * e + 1] = bfhi(ww[e]); } }
#pragma unroll
        for (int j = 0; j < 32; ++j) ss += z[j] * z[j];
        ss += __shfl_xor(ss, 1); ss += __shfl_xor(ss, 2);
        const float r = rsqrtf(ss * (1.0f / 128.0f) + EPS);
#pragma unroll
        for (int j = 0; j < 32; ++j) zs[t * 128 + 32 * p + j] = z[j] * r * gv[32 * p + j];
    }
    __syncthreads();
    {
        float acc[32];
#pragma unroll
        for (int j = 0; j < 32; ++j) acc[j] = 0.f;
        for (int s = 0; s <= t; ++s) { const float w = wsp[t * 128 + s];
#pragma unroll
            for (int j = 0; j < 32; ++j) acc[j] += w * zs[s * 128 + 32 * p + j]; }
        const float bias = bsp[t];
        const bf16* us = proj + (size_t)(tg0 + t) * NP + 1536 + g * 128 + 32 * p; float ss = 0.f;
#pragma unroll
        for (int j8 = 0; j8 < 4; ++j8) { const u32x4 w = *(const GAS u32x4*)(us + j8 * 8); const unsigned ww[4] = {w.x, w.y, w.z, w.w};
#pragma unroll
            for (int e = 0; e < 4; ++e) { const int j = j8 * 8 + 2 * e; acc[j] = bflo(ww[e]) * (acc[j] + bias); acc[j + 1] = bfhi(ww[e]) * (acc[j + 1] + bias); ss += acc[j] * acc[j] + acc[j + 1] * acc[j + 1]; } }
        ss += __shfl_xor(ss, 1); ss += __shfl_xor(ss, 2);
        const float r = rsqrtf(ss * (1.0f / 128.0f) + EPS);
        bf16* yo = ycat + (size_t)(tg0 + t) * D + 512 + g * 128 + 32 * p;
#pragma unroll
        for (int j8 = 0; j8 < 4; ++j8) { unsigned res[4];
#pragma unroll
            for (int e = 0; e < 4; ++e) { const int j = j8 * 8 + 2 * e; res[e] = pk2(acc[j] * r * go[32 * p + j], acc[j + 1] * r * go[32 * p + j + 1]); }
            *(GAS u32x4*)(yo + j8 * 8) = (u32x4){res[0], res[1], res[2], res[3]}; }
    }
}

__device__ __forceinline__ void p5_attn_unit_simple(Frame& F, int u) {
    const int b = u >> 7, h = (u >> 5) & 3, qt = u & 31, tid = F.tid, ql = tid >> 3, p = tid & 7;
    const bf16* Q = (const bf16*)(F.ws + WS_R2); const bf16* Km = (const bf16*)(F.ws + WS_KM); const bf16* Vt = (const bf16*)(F.ws + WS_VT); bf16* O = (bf16*)(F.ws + WS_R3);
    LAS bf16* Ks = (LAS bf16*)(F.lds + 0); LAS bf16* Vs = (LAS bf16*)(F.lds + 32768);
    const size_t tq = (size_t)b * SEQ + qt * 64 + ql;
    float qf[32], acc[32];
    { const bf16* src = Q + tq * D + h * 256 + 32 * p;
#pragma unroll
      for (int j8 = 0; j8 < 4; ++j8) { const u32x4 w = *(const GAS u32x4*)(src + j8 * 8); const unsigned ww[4] = {w.x, w.y, w.z, w.w};
#pragma unroll
          for (int e = 0; e < 4; ++e) { qf[j8 * 8 + 2 * e] = bflo(ww[e]); qf[j8 * 8 + 2 * e + 1] = bfhi(ww[e]); } } }
#pragma unroll
    for (int j = 0; j < 32; ++j) acc[j] = 0.f;
    float mrun = -1.0e30f, l = 0.f;
    for (int kt = 0; kt < 4; ++kt) {
        __syncthreads();
#pragma unroll
        for (int j = 0; j < 4; ++j) { const int i = tid + 512 * j, row = i >> 5, part = i & 31; ld16_to_lds(Ks + row * 256 + part * 8, Km + (size_t)(b * 256 + kt * 64 + row) * D + h * 256 + part * 8); }
#pragma unroll
        for (int j = 0; j < 4; ++j) { const int i = tid + 512 * j, d = i >> 3, part = i & 7; const u32x4 w = *(const GAS u32x4*)(Vt + (size_t)(h * 256 + d) * TM + b * 256 + kt * 64 + part * 8); const unsigned ww[4] = {w.x, w.y, w.z, w.w};
#pragma unroll
            for (int e = 0; e < 4; ++e) { Vs[(part * 8 + 2 * e) * 256 + d] = (bf16)(ww[e] & 0xffffu); Vs[(part * 8 + 2 * e + 1) * 256 + d] = (bf16)(ww[e] >> 16); } }
        __syncthreads();
        for (int mb = 0; mb < 8; ++mb) {
            float s8[8]; float mx = mrun;
#pragma unroll
            for (int e = 0; e < 8; ++e) { const int m = mb * 8 + e; float dot = 0.f;
#pragma unroll
                for (int j8 = 0; j8 < 4; ++j8) { const u32x4 w = *(const LAS u32x4*)(Ks + m * 256 + 32 * p + j8 * 8); const unsigned ww[4] = {w.x, w.y, w.z, w.w};
#pragma unroll
                    for (int q = 0; q < 4; ++q) dot += qf[j8 * 8 + 2 * q] * bflo(ww[q]) + qf[j8 * 8 + 2 * q + 1] * bfhi(ww[q]); }
                dot += __shfl_xor(dot, 1); dot += __shfl_xor(dot, 2); dot += __shfl_xor(dot, 4); s8[e] = dot; mx = fmaxf(mx, dot); }
            const float corr = expf(mrun - mx); mrun = mx; l *= corr;
#pragma unroll
            for (int j = 0; j < 32; ++j) acc[j] *= corr;
#pragma unroll
            for (int e = 0; e < 8; ++e) { const int m = mb * 8 + e; const float pe = expf(s8[e] - mx); l += pe;
#pragma unroll
                for (int j8 = 0; j8 < 4; ++j8) { const u32x4 w = *(const LAS u32x4*)(Vs + m * 256 + 32 * p + j8 * 8); const unsigned ww[4] = {w.x, w.y, w.z, w.w};
#pragma unroll
                    for (int q = 0; q < 4; ++q) { acc[j8 * 8 + 2 * q] += pe * bflo(ww[q]); acc[j8 * 8 + 2 * q + 1] += pe * bfhi(ww[q]); } } }
        }
    }
    const float inv = 1.0f / l; bf16* dst = O + tq * D + h * 256 + 32 * p;
#pragma unroll
    for (int j8 = 0; j8 < 4; ++j8) { u32x4 w; w.x = pk2(acc[j8 * 8] * inv, acc[j8 * 8 + 1] * inv); w.y = pk2(acc[j8 * 8 + 2] * inv, acc[j8 * 8 + 3] * inv); w.z = pk2(acc[j8 * 8 + 4] * inv, acc[j8 * 8 + 5] * inv); w.w = pk2(acc[j8 * 8 + 6] * inv, acc[j8 * 8 + 7] * inv);
        *(GAS u32x4*)(dst + j8 * 8) = w; }
}

__device__ __forceinline__ void p7_router(Frame& F, const Args& A) {
    const int tid = F.tid, lane = F.lane, w = F.wave, tl = lane & 31, kh = lane >> 5;
    const bf16* x2b = (const bf16*)(F.ws + WS_R2); const float* ssq2 = (const float*)(F.ws + WS_SSQ2); float* rr2 = (float*)(F.ws + WS_RR2);
    const float* brt = A.in[18]; int* lpid = (int*)(F.ws + WS_LPID); float* lw = (float*)(F.ws + WS_LW);
    LAS float* wr = (LAS float*)(F.lds + 0);
    LAS int* hist = (LAS int*)(F.lds + LDS_X_OFF); LAS int* basee = hist + 32; LAS int* pinfo = basee + 32; LAS float* pw = (LAS float*)(pinfo + 1024);
    { const float* src = (const float*)(F.ws + WS_WR); for (int i = tid; i < D * NE / 4; i += NTHREADS) ((LAS f32x4*)wr)[i] = ((const GAS f32x4*)src)[i]; }
    if (tid < 32) hist[tid] = 0;
    __syncthreads();
    for (int chunk = F.c; chunk < T / 256; chunk += F.G) {
        const int t = chunk * 256 + 32 * w + tl;
        float acc[32];
#pragma unroll
        for (int e = 0; e < 32; ++e) acc[e] = 0.f;
        const bf16* xr = x2b + (size_t)t * D + 512 * kh;
        for (int k8 = 0; k8 < 64; ++k8) {
            const u32x4 xw = *(const GAS u32x4*)(xr + k8 * 8); const unsigned xx[4] = {xw.x, xw.y, xw.z, xw.w};
#pragma unroll
            for (int q = 0; q < 8; ++q) { const float xv = (q & 1) ? bfhi(xx[q >> 1]) : bflo(xx[q >> 1]); const LAS f32x4* wp = (const LAS f32x4*)(wr + (512 * kh + k8 * 8 + q) * 32);
#pragma unroll
                for (int e4 = 0; e4 < 8; ++e4) { const f32x4 w4 = wp[e4]; acc[e4 * 4] += xv * w4[0]; acc[e4 * 4 + 1] += xv * w4[1]; acc[e4 * 4 + 2] += xv * w4[2]; acc[e4 * 4 + 3] += xv * w4[3]; } }
        }
#pragma unroll
        for (int e = 0; e < 32; ++e) acc[e] += __shfl_xor(acc[e], 32);
        const float r = row_rms_from_ssq(ssq2, t);
#pragma unroll
        for (int e = 0; e < 32; ++e) acc[e] = acc[e] * r + brt[e];
        int idx[4]; float val[4]; unsigned taken = 0u;
#pragma unroll
        for (int k = 0; k < 4; ++k) { float best = -3.0e38f; int bi = 0;
#pragma unroll
            for (int e = 0; e < 32; ++e) { const bool ok = !((taken >> e) & 1u) && (acc[e] > best); best = ok ? acc[e] : best; bi = ok ? e : bi; }
            idx[k] = bi; val[k] = best; taken |= 1u << bi; }
        float ex[4], sum = 0.f;
#pragma unroll
        for (int k = 0; k < 4; ++k) { ex[k] = expf(val[k] - val[0]); sum += ex[k]; }
        const float inv = 1.0f / sum;
        if (kh == 0) { rr2[t] = r;
#pragma unroll
            for (int k = 0; k < 4; ++k) { const int rank = __hip_atomic_fetch_add(hist + idx[k], 1, __ATOMIC_RELAXED, __HIP_MEMORY_SCOPE_WORKGROUP); pinfo[(32 * w + tl) * 4 + k] = idx[k] | (rank << 5); pw[(32 * w + tl) * 4 + k] = ex[k] * inv; } }
        __syncthreads();
        if (tid < 32) { basee[tid] = (int)__hip_atomic_fetch_add((unsigned*)(F.ctl + CW_CNT + tid), (unsigned)hist[tid], RLX_AGENT); hist[tid] = 0; }
        __syncthreads();
#pragma unroll
        for (int j = 0; j < 2; ++j) { const int i = tid + 512 * j, info = pinfo[i], e = info & 31, pos = basee[e] + (info >> 5); lpid[(size_t)e * LISTCAP + pos] = chunk * 1024 + i; lw[(size_t)e * LISTCAP + pos] = pw[i]; }
        __syncthreads();
    }
}
__device__ __forceinline__ int moe_tables(Frame& F, LAS int*& tpre, LAS int*& cnts) {
    tpre = (LAS int*)(F.lds + LDS_X_OFF); cnts = tpre + 40;
    __syncthreads();
    if (F.tid < 32) cnts[F.tid] = (int)__hip_atomic_load((unsigned*)(F.ctl + CW_CNT + F.tid), RLX_AGENT);
    __syncthreads();
    if (F.tid == 0) { int s = 0; for (int e = 0; e < 32; ++e) { tpre[e] = s; s += (cnts[e] + 255) >> 8; } tpre[32] = s; }
    __syncthreads();
    return __builtin_amdgcn_readfirstlane(tpre[32]);
}
__device__ __forceinline__ void p10_final(Frame& F, const Args& A) {
    const int gw = F.c * NWAVES + F.wave, NGW = F.G * NWAVES, lane = F.lane;
    const bf16* x2b = (const bf16*)(F.ws + WS_R2); const bf16* Y = (const bf16*)(F.ws + WS_Y); const float* gf = A.in[25]; float* out = A.out;
    f32x4 g[4];
#pragma unroll
    for (int hh = 0; hh < 2; ++hh) { g[2 * hh] = *(const f32x4*)(gf + 512 * hh + 8 * lane); g[2 * hh + 1] = *(const f32x4*)(gf + 512 * hh + 8 * lane + 4); }
    for (int t = gw; t < T; t += NGW) {
        float v[16];
#pragma unroll
        for (int hh = 0; hh < 2; ++hh) { const u32x4 w = *(const GAS u32x4*)(x2b + (size_t)t * D + 512 * hh + 8 * lane); const unsigned ww[4] = {w.x, w.y, w.z, w.w};
#pragma unroll
            for (int e = 0; e < 4; ++e) { v[8 * hh + 2 * e] = bflo(ww[e]); v[8 * hh + 2 * e + 1] = bfhi(ww[e]); } }
#pragma unroll
        for (int k = 0; k < 4; ++k)
#pragma unroll
            for (int hh = 0; hh < 2; ++hh) { const u32x4 w = *(const GAS u32x4*)(Y + ((size_t)t * 4 + k) * D + 512 * hh + 8 * lane); const unsigned ww[4] = {w.x, w.y, w.z, w.w};
#pragma unroll
                for (int e = 0; e < 4; ++e) { v[8 * hh + 2 * e] += bflo(ww[e]); v[8 * hh + 2 * e + 1] += bfhi(ww[e]); } }
        float s = 0.f;
#pragma unroll
        for (int j = 0; j < 16; ++j) s += v[j] * v[j];
        const float r = rsqrtf(wave_sum(s) * (1.0f / D) + EPS);
#pragma unroll
        for (int hh = 0; hh < 2; ++hh) { float* o = out + (size_t)t * D + 512 * hh + 8 * lane;
            *(GAS f32x4*)o = (f32x4){v[8 * hh] * r * g[2 * hh][0], v[8 * hh + 1] * r * g[2 * hh][1], v[8 * hh + 2] * r * g[2 * hh][2], v[8 * hh + 3] * r * g[2 * hh][3]};
            *(GAS f32x4*)(o + 4) = (f32x4){v[8 * hh + 4] * r * g[2 * hh + 1][0], v[8 * hh + 5] * r * g[2 * hh + 1][1], v[8 * hh + 6] * r * g[2 * hh + 1][2], v[8 * hh + 7] * r * g[2 * hh + 1][3]}; }
    }
}

constexpr int NPHASES = 11;
__global__ void __launch_bounds__(NTHREADS, 2) fwd_kernel(Args args) {
    extern __shared__ __attribute__((aligned(16))) unsigned char lds_raw[];
    Frame F;
    F.lds = (LAS unsigned char*)lds_raw;
    F.MISC = (volatile LAS unsigned*)(F.lds + MISC_OFF);
    F.tid = threadIdx.x; F.lane = F.tid & 63; F.wave = __builtin_amdgcn_readfirstlane(F.tid >> 6);
    F.G = gridDim.x; F.c = blockIdx.x; F.ws = args.ws; F.ctl = (gu32*)(args.ws + WS_CTL);
    for (int u = F.tid; u < 1024 / 4; u += NTHREADS) ((LAS unsigned*)(F.lds + LDSCTL_OFF))[u] = 0u;
    __syncthreads();
    const int lo = args.ph_lo, hi = args.ph_hi;
    XcdBarrier bar; bar.bar = (unsigned*)(F.ctl + CW_BAR); bar.x = 0; bar.st = nullptr;
    if (hi - lo > 1) bar = xcd_barrier_post((unsigned*)(F.ctl + CW_BAR), F.MISC + 8);
#ifndef PH_MASK
#define PH_MASK 0x7ff
#endif
#define IN(k) (((PH_MASK >> (k)) & 1) && lo <= (k) && (k) < hi)
#define SEAM(k) do { if (IN(k) && IN((k) + 1)) xcd_barrier(bar); } while (0)
    unsigned char* ws = args.ws;
    if (IN(0)) { p0_prologue(F, args); SEAM(0); }
    if (IN(1)) {
        P1Order S{F.G, F.c, (const char*)ws};
        EpiP1 E{ws};
        pg8::gemm_phase<EpiP1, P1Order>(F.lds + RING_OFF, F.lds + LDS_G_OFF, D, S, E);
        SEAM(1);
    }
    if (IN(2)) {
        for (int ch = F.c; ch < BATCH * 4; ch += F.G) p2_mlstm_chain_simple(F, args, ch);
        for (int u = (F.c + F.G - (128 % F.G)) % F.G; u < BATCH * 16 * 4; u += F.G) p2_gmlp_unit_simple(F, args, u);
        SEAM(2);
    }
    if (IN(3)) {
        PlainOrder S{F.G, F.c, T / 256, 4, (const char*)(ws + WS_R2), (const char*)(ws + WS_WOUT)};
        EpiResid<true> E{(const void*)args.in[0], (bf16*)(ws + WS_R1), (float*)(ws + WS_SSQ1)};
        pg8::gemm_phase<EpiResid<true>, PlainOrder>(F.lds + RING_OFF, F.lds + LDS_G_OFF, D, S, E);
        SEAM(3);
    }
    if (IN(4)) {
        PlainOrder S{F.G, F.c, T / 256, 4, (const char*)(ws + WS_R1), (const char*)(ws + WS_WQ)};
        EpiQ E{(bf16*)(ws + WS_R2), (const float*)(ws + WS_SSQ1)};
        pg8::gemm_phase<EpiQ, PlainOrder>(F.lds + RING_OFF, F.lds + LDS_G_OFF, D, S, E);
        SEAM(4);
    }
    if (IN(5)) {
        for (int u = F.c; u < BATCH * 4 * 32; u += F.G) p5_attn_unit_simple(F, u);
        SEAM(5);
    }
    if (IN(6)) {
        PlainOrder S{F.G, F.c, T / 256, 4, (const char*)(ws + WS_R3), (const char*)(ws + WS_WXO)};
        EpiResid<false> E{(const void*)(ws + WS_R1), (bf16*)(ws + WS_R2), (float*)(ws + WS_SSQ2)};
        pg8::gemm_phase<EpiResid<false>, PlainOrder>(F.lds + RING_OFF, F.lds + LDS_G_OFF, D, S, E);
        SEAM(6);
    }
    if (IN(7)) { p7_router(F, args); SEAM(7); }
    if (IN(8)) {
        LAS int *tpre, *cnts; const int NT = moe_tables(F, tpre, cnts);
        MoeOrder<true, 8> S{F.G, F.c, NT, tpre, cnts, (const char*)(ws + WS_R2), nullptr, (const char*)(ws + WS_WGU), (const int*)(ws + WS_LPID)};
        EpiG1 E{(bf16*)args.out, (bf16*)(ws + WS_H2), (const int*)(ws + WS_LPID), (const float*)(ws + WS_RR2), args.in[20], args.in[22], tpre, cnts};
        pg8::gemm_phase<EpiG1, MoeOrder<true, 8>>(F.lds + RING_OFF, F.lds + LDS_G_OFF, D, S, E);
        SEAM(8);
    }
    if (IN(9)) {
        LAS int *tpre, *cnts; const int NT = moe_tables(F, tpre, cnts);
        MoeOrder<false, 4> S{F.G, F.c, NT, tpre, cnts, (const char*)args.out, (const char*)(ws + WS_H2), (const char*)(ws + WS_WD), nullptr};
        EpiG2 E{(bf16*)(ws + WS_Y), (const int*)(ws + WS_LPID), (const float*)(ws + WS_LW), args.in[24], tpre, cnts};
        pg8::gemm_phase<EpiG2, MoeOrder<false, 4>>(F.lds + RING_OFF, F.lds + LDS_G_OFF, FF, S, E);
        SEAM(9);
    }
    if (IN(10)) p10_final(F, args);
#undef IN
#undef SEAM
}

extern "C" void kernel_launch(void* const* d_in, const int* in_sizes, int n_in, void* d_out, int out_size, void* d_ws, size_t ws_size, hipStream_t stream) {
    static int grid = 0;
    if (grid == 0) {
        if (n_in != 26 || in_sizes[0] != T * D || out_size != T * D || ws_size < WS_END) { fprintf(stderr, "kernel_launch: unexpected shapes (n_in %d, in0 %d, out %d, ws %zu)\n", n_in, n_in > 0 ? in_sizes[0] : -1, out_size, ws_size); grid = -1; return; }
        int dev = 0, cus = 0, per_cu = 0;
        if (hipGetDevice(&dev) != hipSuccess || hipDeviceGetAttribute(&cus, hipDeviceAttributeMultiprocessorCount, dev) != hipSuccess) { grid = -1; return; }
        if (hipFuncSetAttribute((const void*)fwd_kernel, hipFuncAttributeMaxDynamicSharedMemorySize, LDS_BYTES) != hipSuccess) { fprintf(stderr, "kernel_launch: hipFuncSetAttribute failed\n"); grid = -1; return; }
        if (hipOccupancyMaxActiveBlocksPerMultiprocessor(&per_cu, (const void*)fwd_kernel, NTHREADS, LDS_BYTES) != hipSuccess || per_cu < 1) { fprintf(stderr, "kernel_launch: occupancy query says %d\n", per_cu); }
        (void)hipGetLastError();
        grid = cus;
    }
    if (grid < 0) return;
    (void)hipMemsetAsync((char*)d_ws + WS_CTL, 0, CTL_ZERO_BYTES, stream);
    Args a{};
    for (int i = 0; i < 26; ++i) a.in[i] = (const float*)d_in[i];
    a.out = (float*)d_out; a.ws = (unsigned char*)d_ws;
#if MK_PER_PHASE
    for (int ph = 0; ph < NPHASES; ++ph) { a.ph_lo = ph; a.ph_hi = ph + 1; hipLaunchKernelGGL(fwd_kernel, dim3(grid), dim3(NTHREADS), LDS_BYTES, stream, a); }
#else
    a.ph_lo = 0; a.ph_hi = NPHASES; hipLaunchKernelGGL(fwd_kernel, dim3(grid), dim3(NTHREADS), LDS_BYTES, stream, a);
#endif
}
```

```cpp
#include <hip/hip_runtime.h>
#include <cstdio>
#include <cstdint>

#ifndef MK_PER_PHASE
#define MK_PER_PHASE 0
#endif

#define GAS __attribute__((address_space(1)))
#define LAS __attribute__((address_space(3)))
typedef unsigned short bf16;
typedef short bf16x8 __attribute__((ext_vector_type(8)));
typedef float f32x4 __attribute__((ext_vector_type(4)));
typedef float f32x2 __attribute__((ext_vector_type(2)));
typedef unsigned u32x4 __attribute__((ext_vector_type(4)));
typedef unsigned u32x2 __attribute__((ext_vector_type(2)));

constexpr int BATCH = 32, SEQ = 2048, T = BATCH * SEQ, D = 1024;
constexpr int MEMLEN = 256, TM = BATCH * MEMLEN;
constexpr int NP = 2560, INW = 2568;
constexpr int NE = 32, TOPK = 4, FF = 1024, NPAIR = T * TOPK;
constexpr int MAXTILES = NPAIR / 256 + NE;
constexpr int LISTCAP = 65536;
constexpr float EPS = 1e-6f;
constexpr int NWAVES = 8, NTHREADS = 512;

constexpr size_t MiB = 1u << 20;
constexpr size_t WS_CTL = 0, CTL_ZERO_BYTES = 1 * MiB;
constexpr size_t WS_WIN = 1 * MiB;
constexpr size_t WS_WOUT = 6 * MiB;
constexpr size_t WS_WQ = 8 * MiB;
constexpr size_t WS_WKV = 10 * MiB;
constexpr size_t WS_WXO = 14 * MiB;
constexpr size_t WS_WD = 16 * MiB;
constexpr size_t WS_R2 = 80 * MiB;
constexpr size_t WS_WGU = 208 * MiB;
constexpr size_t WS_R1 = 336 * MiB;
constexpr size_t WS_R3 = 464 * MiB;
constexpr size_t WS_KM = 592 * MiB;
constexpr size_t WS_VT = 608 * MiB;
constexpr size_t WS_PROJ = 624 * MiB;
constexpr size_t WS_Y = 208 * MiB;
constexpr size_t WS_H2 = 720 * MiB;
constexpr size_t WS_MISC = 992 * MiB;
constexpr size_t WS_GATES = WS_MISC;
constexpr size_t WS_SSQ1 = WS_MISC + 2 * MiB;
constexpr size_t WS_SSQ2 = WS_MISC + 6 * MiB;
constexpr size_t WS_RR2 = WS_MISC + 10 * MiB;
constexpr size_t WS_WR = WS_MISC + 11 * MiB;
constexpr size_t WS_LPID = WS_MISC + 12 * MiB;
constexpr size_t WS_LW = WS_MISC + 20 * MiB;
constexpr size_t WS_END = 1024 * MiB;
static_assert(WS_LW + 8 * MiB <= WS_END && WS_H2 + (size_t)(MAXTILES - 512) * 256 * 1024 * 2 <= WS_MISC && WS_Y + (size_t)NPAIR * 1024 * 2 <= WS_H2, "ws map");
static_assert(WS_PROJ + (size_t)T * NP * 2 <= WS_MISC, "ws map 2");
constexpr int CW_TMO = 0, CW_CODE = 1, CW_CNT = 1024  , CW_BAR = 4096;

constexpr int RING_OFF = 0, RING_BYTES = 131072;
constexpr int LDSCTL_OFF = RING_BYTES, MISC_OFF = LDSCTL_OFF + 320;
constexpr int LDS_X_OFF = LDSCTL_OFF + 1024;
constexpr int LDS_G_OFF = LDS_X_OFF + 1024;
constexpr int LDS_BYTES = 147456;

#define LDS_WAIT() asm volatile("s_waitcnt lgkmcnt(0)" ::: "memory")
#define VM_WAIT() asm volatile("s_waitcnt vmcnt(0)" ::: "memory")
typedef GAS unsigned gu32;
#define RLX_AGENT __ATOMIC_RELAXED, __HIP_MEMORY_SCOPE_AGENT

__device__ __forceinline__ unsigned f2bf(float f) { unsigned u = __builtin_bit_cast(unsigned, f); return (u + 0x7fffu + ((u >> 16) & 1u)) >> 16; }
__device__ __forceinline__ unsigned pk2(float lo, float hi) { return f2bf(lo) | (f2bf(hi) << 16); }
__device__ __forceinline__ float bf2f(unsigned b) { return __builtin_bit_cast(float, b << 16); }
__device__ __forceinline__ float bflo(unsigned w) { return __builtin_bit_cast(float, w << 16); }
__device__ __forceinline__ float bfhi(unsigned w) { return __builtin_bit_cast(float, w & 0xffff0000u); }
__device__ __forceinline__ unsigned cvt_pk_bf16(float lo, float hi) { unsigned r; asm volatile("v_cvt_pk_bf16_f32 %0, %1, %2" : "=v"(r) : "v"(lo), "v"(hi)); return r; }
__device__ __forceinline__ int opaque(int x) { asm volatile("" : "+v"(x)); return x; }
__device__ __forceinline__ float wave_sum(float v) {
#pragma unroll
    for (int o = 1; o < 64; o <<= 1) v += __shfl_xor(v, o);
    return v;
}
__device__ __forceinline__ float gelu_tanh(float x) {
    const float z = x * (1.0f + 0.044715f * x * x) * (-2.0f * 0.7978845608028654f * 1.4426950408889634f);
    return x * __builtin_amdgcn_rcpf(1.0f + __builtin_amdgcn_exp2f(z));
}
__device__ __forceinline__ float sigmoidf_fast(float x) { return __builtin_amdgcn_rcpf(1.0f + __builtin_amdgcn_exp2f(-1.4426950408889634f * x)); }

namespace pg8 {
constexpr int BM = 256, BK = 64, HALF = 128, HTB = HALF * BK * 2, STAGE_BYTES = 8 * HTB;
__host__ __device__ __forceinline__ int lds_byte(int r, int c) { const int st = (r >> 4) * 2 + (c >> 5), rr = r & 15, cc = c & 31, ob = rr * 64 + cc * 2; return st * 1024 + (ob ^ (((ob >> 9) & 1) << 5)); }
__host__ __device__ __forceinline__ void stage_rc(int b, int& R, int& C) { const int st = b / 1024, sb = b % 1024, swz = sb ^ (((sb >> 9) & 1) << 5); R = (st >> 1) * 16 + swz / 64; C = (st & 1) * 32 + (swz % 64) / 2; }
__host__ __device__ __forceinline__ int perm32(int rho) { const int n = rho >> 4, i = rho & 15; return 8 * (i >> 2) + 4 * n + (i & 3); }
struct Unit { int pm, pn, aux; };
__device__ __forceinline__ void tile_remap(int L, int nM, int nN, int& pm, int& pn) {
    const int nwg = nM * nN; int wgid = L;
    { const int q = nwg / 8, r = nwg % 8, xcd = wgid % 8, off = wgid / 8; wgid = (xcd < r ? xcd * (q + 1) : r * (q + 1) + (xcd - r) * q) + off; }
    const int nig = 8 * nN, gid = wgid / nig, fm = gid * 8, gsz = (nM - fm) < 8 ? (nM - fm) : 8;
    pm = fm + ((wgid % nig) % gsz); pn = (wgid % nig) / gsz;
}
template <class Epi, class Sched>
__device__ __forceinline__ void gemm_phase(LAS unsigned char* lds, LAS unsigned char* xlds, const int K, const Sched& S, const Epi& E) {
    int tid_ = threadIdx.x; asm volatile("" : "+v"(tid_));
    const int tid = tid_, wid = __builtin_amdgcn_readfirstlane(tid >> 6), lane = tid & 63, wr = wid >> 2, wc = wid & 3, fr = lane & 15, fq = lane >> 4;
    const int nt = K / BK;
    int Rr[2], Cc[2]; unsigned voffB[2];
#pragma unroll
    for (int i = 0; i < 2; ++i) { int R, C; stage_rc(tid * 16 + i * 8192, R, C); Rr[i] = R; Cc[i] = C; const int Rb = Epi::PERM ? ((R & ~31) + perm32(R & 31)) : R; voffB[i] = (unsigned)(Rb * K + C) * 2u; }
    const size_t kstep = (size_t)(BK * 2);
    const size_t hstep = (size_t)HALF * K * 2;
    const unsigned ldsw = (unsigned)wid * 1024u;
    const int aoff = lds_byte(wr * 64 + fr, fq * 8), boff = lds_byte(wc * 32 + fr, fq * 8);
#define PG8_SA(b, h) (((b) * 2 + (h)) * HTB)
#define PG8_SB(b, h) ((4 + (b) * 2 + (h)) * HTB)
#define PG8_STAGE(bufoff, gbase, voff) do { _Pragma("unroll") for (int _i = 0; _i < 2; ++_i) \
        __builtin_amdgcn_global_load_lds((const unsigned*)((const char*)(gbase) + (voff)[_i]), (LAS unsigned*)(lds + (bufoff) + ldsw + _i * 8192), 16, 0, 0); } while (0)
#define PG8_STAGEA(bufoff, gbase, o0, o1) do { \
        __builtin_amdgcn_global_load_lds((const unsigned*)((const char*)(gbase) + (o0)), (LAS unsigned*)(lds + (bufoff) + ldsw), 16, 0, 0); \
        __builtin_amdgcn_global_load_lds((const unsigned*)((const char*)(gbase) + (o1)), (LAS unsigned*)(lds + (bufoff) + ldsw + 8192), 16, 0, 0); } while (0)
#define PG8_LDA(dst, b, h) do { _Pragma("unroll") for (int m = 0; m < 4; ++m) _Pragma("unroll") for (int k = 0; k < 2; ++k) dst[m][k] = *(const LAS bf16x8*)(lds + PG8_SA(b, h) + aoff + m * 2048 + k * 1024); } while (0)
#define PG8_LDB(dst, b, h) do { _Pragma("unroll") for (int n = 0; n < 2; ++n) _Pragma("unroll") for (int k = 0; k < 2; ++k) dst[n][k] = *(const LAS bf16x8*)(lds + PG8_SB(b, h) + boff + n * 2048 + k * 1024); } while (0)
#define PG8_MMA(ai, bj, At, Bt) do { __builtin_amdgcn_s_setprio(1); _Pragma("unroll") for (int m = 0; m < 4; ++m) _Pragma("unroll") for (int n = 0; n < 2; ++n) _Pragma("unroll") for (int k = 0; k < 2; ++k) \
        acc[ai][bj][m][n] = __builtin_amdgcn_mfma_f32_16x16x32_bf16(Bt[n][k], At[m][k], acc[ai][bj][m][n], 0, 0, 0); __builtin_amdgcn_s_setprio(0); } while (0)
#define PG8_WAIT_V(n) asm volatile("s_waitcnt vmcnt(" #n ")" ::: "memory")
#define PG8_WAIT_L(n) asm volatile("s_waitcnt lgkmcnt(" #n ")" ::: "memory")
#define PG8_BAR __builtin_amdgcn_s_barrier()
#define PG8_SCHED __builtin_amdgcn_sched_barrier(0)
    Unit cur, nxt; int ui = 0;
    if (!S.next(0, cur)) return;
    f32x4 acc[2][2][4][2];
    bf16x8 At[4][2], B0[2][2], B1[2][2];
    unsigned vA0, vA1, vA2, vA3;
    { unsigned v[4]; S.a_offsets(cur, Rr, Cc, K, v); vA0 = v[0]; vA1 = v[1]; vA2 = v[2]; vA3 = v[3]; }
    const char* cA = S.Abase(cur); const char* cB = S.Bbase(cur);
    bool has_next = S.next(1, nxt);
    const char* nA = cA; const char* nB = cB;
    LAS u32x4* nslot = (LAS u32x4*)(xlds) + tid;
    if (has_next) { nA = S.Abase(nxt); nB = S.Bbase(nxt); }
    if (Sched::GATHER) { unsigned v[4] = {vA0, vA1, vA2, vA3}; if (has_next) S.a_offsets(nxt, Rr, Cc, K, v); *nslot = (u32x4){v[0], v[1], v[2], v[3]}; }
#pragma unroll
    for (int a = 0; a < 2; ++a)
#pragma unroll
        for (int b = 0; b < 2; ++b)
#pragma unroll
            for (int m = 0; m < 4; ++m)
#pragma unroll
                for (int n = 0; n < 2; ++n) acc[a][b][m][n] = (f32x4){0.f, 0.f, 0.f, 0.f};
    PG8_STAGE(PG8_SB(0, 0), cB, voffB); PG8_STAGE(PG8_SB(0, 1), cB + hstep, voffB); PG8_STAGEA(PG8_SA(0, 0), cA, vA0, vA1); PG8_STAGEA(PG8_SA(0, 1), cA, vA2, vA3);
    if (wr == 1) PG8_BAR;
    PG8_WAIT_V(2); PG8_BAR;
    PG8_STAGE(PG8_SB(1, 0), cB + kstep, voffB); PG8_STAGEA(PG8_SA(1, 0), cA + kstep, vA0, vA1); PG8_STAGE(PG8_SB(1, 1), cB + hstep + kstep, voffB);
    PG8_WAIT_V(6); PG8_BAR;
    for (;;) {
        for (int t = 0; t < nt; t += 2) {
            const bool last = (t == nt - 2);
            const char* a1 = cA + (size_t)(t + 1) * kstep;
            const char* a2 = last ? nA : cA + (size_t)(t + 2) * kstep; const char* b2 = last ? nB : cB + (size_t)(t + 2) * kstep;
            const char* a3 = a2 + kstep; const char* b3 = b2 + kstep;
            PG8_LDB(B0, 0, 0); PG8_LDB(B1, 0, 1); PG8_SCHED; PG8_LDA(At, 0, 0); PG8_STAGEA(PG8_SA(1, 1), a1, vA2, vA3);
            if (Sched::GATHER) { if (last) { const u32x4 nv = *nslot; vA0 = nv.x; vA1 = nv.y; vA2 = nv.z; vA3 = nv.w; } }
            PG8_WAIT_V(8); PG8_WAIT_L(0); PG8_BAR; PG8_MMA(0, 0, At, B0); PG8_MMA(0, 1, At, B1); PG8_BAR; PG8_SCHED;
            PG8_LDA(At, 0, 1); PG8_STAGE(PG8_SB(0, 0), b2, voffB); PG8_STAGE(PG8_SB(0, 1), b2 + hstep, voffB); PG8_STAGEA(PG8_SA(0, 0), a2, vA0, vA1);
            PG8_WAIT_V(8); PG8_WAIT_L(0); PG8_BAR; PG8_MMA(1, 0, At, B0); PG8_MMA(1, 1, At, B1); PG8_BAR; PG8_SCHED;
            PG8_LDB(B0, 1, 0); PG8_LDB(B1, 1, 1); PG8_SCHED; PG8_LDA(At, 1, 0); PG8_STAGEA(PG8_SA(0, 1), a2, vA2, vA3);
            PG8_WAIT_V(8); PG8_WAIT_L(0); PG8_BAR; PG8_MMA(0, 0, At, B0); PG8_MMA(0, 1, At, B1); PG8_BAR; PG8_SCHED;
            PG8_LDA(At, 1, 1); PG8_STAGE(PG8_SB(1, 0), b3, voffB); PG8_STAGE(PG8_SB(1, 1), b3 + hstep, voffB); PG8_STAGEA(PG8_SA(1, 0), a3, vA0, vA1);
            PG8_WAIT_V(8); PG8_WAIT_L(0); PG8_BAR; PG8_MMA(1, 0, At, B0); PG8_MMA(1, 1, At, B1); PG8_BAR; PG8_SCHED;
        }
        if (wr == 0) PG8_BAR;
        { const int fr2 = opaque(fr), fq2 = opaque(fq); E(acc, cur, wr, wc, fr2, fq2); }
        if (!has_next) break;
        cur = nxt; cA = nA; cB = nB; ++ui;
        has_next = S.next(ui + 1, nxt);
        if (has_next) { nA = S.Abase(nxt); nB = S.Bbase(nxt); }
        if (Sched::GATHER) { unsigned v[4] = {vA0, vA1, vA2, vA3}; if (has_next) S.a_offsets(nxt, Rr, Cc, K, v); *nslot = (u32x4){v[0], v[1], v[2], v[3]}; asm volatile("" ::: "memory"); }
#pragma unroll
        for (int a = 0; a < 2; ++a)
#pragma unroll
            for (int b = 0; b < 2; ++b)
#pragma unroll
                for (int m = 0; m < 4; ++m)
#pragma unroll
                    for (int n = 0; n < 2; ++n) acc[a][b][m][n] = (f32x4){0.f, 0.f, 0.f, 0.f};
        if (wr == 1) PG8_BAR;
    }
    PG8_WAIT_V(0);
    PG8_BAR;
#undef PG8_SA
#undef PG8_SB
#undef PG8_STAGE
#undef PG8_STAGEA
#undef PG8_LDA
#undef PG8_LDB
#undef PG8_MMA
#undef PG8_WAIT_V
#undef PG8_WAIT_L
#undef PG8_BAR
#undef PG8_SCHED
}
}

#define XB_TMO      128
#define XB_XCNT(j)  (256  + 64 * (j))
#define XB_XSUB(j)  (1280 + 64 * (j))
#define XB_XGEN(j)  (2304 + 64 * (j))
#define XB_TOP      3328
#define XB_TOPGEN   3392
#define XCD_BAR_WORDS 3456
#define XB_SPIN_CAP (1u << 18)
__device__ __forceinline__ unsigned xb_ld(unsigned* p)              { return __hip_atomic_load(p, __ATOMIC_RELAXED, __HIP_MEMORY_SCOPE_AGENT); }
__device__ __forceinline__ unsigned xb_add(unsigned* p, unsigned v) { return __hip_atomic_fetch_add(p, v, __ATOMIC_RELAXED, __HIP_MEMORY_SCOPE_AGENT); }
__device__ __forceinline__ unsigned xb_xcc_id() { return (unsigned)__builtin_amdgcn_s_getreg((3 << 11) | 20) & 0xFu; }
#define XB_SPIN(cond, bar) do { unsigned _sp = 0; while (cond) { __builtin_amdgcn_s_sleep(1); \
    if ((++_sp & 255u) == 0u) { if (xb_ld(&(bar)[XB_TMO])) break; if (_sp > XB_SPIN_CAP) { atomicAdd(&(bar)[XB_TMO], 1u); break; } } } } while (0)
struct XcdBarrier { unsigned* bar; unsigned x; volatile LAS unsigned* st; };
__device__ __forceinline__ XcdBarrier xcd_barrier_post(unsigned* bar, volatile LAS unsigned* st) {
    XcdBarrier b; b.bar = bar; b.x = xb_xcc_id(); b.st = st;
    if (threadIdx.x == 0) (void)xb_add(&bar[XB_XCNT(b.x)], 1u);
    return b;
}
__device__ __forceinline__ void xcd_barrier_complete(unsigned* bar, unsigned x, unsigned& nloc, unsigned& nx) {
    const unsigned G = gridDim.x * gridDim.y * gridDim.z;
    unsigned sum, cnt, mine, sp = 0u;
    for (;;) {
        sum = 0u; cnt = 0u; mine = 0u;
#pragma unroll
        for (unsigned j = 0; j < 16; ++j) { const unsigned c = xb_ld(&bar[XB_XCNT(j)]); sum += c; cnt += (c > 0u) ? 1u : 0u; mine = (j == x) ? c : mine; }
        if (sum == G) break;
        __builtin_amdgcn_s_sleep(1);
        if ((++sp & 255u) == 0u) { if (xb_ld(&bar[XB_TMO])) break; if (sp > XB_SPIN_CAP) { atomicAdd(&bar[XB_TMO], 1u); break; } }
    }
    nloc = mine > 0u ? mine : 1u; nx = cnt > 0u ? cnt : 1u;
}
__device__ __forceinline__ void xcd_barrier(const XcdBarrier& b) {
    asm volatile("s_waitcnt vmcnt(0)" ::: "memory");
    __syncthreads();
    if (threadIdx.x == 0) {
        unsigned* bar = b.bar;
        __builtin_amdgcn_s_waitcnt(0);
        unsigned nloc = b.st[0], nx = b.st[1];
        if (nloc == 0u) { xcd_barrier_complete(bar, b.x, nloc, nx); b.st[0] = nloc; b.st[1] = nx; }
        const unsigned old = xb_add(&bar[XB_XSUB(b.x)], 1u);
        const unsigned gen = old / nloc;
        if (old + 1u == (gen + 1u) * nloc) {
            __builtin_amdgcn_fence(__ATOMIC_RELEASE, "agent");
            asm volatile("s_waitcnt vmcnt(0)" ::: "memory");
            const unsigned og = xb_add(&bar[XB_TOP], 1u);
            const unsigned tg = og / nx;
            if (og + 1u == (tg + 1u) * nx) xb_add(&bar[XB_TOPGEN], 1u);
            else XB_SPIN(xb_ld(&bar[XB_TOPGEN]) == tg, bar);
            __builtin_amdgcn_fence(__ATOMIC_ACQUIRE, "agent");
            xb_add(&bar[XB_XGEN(b.x)], 1u);
            asm volatile("s_waitcnt vmcnt(0)" ::: "memory");
        } else {
            XB_SPIN(xb_ld(&bar[XB_XGEN(b.x)]) == gen, bar);
            __builtin_amdgcn_fence(__ATOMIC_ACQUIRE, "agent");
            asm volatile("s_waitcnt vmcnt(0)" ::: "memory");
        }
    }
    __syncthreads();
}

struct Frame {
    LAS unsigned char* lds;
    volatile LAS unsigned* MISC;
    gu32* ctl;
    int tid, lane, wave, G, c;
    unsigned char* ws;
};
struct Args { const float* in[26]; float* out; unsigned char* ws; int ph_lo, ph_hi; };

__device__ __forceinline__ void p0_transpose_item(const float* W, int ldw, int csrc0, int k0, const float* gain, bf16* WT, int Kd, int drow0, LAS float* scr, int lane) {
#pragma unroll 8
    for (int i = 0; i < 32; ++i) { const int kk = 2 * i + (lane >> 5); float v = W[(size_t)(k0 + kk) * ldw + csrc0 + (lane & 31)]; if (gain) v *= gain[k0 + kk]; scr[kk * 33 + (lane & 31)] = v; }
    LDS_WAIT(); asm volatile("" ::: "memory");
    const int c = lane & 7;
#pragma unroll
    for (int j = 0; j < 4; ++j) { const int n = (lane >> 3) + 8 * j; const LAS float* s = scr + (8 * c) * 33 + n;
        u32x4 o; o.x = pk2(s[0 * 33], s[1 * 33]); o.y = pk2(s[2 * 33], s[3 * 33]); o.z = pk2(s[4 * 33], s[5 * 33]); o.w = pk2(s[6 * 33], s[7 * 33]);
        *(GAS u32x4*)(WT + (size_t)(drow0 + n) * Kd + k0 + 8 * c) = o; }
    LDS_WAIT(); asm volatile("" ::: "memory");
}

__device__ __forceinline__ void p0_prologue(Frame& F, const Args& A) {
    LAS float* scr = (LAS float*)(F.lds + RING_OFF + F.wave * 16384);
    const int gw = F.c * NWAVES + F.wave, NGW = F.G * NWAVES, lane = opaque(F.lane);
    unsigned char* ws = F.ws;
    constexpr int I_IN = 16 * (NP / 32), I_SQ = 16 * 32, I_KV = 16 * 64, I_EXP = 16 * 32;
    constexpr int NITEMS = I_IN + 3 * I_SQ + I_KV + 3 * NE * I_EXP;
    for (int it = gw; it < NITEMS; it += NGW) {
        int r = it;
        if (r < I_IN) { const int kb = r / (NP / 32), nb = r % (NP / 32), n0 = nb * 32; p0_transpose_item(A.in[3], INW, n0 + (n0 >= 1536 ? 8 : 0), kb * 64, nullptr, (bf16*)(ws + WS_WIN), D, n0, scr, lane); continue; } r -= I_IN;
        if (r < I_SQ) { p0_transpose_item(A.in[10], D, (r % 32) * 32, (r / 32) * 64, nullptr, (bf16*)(ws + WS_WOUT), D, (r % 32) * 32, scr, lane); continue; } r -= I_SQ;
        if (r < I_SQ) { p0_transpose_item(A.in[13], D, (r % 32) * 32, (r / 32) * 64, A.in[11], (bf16*)(ws + WS_WQ), D, (r % 32) * 32, scr, lane); continue; } r -= I_SQ;
        if (r < I_KV) { p0_transpose_item(A.in[14], 2 * D, (r % 64) * 32, (r / 64) * 64, nullptr, (bf16*)(ws + WS_WKV), D, (r % 64) * 32, scr, lane); continue; } r -= I_KV;
        if (r < I_SQ) { p0_transpose_item(A.in[15], D, (r % 32) * 32, (r / 32) * 64, nullptr, (bf16*)(ws + WS_WXO), D, (r % 32) * 32, scr, lane); continue; } r -= I_SQ;
        const int which = r / (NE * I_EXP); r -= which * (NE * I_EXP);
        const int e = r / I_EXP, q = r % I_EXP, kb = q / 32, nb = q % 32, n0 = nb * 32;
        if (which == 2) p0_transpose_item(A.in[23] + (size_t)e * FF * D, D, n0, kb * 64, nullptr, (bf16*)(ws + WS_WD), FF, e * D + n0, scr, lane);
        else { const int p = n0 >> 7, drow = e * 2048 + p * 256 + which * 128 + (n0 & 127);
               p0_transpose_item(A.in[which == 0 ? 19 : 21] + (size_t)e * D * FF, FF, n0, kb * 64, A.in[16], (bf16*)(ws + WS_WGU), D, drow, scr, lane); }
    }
    { const float* wr = A.in[17]; const float* gm = A.in[16]; float* o = (float*)(ws + WS_WR);
      for (int i = (F.c * NTHREADS + F.tid); i < D * NE; i += F.G * NTHREADS) o[i] = wr[i] * gm[i >> 5]; }
    __syncthreads();
    LAS float* wgs = (LAS float*)(F.lds + RING_OFF);
    for (int i = F.tid; i < 8 * D; i += NTHREADS) { const int k = i >> 3, j = i & 7; wgs[j * D + k] = A.in[3][(size_t)k * INW + 1536 + j]; }
    __syncthreads();
    {
        const float* x = A.in[0]; const float* gmix = A.in[2]; const float* bg = A.in[4];
        bf16* xn = (bf16*)(ws + WS_R1); float* gates = (float*)(ws + WS_GATES);
        f32x4 g[4];
#pragma unroll
        for (int j = 0; j < 4; ++j) g[j] = *(const f32x4*)(gmix + 4 * lane + 256 * j);
        for (int m = gw; m < T; m += NGW) {
            const GAS f32x4* xr = (const GAS f32x4*)(x + (size_t)m * D) + lane;
            f32x4 v[4]; float s = 0.f;
#pragma unroll
            for (int j = 0; j < 4; ++j) { v[j] = xr[64 * j]; s += (v[j].x * v[j].x + v[j].y * v[j].y) + (v[j].z * v[j].z + v[j].w * v[j].w); }
            const float r = rsqrtf(wave_sum(s) * (1.f / D) + EPS);
#pragma unroll
            for (int j = 0; j < 4; ++j) v[j] = v[j] * r * g[j];
            GAS unsigned long long* o8 = (GAS unsigned long long*)(xn + (size_t)m * D) + lane;
#pragma unroll
            for (int j = 0; j < 4; ++j) o8[64 * j] = (unsigned long long)pk2(v[j].x, v[j].y) | ((unsigned long long)pk2(v[j].z, v[j].w) << 32);
            float gs[8];
#pragma unroll
            for (int jg = 0; jg < 8; ++jg) { float a = 0.f;
#pragma unroll
                for (int j = 0; j < 4; ++j) { const f32x4 w = *(const LAS f32x4*)(wgs + jg * D + 4 * lane + 256 * j); a += (v[j].x * w.x + v[j].y * w.y) + (v[j].z * w.z + v[j].w * w.w); }
                gs[jg] = wave_sum(a); }
            if (lane < 8) { float pre = 0.f;
#pragma unroll
                for (int jg = 0; jg < 8; ++jg) pre = (lane == jg) ? gs[jg] : pre;
                pre += bg[lane];
                const float sc = 15.0f * tanhf(pre * (1.0f / 15.0f));
                float o = sc;
                if (lane >= 4) o = -log1pf(expf(-sc));
                gates[(size_t)m * 8 + lane] = o; }
        }
    }
    {
        const float* x = A.in[1]; const float* gmem = A.in[12]; bf16* mn = (bf16*)(ws + WS_R3);
        f32x4 g[4];
#pragma unroll
        for (int j = 0; j < 4; ++j) g[j] = *(const f32x4*)(gmem + 4 * lane + 256 * j);
        for (int m = gw; m < TM; m += NGW) {
            const GAS f32x4* xr = (const GAS f32x4*)(x + (size_t)m * D) + lane;
            f32x4 v[4]; float s = 0.f;
#pragma unroll
            for (int j = 0; j < 4; ++j) { v[j] = xr[64 * j]; s += (v[j].x * v[j].x + v[j].y * v[j].y) + (v[j].z * v[j].z + v[j].w * v[j].w); }
            const float r = rsqrtf(wave_sum(s) * (1.f / D) + EPS);
#pragma unroll
            for (int j = 0; j < 4; ++j) v[j] = v[j] * r * g[j];
            GAS unsigned long long* o8 = (GAS unsigned long long*)(mn + (size_t)m * D) + lane;
#pragma unroll
            for (int j = 0; j < 4; ++j) o8[64 * j] = (unsigned long long)pk2(v[j].x, v[j].y) | ((unsigned long long)pk2(v[j].z, v[j].w) << 32);
        }
    }
}

constexpr size_t TS1K = (size_t)256 * 1024 * 2;
struct P1Order {
    static constexpr bool GATHER = false;
    int G, c; const char* ws;
    __device__ __forceinline__ bool next(int i, pg8::Unit& u) const {
        const int L = i * G + c; if (L >= 2816) return false;
        if (L < 2560) { pg8::tile_remap(L, 256, 10, u.pm, u.pn); u.aux = 0; }
        else { const int Lp = L - 2560; if (Lp < 128) { u.aux = 1; u.pm = Lp >> 2; u.pn = Lp & 3; } else { const int Lq = Lp - 128; u.aux = 2; u.pm = Lq & 3; u.pn = Lq >> 2; } }
        return true;
    }
    __device__ __forceinline__ const char* Abase(const pg8::Unit& u) const { size_t o = WS_R1; if (u.aux == 1) o = WS_R3; if (u.aux == 2) o = WS_WKV + 4 * TS1K; return ws + o + (size_t)u.pm * TS1K; }
    __device__ __forceinline__ const char* Bbase(const pg8::Unit& u) const { size_t o = WS_WIN; if (u.aux == 1) o = WS_WKV; if (u.aux == 2) o = WS_R3; return ws + o + (size_t)u.pn * TS1K; }
    __device__ __forceinline__ void a_offsets(const pg8::Unit&, const int (&R)[2], const int (&C)[2], int K, unsigned (&v)[4]) const {
#pragma unroll
        for (int h = 0; h < 2; ++h)
#pragma unroll
            for (int i = 0; i < 2; ++i) v[h * 2 + i] = (unsigned)((h * 128 + R[i]) * K + C[i]) * 2u; }
};
struct PlainOrder {
    static constexpr bool GATHER = false;
    int G, c, nM, nN; const char *A, *Bt;
    __device__ __forceinline__ bool next(int i, pg8::Unit& u) const { const int L = i * G + c; if (L >= nM * nN) return false; pg8::tile_remap(L, nM, nN, u.pm, u.pn); u.aux = 0; return true; }
    __device__ __forceinline__ const char* Abase(const pg8::Unit& u) const { return A + (size_t)u.pm * TS1K; }
    __device__ __forceinline__ const char* Bbase(const pg8::Unit& u) const { return Bt + (size_t)u.pn * TS1K; }
    __device__ __forceinline__ void a_offsets(const pg8::Unit&, const int (&R)[2], const int (&C)[2], int K, unsigned (&v)[4]) const {
#pragma unroll
        for (int h = 0; h < 2; ++h)
#pragma unroll
            for (int i = 0; i < 2; ++i) v[h * 2 + i] = (unsigned)((h * 128 + R[i]) * K + C[i]) * 2u; }
};
template <bool GATH, int NN>
struct MoeOrder {
    static constexpr bool GATHER = GATH;
    int G, c, NT; const LAS int* tpre; const LAS int* cnts; const char* A; const char* A2; const char* Bt; const int* lpid;
    __device__ __forceinline__ bool next(int i, pg8::Unit& u) const {
        const int L = i * G + c; if (L >= NT * NN) return false; pg8::tile_remap(L, NT, NN, u.pm, u.pn);
        int e = 0;
#pragma unroll 1
        for (int j = 1; j < NE; ++j) e += (tpre[j] <= u.pm) ? 1 : 0;
        u.aux = __builtin_amdgcn_readfirstlane(e); return true; }
    __device__ __forceinline__ const char* Abase(const pg8::Unit& u) const { if (GATH) return A; return u.pm < 512 ? A + (size_t)u.pm * TS1K : A2 + (size_t)(u.pm - 512) * TS1K; }
    __device__ __forceinline__ const char* Bbase(const pg8::Unit& u) const { return Bt + (size_t)(u.aux * NN + u.pn) * TS1K; }
    __device__ __forceinline__ void a_offsets(const pg8::Unit& u, const int (&R)[2], const int (&C)[2], int K, unsigned (&v)[4]) const {
        if (GATH) { const int base = (u.pm - tpre[u.aux]) * 256, cnt = cnts[u.aux];
#pragma unroll
            for (int h = 0; h < 2; ++h)
#pragma unroll
                for (int i = 0; i < 2; ++i) { const int pos = base + h * 128 + R[i]; int pid = 0; if (pos < cnt) pid = lpid[(size_t)u.aux * LISTCAP + pos]; v[h * 2 + i] = (unsigned)((pid >> 2) * K + C[i]) * 2u; }
        } else {
#pragma unroll
            for (int h = 0; h < 2; ++h)
#pragma unroll
                for (int i = 0; i < 2; ++i) v[h * 2 + i] = (unsigned)((h * 128 + R[i]) * K + C[i]) * 2u; } }
};

struct EpiP1 {
    static constexpr bool PERM = true;
    unsigned char* ws;
    __device__ __forceinline__ void operator()(const f32x4 (&acc)[2][2][4][2], const pg8::Unit& u, int wr, int wc, int fr, int fq) const {
        const int row0 = u.pm * 256 + wr * 64 + fr, col0 = u.pn * 256 + wc * 32 + 8 * fq;
        size_t bo = WS_PROJ; int ld = NP; if (u.aux == 1) { bo = WS_KM; ld = D; } if (u.aux == 2) { bo = WS_VT; ld = TM; }
        bf16* base = (bf16*)(ws + bo);
        const bool act = (u.aux == 0 && u.pn >= 6);
#pragma unroll
        for (int ai = 0; ai < 2; ++ai)
#pragma unroll
            for (int m = 0; m < 4; ++m) { bf16* rowp = base + (size_t)(row0 + ai * 128 + m * 16) * ld + col0;
#pragma unroll
                for (int bj = 0; bj < 2; ++bj) { f32x4 v0 = acc[ai][bj][m][0], v1 = acc[ai][bj][m][1];
                    if (act) {
#pragma unroll
                        for (int j = 0; j < 4; ++j) { v0[j] = gelu_tanh(v0[j]); v1[j] = gelu_tanh(v1[j]); } }
                    u32x4 w; w.x = cvt_pk_bf16(v0[0], v0[1]); w.y = cvt_pk_bf16(v0[2], v0[3]); w.z = cvt_pk_bf16(v1[0], v1[1]); w.w = cvt_pk_bf16(v1[2], v1[3]);
                    *(u32x4*)(rowp + bj * 128) = w; } }
    }
};
template <bool BASE_F32> struct EpiResid {
    static constexpr bool PERM = true;
    const void* base; bf16* out; float* ssq;
    __device__ __forceinline__ void operator()(const f32x4 (&acc)[2][2][4][2], const pg8::Unit& u, int wr, int wc, int fr, int fq) const {
        const int row0 = u.pm * 256 + wr * 64 + fr, col0 = u.pn * 256 + wc * 32 + 8 * fq;
#pragma unroll
        for (int ai = 0; ai < 2; ++ai)
#pragma unroll
            for (int m = 0; m < 4; ++m) { const int row = row0 + ai * 128 + m * 16; float ss = 0.f;
#pragma unroll
                for (int bj = 0; bj < 2; ++bj) { const size_t off = (size_t)row * D + col0 + bj * 128; f32x4 b0, b1;
                    if (BASE_F32) { b0 = *(const f32x4*)((const float*)base + off); b1 = *(const f32x4*)((const float*)base + off + 4); }
                    else { const u32x4 w = *(const u32x4*)((const bf16*)base + off); b0 = (f32x4){bflo(w.x), bfhi(w.x), bflo(w.y), bfhi(w.y)}; b1 = (f32x4){bflo(w.z), bfhi(w.z), bflo(w.w), bfhi(w.w)}; }
                    const f32x4 v0 = acc[ai][bj][m][0] + b0, v1 = acc[ai][bj][m][1] + b1;
                    ss += (v0[0] * v0[0] + v0[1] * v0[1]) + (v0[2] * v0[2] + v0[3] * v0[3]) + (v1[0] * v1[0] + v1[1] * v1[1]) + (v1[2] * v1[2] + v1[3] * v1[3]);
                    u32x4 w; w.x = cvt_pk_bf16(v0[0], v0[1]); w.y = cvt_pk_bf16(v0[2], v0[3]); w.z = cvt_pk_bf16(v1[0], v1[1]); w.w = cvt_pk_bf16(v1[2], v1[3]);
                    *(u32x4*)(out + off) = w; }
                ss += __shfl_xor(ss, 16); ss += __shfl_xor(ss, 32);
                if (fq == 0) ssq[(size_t)row * 16 + u.pn * 4 + wc] = ss; }
    }
};
__device__ __forceinline__ float row_rms_from_ssq(const float* ssq, int row) {
    const f32x4* p = (const f32x4*)(ssq + (size_t)row * 16); const f32x4 a = p[0], b = p[1], c = p[2], d = p[3];
    const float s = (((a[0] + a[1]) + (a[2] + a[3])) + ((b[0] + b[1]) + (b[2] + b[3]))) + (((c[0] + c[1]) + (c[2] + c[3])) + ((d[0] + d[1]) + (d[2] + d[3])));
    return rsqrtf(s * (1.0f / D) + EPS);
}
struct EpiQ {
    static constexpr bool PERM = true;
    bf16* out; const float* ssq;
    __device__ __forceinline__ void operator()(const f32x4 (&acc)[2][2][4][2], const pg8::Unit& u, int wr, int wc, int fr, int fq) const {
        const int row0 = u.pm * 256 + wr * 64 + fr, col0 = u.pn * 256 + wc * 32 + 8 * fq;
#pragma unroll
        for (int ai = 0; ai < 2; ++ai)
#pragma unroll
            for (int m = 0; m < 4; ++m) { const int row = row0 + ai * 128 + m * 16; const float r = row_rms_from_ssq(ssq, row) * (1.0f / 16.0f);
#pragma unroll
                for (int bj = 0; bj < 2; ++bj) { const f32x4 v0 = acc[ai][bj][m][0] * r, v1 = acc[ai][bj][m][1] * r;
                    u32x4 w; w.x = cvt_pk_bf16(v0[0], v0[1]); w.y = cvt_pk_bf16(v0[2], v0[3]); w.z = cvt_pk_bf16(v1[0], v1[1]); w.w = cvt_pk_bf16(v1[2], v1[3]);
                    *(u32x4*)(out + (size_t)row * D + col0 + bj * 128) = w; } }
    }
};
struct EpiG1 {
    static constexpr bool PERM = true;
    bf16* H1; bf16* H2; const int* lpid; const float* rr2; const float* bgate; const float* bup; const LAS int* tpre; const LAS int* cnts;
    __device__ __forceinline__ void operator()(const f32x4 (&acc)[2][2][4][2], const pg8::Unit& u, int wr, int wc, int fr, int fq) const {
        const int e = u.aux, base = (u.pm - tpre[e]) * 256, cnt = cnts[e];
        bf16* Ht = u.pm < 512 ? H1 + (size_t)u.pm * 256 * 1024 : H2 + (size_t)(u.pm - 512) * 256 * 1024;
        const int hc = u.pn * 128 + wc * 32 + 8 * fq;
        const f32x4 bg0 = *(const f32x4*)(bgate + e * FF + hc), bg1 = *(const f32x4*)(bgate + e * FF + hc + 4);
        const f32x4 bu0 = *(const f32x4*)(bup + e * FF + hc), bu1 = *(const f32x4*)(bup + e * FF + hc + 4);
#pragma unroll
        for (int ai = 0; ai < 2; ++ai)
#pragma unroll
            for (int m = 0; m < 4; ++m) { const int rl = ai * 128 + wr * 64 + m * 16 + fr; const int pos = base + rl; int pid = 0; if (pos < cnt) pid = lpid[(size_t)e * LISTCAP + pos];
                const float r = rr2[pid >> 2];
                f32x4 g0 = acc[ai][0][m][0] * r + bg0, g1 = acc[ai][0][m][1] * r + bg1, u0 = acc[ai][1][m][0] * r + bu0, u1 = acc[ai][1][m][1] * r + bu1;
                float h[8];
#pragma unroll
                for (int j = 0; j < 4; ++j) { float g = fminf(g0[j], 7.0f), uu = fminf(fmaxf(u0[j], -7.0f), 7.0f); h[j] = (uu + 1.0f) * g * sigmoidf_fast(1.702f * g);
                    g = fminf(g1[j], 7.0f); uu = fminf(fmaxf(u1[j], -7.0f), 7.0f); h[4 + j] = (uu + 1.0f) * g * sigmoidf_fast(1.702f * g); }
                u32x4 w; w.x = cvt_pk_bf16(h[0], h[1]); w.y = cvt_pk_bf16(h[2], h[3]); w.z = cvt_pk_bf16(h[4], h[5]); w.w = cvt_pk_bf16(h[6], h[7]);
                *(u32x4*)(Ht + (size_t)rl * FF + hc) = w; }
    }
};
struct EpiG2 {
    static constexpr bool PERM = true;
    bf16* Y; const int* lpid; const float* lw; const float* bdown; const LAS int* tpre; const LAS int* cnts;
    __device__ __forceinline__ void operator()(const f32x4 (&acc)[2][2][4][2], const pg8::Unit& u, int wr, int wc, int fr, int fq) const {
        const int e = u.aux, base = (u.pm - tpre[e]) * 256, cnt = cnts[e];
        const int col0 = u.pn * 256 + wc * 32 + 8 * fq;
        f32x4 bd[2][2];
#pragma unroll
        for (int bj = 0; bj < 2; ++bj) { bd[bj][0] = *(const f32x4*)(bdown + e * D + col0 + bj * 128); bd[bj][1] = *(const f32x4*)(bdown + e * D + col0 + bj * 128 + 4); }
#pragma unroll
        for (int ai = 0; ai < 2; ++ai)
#pragma unroll
            for (int m = 0; m < 4; ++m) { const int rl = ai * 128 + wr * 64 + m * 16 + fr; const int pos = base + rl;
                if (pos < cnt) { const int pid = lpid[(size_t)e * LISTCAP + pos]; const float w8 = lw[(size_t)e * LISTCAP + pos];
#pragma unroll
                    for (int bj = 0; bj < 2; ++bj) { const f32x4 v0 = (acc[ai][bj][m][0] + bd[bj][0]) * w8, v1 = (acc[ai][bj][m][1] + bd[bj][1]) * w8;
                        u32x4 w; w.x = cvt_pk_bf16(v0[0], v0[1]); w.y = cvt_pk_bf16(v0[2], v0[3]); w.z = cvt_pk_bf16(v1[0], v1[1]); w.w = cvt_pk_bf16(v1[2], v1[3]);
                        *(u32x4*)(Y + (size_t)pid * D + col0 + bj * 128) = w; } } }
    }
};


__device__ __forceinline__ void ld16_to_lds(LAS bf16* dst, const bf16* src) { *(LAS u32x4*)dst = *(const GAS u32x4*)src; }

__device__ __forceinline__ void p2_mlstm_chain_simple(Frame& F, const Args& A, int ch) {
    const int b = ch >> 2, h = ch & 3, tid = F.tid, t = tid >> 2, p = tid & 3;
    const bf16* proj = (const bf16*)(F.ws + WS_PROJ); const float* gates = (const float*)(F.ws + WS_GATES); bf16* ycat = (bf16*)(F.ws + WS_R2);
    const float* ghead = A.in[5];
    LAS bf16* qs = (LAS bf16*)(F.lds + 0); LAS bf16* ks = (LAS bf16*)(F.lds + 16384); LAS bf16* vs = (LAS bf16*)(F.lds + 32768);
    LAS float* Cs = (LAS float*)(F.lds + 65536); LAS float* ns = (LAS float*)(F.lds + 98304);
    LAS float* ibs = ns + 64; LAS float* fbs = ibs + 128; LAS float* As = fbs + 128; LAS float* Mts = As + 128; LAS float* bcs = Mts + 128; LAS float* wks = bcs + 128; LAS float* scal = wks + 128;
    for (int i = tid; i < 128 * 64; i += NTHREADS) Cs[i] = 0.f;
    if (tid < 64) ns[tid] = 0.f;
    float mstate = 0.f;
    for (int c = 0; c < 16; ++c) {
        const int tg0 = b * SEQ + c * 128;
        __syncthreads();
#pragma unroll
        for (int j = 0; j < 2; ++j) { const int i = tid + 512 * j, row = i >> 3, part = i & 7; const bf16* src = proj + (size_t)(tg0 + row) * NP + h * 64 + part * 8;
            ld16_to_lds(qs + row * 64 + part * 8, src); ld16_to_lds(ks + row * 64 + part * 8, src + 256); }
#pragma unroll
        for (int j = 0; j < 4; ++j) { const int i = tid + 512 * j, row = i >> 4, part = i & 15; ld16_to_lds(vs + row * 128 + part * 8, proj + (size_t)(tg0 + row) * NP + 512 + h * 128 + part * 8); }
        if (tid < 128) { ibs[tid] = gates[(size_t)(tg0 + tid) * 8 + h]; fbs[tid] = gates[(size_t)(tg0 + tid) * 8 + 4 + h]; }
        __syncthreads();
        if (tid == 0) { float bs = 0.f, pm = -3.0e38f;
            for (int s = 0; s < 128; ++s) { bs += fbs[s]; bcs[s] = bs; const float a = ibs[s] - bs; As[s] = a; pm = fmaxf(pm, a); Mts[s] = fmaxf(mstate, pm); }
            scal[0] = fmaxf(mstate, pm); scal[1] = bs; }
        __syncthreads();
        const float Mnew = scal[0], bL = scal[1];
        if (tid < 128) wks[tid] = expf(As[tid] - Mnew);
        {
            const float Mt = Mts[t];
            float qd[16];
#pragma unroll
            for (int j = 0; j < 16; ++j) qd[j] = bf2f(qs[t * 64 + 16 * p + j]) * 0.125f;
            float acc[32]; float den = 0.f;
#pragma unroll
            for (int j = 0; j < 32; ++j) acc[j] = 0.f;
            for (int s = 0; s <= t; ++s) {
                float dot = 0.f;
#pragma unroll
                for (int j = 0; j < 16; ++j) dot += qd[j] * bf2f(ks[s * 64 + 16 * p + j]);
                dot += __shfl_xor(dot, 1); dot += __shfl_xor(dot, 2);
                const float val = dot * expf(As[s] - Mt);
                den += val;
#pragma unroll
                for (int j = 0; j < 32; ++j) acc[j] += val * bf2f(vs[s * 128 + 32 * p + j]);
            }
            const float winter = expf(mstate - Mt);
            float acc2[32]; float nq = 0.f;
#pragma unroll
            for (int j = 0; j < 32; ++j) acc2[j] = 0.f;
            for (int d = 0; d < 64; d += 4) {
                float q4[4];
#pragma unroll
                for (int e = 0; e < 4; ++e) q4[e] = bf2f(qs[t * 64 + d + e]) * 0.125f;
#pragma unroll
                for (int j = 0; j < 32; ++j) { const f32x4 c4 = *(const LAS f32x4*)(Cs + (32 * p + j) * 64 + d); acc2[j] += (c4[0] * q4[0] + c4[1] * q4[1]) + (c4[2] * q4[2] + c4[3] * q4[3]); }
                const f32x4 n4 = *(const LAS f32x4*)(ns + d); nq += (n4[0] * q4[0] + n4[1] * q4[1]) + (n4[2] * q4[2] + n4[3] * q4[3]);
            }
            den += winter * nq;
            const float dn = fmaxf(fabsf(den), expf(-(bcs[t] + Mt)));
            const float inv = 1.0f / dn; float ss = 0.f;
#pragma unroll
            for (int j = 0; j < 32; ++j) { acc[j] = (acc[j] + winter * acc2[j]) * inv; ss += acc[j] * acc[j]; }
            ss += __shfl_xor(ss, 1); ss += __shfl_xor(ss, 2);
            const float r = rsqrtf(ss * (1.0f / 128.0f) + EPS);
            const bf16* og = proj + (size_t)(tg0 + t) * NP + 1024 + h * 128 + 32 * p; bf16* yo = ycat + (size_t)(tg0 + t) * D + h * 128 + 32 * p; const float* gh = ghead + h * 128 + 32 * p;
#pragma unroll
            for (int j8 = 0; j8 < 4; ++j8) { const u32x4 ow = *(const GAS u32x4*)(og + j8 * 8); const unsigned oww[4] = {ow.x, ow.y, ow.z, ow.w}; unsigned res[4];
#pragma unroll
                for (int e = 0; e < 4; ++e) { const int j = j8 * 8 + 2 * e; const float o0 = bflo(oww[e]), o1 = bfhi(oww[e]);
                    const float y0 = acc[j] * r * gh[j] * (1.0f / (1.0f + expf(-o0))), y1 = acc[j + 1] * r * gh[j + 1] * (1.0f / (1.0f + expf(-o1))); res[e] = pk2(y0, y1); }
                *(GAS u32x4*)(yo + j8 * 8) = (u32x4){res[0], res[1], res[2], res[3]}; }
        }
        __syncthreads();
        {
            const float decay = expf(mstate - Mnew); const int v = tid >> 2, d0 = 16 * (tid & 3);
            float cn[16];
#pragma unroll
            for (int j = 0; j < 16; ++j) cn[j] = decay * Cs[v * 64 + d0 + j];
            for (int s = 0; s < 128; ++s) { const float wv = wks[s] * bf2f(vs[s * 128 + v]);
#pragma unroll
                for (int j = 0; j < 16; ++j) cn[j] += wv * bf2f(ks[s * 64 + d0 + j]); }
#pragma unroll
            for (int j = 0; j < 16; ++j) Cs[v * 64 + d0 + j] = cn[j];
            if (tid < 64) { float a = decay * ns[tid]; for (int s = 0; s < 128; ++s) a += wks[s] * bf2f(ks[s * 64 + tid]); ns[tid] = a; }
            mstate = bL + Mnew;
        }
    }
    __syncthreads();
}

__device__ __forceinline__ void p2_gmlp_unit_simple(Frame& F, const Args& A, int u) {
    const int b = u >> 6, c = (u >> 2) & 15, g = u & 3, tid = F.tid, t = tid >> 2, p = tid & 3, tg0 = b * SEQ + c * 128;
    const bf16* proj = (const bf16*)(F.ws + WS_PROJ); bf16* ycat = (bf16*)(F.ws + WS_R2);
    const float* wsp = A.in[6] + (size_t)g * 128 * 128; const float* bsp = A.in[7] + g * 128; const float* gv = A.in[8] + g * 128; const float* go = A.in[9] + g * 128;
    LAS float* zs = (LAS float*)(F.lds + 0);
    __syncthreads();
    {
        const bf16* src = proj + (size_t)(tg0 + t) * NP + 2048 + g * 128 + 32 * p; float z[32]; float ss = 0.f;
#pragma unroll
        for (int j8 = 0; j8 < 4; ++j8) { const u32x4 w = *(const GAS u32x4*)(src + j8 * 8); const unsigned ww[4] = {w.x, w.y, w.z, w.w};
#pragma unroll
            for (int e = 0; e < 4; ++e) { z[j8 * 8 + 2 * e] = bflo(ww[e]); z[j8 * 8 + 2 * e + 1] = bfhi(ww[e]); } }
#pragma unroll
        for (int j = 0; j < 32; ++j) ss += z[j] * z[j];
        ss += __shfl_xor(ss, 1); ss += __shfl_xor(ss, 2);
        const float r = rsqrtf(ss * (1.0f / 128.0f) + EPS);
#pragma unroll
        for (int j = 0; j < 32; ++j) zs[t * 128 + 32 * p + j] = z[j] * r * gv[32 * p + j];
    }
    __syncthreads();
    {
        float acc[32];
#pragma unroll
        for (int j = 0; j < 32; ++j) acc[j] = 0.f;
        for (int s = 0; s <= t; ++s) { const float w = wsp[t * 128 + s];
#pragma unroll
            for (int j = 0; j < 32; ++j) acc[j] += w * zs[s * 128 + 32 * p + j]; }
        const float bias = bsp[t];
        const bf16* us = proj + (size_t)(tg0 + t) * NP + 1536 + g * 128 + 32 * p; float ss = 0.f;
#pragma unroll
        for (int j8 = 0; j8 < 4; ++j8) { const u32x4 w = *(const GAS u32x4*)(us + j8 * 8); const unsigned ww[4] = {w.x, w.y, w.z, w.w};
#pragma unroll
            for (int e = 0; e < 4; ++e) { const int j = j8 * 8 + 2 * e; acc[j] = bflo(ww[e]) * (acc[j] + bias); acc[j + 1] = bfhi(ww[e]) * (acc[j + 1] + bias); ss += acc[j] * acc[j] + acc[j + 1] * acc[j + 1]; } }
        ss += __shfl_xor(ss, 1); ss += __shfl_xor(ss, 2);
        const float r = rsqrtf(ss * (1.0f / 128.0f) + EPS);
        bf16* yo = ycat + (size_t)(tg0 + t) * D + 512 + g * 128 + 32 * p;
#pragma unroll
        for (int j8 = 0; j8 < 4; ++j8) { unsigned res[4];
#pragma unroll
            for (int e = 0; e < 4; ++e) { const int j = j8 * 8 + 2 * e; res[e] = pk2(acc[j] * r * go[32 * p + j], acc[j + 1] * r * go[32 * p + j + 1]); }
            *(GAS u32x4*)(yo + j8 * 8) = (u32x4){res[0], res[1], res[2], res[3]}; }
    }
}

__device__ __forceinline__ void p5_attn_unit_simple(Frame& F, int u) {
    const int b = u >> 7, h = (u >> 5) & 3, qt = u & 31, tid = F.tid, ql = tid >> 3, p = tid & 7;
    const bf16* Q = (const bf16*)(F.ws + WS_R2); const bf16* Km = (const bf16*)(F.ws + WS_KM); const bf16* Vt = (const bf16*)(F.ws + WS_VT); bf16* O = (bf16*)(F.ws + WS_R3);
    LAS bf16* Ks = (LAS bf16*)(F.lds + 0); LAS bf16* Vs = (LAS bf16*)(F.lds + 32768);
    const size_t tq = (size_t)b * SEQ + qt * 64 + ql;
    float qf[32], acc[32];
    { const bf16* src = Q + tq * D + h * 256 + 32 * p;
#pragma unroll
      for (int j8 = 0; j8 < 4; ++j8) { const u32x4 w = *(const GAS u32x4*)(src + j8 * 8); const unsigned ww[4] = {w.x, w.y, w.z, w.w};
#pragma unroll
          for (int e = 0; e < 4; ++e) { qf[j8 * 8 + 2 * e] = bflo(ww[e]); qf[j8 * 8 + 2 * e + 1] = bfhi(ww[e]); } } }
#pragma unroll
    for (int j = 0; j < 32; ++j) acc[j] = 0.f;
    float mrun = -1.0e30f, l = 0.f;
    for (int kt = 0; kt < 4; ++kt) {
        __syncthreads();
#pragma unroll
        for (int j = 0; j < 4; ++j) { const int i = tid + 512 * j, row = i >> 5, part = i & 31; ld16_to_lds(Ks + row * 256 + part * 8, Km + (size_t)(b * 256 + kt * 64 + row) * D + h * 256 + part * 8); }
#pragma unroll
        for (int j = 0; j < 4; ++j) { const int i = tid + 512 * j, d = i >> 3, part = i & 7; const u32x4 w = *(const GAS u32x4*)(Vt + (size_t)(h * 256 + d) * TM + b * 256 + kt * 64 + part * 8); const unsigned ww[4] = {w.x, w.y, w.z, w.w};
#pragma unroll
            for (int e = 0; e < 4; ++e) { Vs[(part * 8 + 2 * e) * 256 + d] = (bf16)(ww[e] & 0xffffu); Vs[(part * 8 + 2 * e + 1) * 256 + d] = (bf16)(ww[e] >> 16); } }
        __syncthreads();
        for (int mb = 0; mb < 8; ++mb) {
            float s8[8]; float mx = mrun;
#pragma unroll
            for (int e = 0; e < 8; ++e) { const int m = mb * 8 + e; float dot = 0.f;
#pragma unroll
                for (int j8 = 0; j8 < 4; ++j8) { const u32x4 w = *(const LAS u32x4*)(Ks + m * 256 + 32 * p + j8 * 8); const unsigned ww[4] = {w.x, w.y, w.z, w.w};
#pragma unroll
                    for (int q = 0; q < 4; ++q) dot += qf[j8 * 8 + 2 * q] * bflo(ww[q]) + qf[j8 * 8 + 2 * q + 1] * bfhi(ww[q]); }
                dot += __shfl_xor(dot, 1); dot += __shfl_xor(dot, 2); dot += __shfl_xor(dot, 4); s8[e] = dot; mx = fmaxf(mx, dot); }
            const float corr = expf(mrun - mx); mrun = mx; l *= corr;
#pragma unroll
            for (int j = 0; j < 32; ++j) acc[j] *= corr;
#pragma unroll
            for (int e = 0; e < 8; ++e) { const int m = mb * 8 + e; const float pe = expf(s8[e] - mx); l += pe;
#pragma unroll
                for (int j8 = 0; j8 < 4; ++j8) { const u32x4 w = *(const LAS u32x4*)(Vs + m * 256 + 32 * p + j8 * 8); const unsigned ww[4] = {w.x, w.y, w.z, w.w};
#pragma unroll
                    for (int q = 0; q < 4; ++q) { acc[j8 * 8 + 2 * q] += pe * bflo(ww[q]); acc[j8 * 8 + 2 * q + 1] += pe * bfhi(ww[q]); } } }
        }
    }
    const float inv = 1.0f / l; bf16* dst = O + tq * D + h * 256 + 32 * p;
#pragma unroll
    for (int j8 = 0; j8 < 4; ++j8) { u32x4 w; w.x = pk2(acc[j8 * 8] * inv, acc[j8 * 8 + 1] * inv); w.y = pk2(acc[j8 * 8 + 2] * inv, acc[j8 * 8 + 3] * inv); w.z = pk2(acc[j8 * 8 + 4] * inv, acc[j8 * 8 + 5] * inv); w.w = pk2(acc[j8 * 8 + 6] * inv, acc[j8 * 8 + 7] * inv);
        *(GAS u32x4*)(dst + j8 * 8) = w; }
}

constexpr int ML_QS = 0, ML_KS = 18432, ML_VT = 36864, ML_CB = 71680, ML_NS = 90112, ML_A = 90368, ML_M = ML_A + 8192, ML_LF = ML_M + 8192, ML_MC = ML_LF + 8192, ML_TMP = 0;
__device__ __forceinline__ bf16x8 scale_frag(bf16x8 f, float sc) {
    const u32x4 w = __builtin_bit_cast(u32x4, f);
    return __builtin_bit_cast(bf16x8, (u32x4){cvt_pk_bf16(bflo(w.x) * sc, bfhi(w.x) * sc), cvt_pk_bf16(bflo(w.y) * sc, bfhi(w.y) * sc), cvt_pk_bf16(bflo(w.z) * sc, bfhi(w.z) * sc), cvt_pk_bf16(bflo(w.w) * sc, bfhi(w.w) * sc)});
}
__device__ __forceinline__ void p2_mlstm_chain(Frame& F, const Args& A, int ch) {
    const int b = ch >> 2, h = ch & 3, tid = opaque(F.tid), lane = tid & 63, w = F.wave, tl = lane & 15, fq = lane >> 4;
    const bf16* proj = (const bf16*)(F.ws + WS_PROJ); const float* gates = (const float*)(F.ws + WS_GATES); bf16* ycat = (bf16*)(F.ws + WS_R2);
    const float* ghead = A.in[5] + h * 128;
    LAS unsigned char* L = F.lds;
    LAS float* sA = (LAS float*)(L + ML_A); LAS float* sM = (LAS float*)(L + ML_M); LAS float* sLF = (LAS float*)(L + ML_LF); LAS float* sMC = (LAS float*)(L + ML_MC);
    LAS float* ns = (LAS float*)(L + ML_NS);
    __syncthreads();
    { LAS float* tib = (LAS float*)(L + ML_TMP); LAS float* tfb = tib + 2048;
#pragma unroll
      for (int j = 0; j < 4; ++j) { const int p = tid + 512 * j; tib[p] = gates[((size_t)b * SEQ + p) * 8 + h]; tfb[p] = gates[((size_t)b * SEQ + p) * 8 + 4 + h]; }
      __syncthreads();
#pragma unroll 1
      for (int j = 0; j < 4; ++j) { const int p = tid + 512 * j, c0 = p & ~127, tt = p & 127; float bs = 0.f; for (int q = 0; q <= tt; ++q) bs += tfb[c0 + q]; sA[p] = tib[p] - bs; sLF[p] = bs; }
      __syncthreads();
#pragma unroll 1
      for (int j = 0; j < 4; ++j) { const int p = tid + 512 * j, c0 = p & ~127, tt = p & 127; float pm = -3.0e38f; for (int q = 0; q <= tt; ++q) pm = fmaxf(pm, sA[c0 + q]); sM[p] = pm; }
      __syncthreads();
      if (tid == 0) { float m = 0.f; for (int c = 0; c < 16; ++c) { sMC[c] = m; const float Mn = fmaxf(m, sM[c * 128 + 127]); sMC[32 + c] = Mn; m = sLF[c * 128 + 127] + Mn; } sMC[16] = m; }
      __syncthreads();
#pragma unroll
      for (int j = 0; j < 4; ++j) { const int p = tid + 512 * j; const float Mt = fmaxf(sMC[p >> 7], sM[p]); sM[p] = Mt; sLF[p] = -(sLF[p] + Mt); }
      for (int i = tid; i < 128 * 144 / 4; i += NTHREADS) ((LAS unsigned*)(L + ML_CB))[i] = 0u;
      if (tid < 64) ns[tid] = 0.f;
      __syncthreads(); }
    f32x4 Cst[4];
#pragma unroll
    for (int i = 0; i < 4; ++i) Cst[i] = (f32x4){0.f, 0.f, 0.f, 0.f};
    u32x4 qreg[2], kreg[2], vreg[4];
    { const size_t tg0 = (size_t)b * SEQ;
#pragma unroll
      for (int j = 0; j < 2; ++j) { const int idx = tid + 512 * j, row = idx >> 3, part = idx & 7; const bf16* src = proj + (tg0 + row) * NP + h * 64 + part * 8; qreg[j] = *(const GAS u32x4*)src; kreg[j] = *(const GAS u32x4*)(src + 256); }
#pragma unroll
      for (int j = 0; j < 4; ++j) { const int idx = tid + 512 * j, row = idx >> 4, part = idx & 15; vreg[j] = *(const GAS u32x4*)(proj + (tg0 + row) * NP + 512 + h * 128 + part * 8); } }
#pragma unroll 1
    for (int c = 0; c < 16; ++c) {
        const size_t tg0 = (size_t)b * SEQ + c * 128; const int t = 16 * w + tl;
#pragma unroll
        for (int j = 0; j < 2; ++j) { const int idx = tid + 512 * j, row = idx >> 3, part = idx & 7; *(LAS u32x4*)(L + ML_QS + row * 144 + part * 16) = qreg[j]; *(LAS u32x4*)(L + ML_KS + row * 144 + part * 16) = kreg[j]; }
#pragma unroll
        for (int j = 0; j < 4; ++j) { const int idx = tid + 512 * j, row = idx >> 4, part = idx & 15; const unsigned ww[4] = {vreg[j].x, vreg[j].y, vreg[j].z, vreg[j].w};
#pragma unroll
            for (int e = 0; e < 4; ++e) { *(LAS bf16*)(L + ML_VT + (part * 8 + 2 * e) * 272 + row * 2) = (bf16)(ww[e] & 0xffffu); *(LAS bf16*)(L + ML_VT + (part * 8 + 2 * e + 1) * 272 + row * 2) = (bf16)(ww[e] >> 16); } }
        __syncthreads();
        if (c < 15) { const size_t tn = tg0 + 128;
#pragma unroll
            for (int j = 0; j < 2; ++j) { const int idx = tid + 512 * j, row = idx >> 3, part = idx & 7; qreg[j] = *(const GAS u32x4*)(proj + (tn + row) * NP + h * 64 + part * 8); }
#pragma unroll
            for (int j = 0; j < 4; ++j) { const int idx = tid + 512 * j, row = idx >> 4, part = idx & 15; vreg[j] = *(const GAS u32x4*)(proj + (tn + row) * NP + 512 + h * 128 + part * 8); } }
        u32x2 og[8];
#pragma unroll
        for (int vb = 0; vb < 8; ++vb) og[vb] = *(const GAS u32x2*)(proj + (tg0 + t) * NP + 1024 + h * 128 + 16 * vb + 4 * fq);
        const float mc = sMC[c], Mn = sMC[32 + c], Mt = sM[c * 128 + t], lf = sLF[c * 128 + t];
        bf16x8 qf[2];
#pragma unroll
        for (int ds = 0; ds < 2; ++ds) qf[ds] = *(const LAS bf16x8*)(L + ML_QS + t * 144 + ds * 64 + fq * 16);
        unsigned sfr[4][4];
#pragma unroll
        for (int i = 0; i < 4; ++i)
#pragma unroll
            for (int j = 0; j < 4; ++j) sfr[i][j] = 0u;
        float den = 0.f;
#pragma unroll
        for (int sb = 0; sb < 8; ++sb) {
            if (sb <= w) {
                f32x4 G = (f32x4){0.f, 0.f, 0.f, 0.f};
#pragma unroll
                for (int ds = 0; ds < 2; ++ds) { const bf16x8 a = *(const LAS bf16x8*)(L + ML_KS + (16 * sb + tl) * 144 + ds * 64 + fq * 16); G = __builtin_amdgcn_mfma_f32_16x16x32_bf16(a, qf[ds], G, 0, 0, 0); }
                const f32x4 as = *(const LAS f32x4*)(sA + c * 128 + 16 * sb + 4 * fq);
                float sw[4];
#pragma unroll
                for (int r = 0; r < 4; ++r) { const int s = 16 * sb + 4 * fq + r; float wg = __builtin_amdgcn_exp2f((as[r] - Mt) * 1.4426950408889634f) * 0.125f; if (s > t) wg = 0.f; sw[r] = G[r] * wg; den += sw[r]; }
                sfr[sb >> 1][(sb & 1) * 2] = cvt_pk_bf16(sw[0], sw[1]); sfr[sb >> 1][(sb & 1) * 2 + 1] = cvt_pk_bf16(sw[2], sw[3]);
            }
        }
        den += __shfl_xor(den, 16); den += __shfl_xor(den, 32);
        const float winter = __builtin_amdgcn_exp2f((mc - Mt) * 1.4426950408889634f);
        { float nq = 0.f;
#pragma unroll
          for (int ds = 0; ds < 2; ++ds) { const u32x4 qw = __builtin_bit_cast(u32x4, qf[ds]); const f32x4 n0 = *(const LAS f32x4*)(ns + ds * 32 + fq * 8), n1 = *(const LAS f32x4*)(ns + ds * 32 + fq * 8 + 4);
              nq += (bflo(qw.x) * n0[0] + bfhi(qw.x) * n0[1]) + (bflo(qw.y) * n0[2] + bfhi(qw.y) * n0[3]) + (bflo(qw.z) * n1[0] + bfhi(qw.z) * n1[1]) + (bflo(qw.w) * n1[2] + bfhi(qw.w) * n1[3]); }
          nq += __shfl_xor(nq, 16); nq += __shfl_xor(nq, 32);
          den += winter * nq * 0.125f; }
        __syncthreads();
#pragma unroll
        for (int j = 0; j < 2; ++j) { const int idx = tid + 512 * j, row = idx >> 3, part = idx & 7; const float wk = __builtin_amdgcn_exp2f((sA[c * 128 + row] - Mn) * 1.4426950408889634f);
            const unsigned ww[4] = {kreg[j].x, kreg[j].y, kreg[j].z, kreg[j].w};
#pragma unroll
            for (int e = 0; e < 4; ++e) { *(LAS bf16*)(L + ML_KS + (part * 8 + 2 * e) * 272 + row * 2) = (bf16)f2bf(bflo(ww[e]) * wk); *(LAS bf16*)(L + ML_KS + (part * 8 + 2 * e + 1) * 272 + row * 2) = (bf16)f2bf(bfhi(ww[e]) * wk); } }
        if (c < 15) { const size_t tn = tg0 + 128;
#pragma unroll
            for (int j = 0; j < 2; ++j) { const int idx = tid + 512 * j, row = idx >> 3, part = idx & 7; kreg[j] = *(const GAS u32x4*)(proj + (tn + row) * NP + 256 + h * 64 + part * 8); } }
        f32x4 acc[8];
#pragma unroll
        for (int vb = 0; vb < 8; ++vb) acc[vb] = (f32x4){0.f, 0.f, 0.f, 0.f};
        { bf16x8 qw[2]; qw[0] = scale_frag(qf[0], winter * 0.125f); qw[1] = scale_frag(qf[1], winter * 0.125f);
#pragma unroll
          for (int vb = 0; vb < 8; ++vb)
#pragma unroll
              for (int ds = 0; ds < 2; ++ds) { const bf16x8 a = *(const LAS bf16x8*)(L + ML_CB + (16 * vb + tl) * 144 + ds * 64 + fq * 16); acc[vb] = __builtin_amdgcn_mfma_f32_16x16x32_bf16(a, qw[ds], acc[vb], 0, 0, 0); } }
#pragma unroll
        for (int st = 0; st < 4; ++st) {
            if (2 * st <= w) {
                const bf16x8 bfr = __builtin_bit_cast(bf16x8, (u32x4){sfr[st][0], sfr[st][1], sfr[st][2], sfr[st][3]});
#pragma unroll
                for (int vb = 0; vb < 8; ++vb) { const LAS unsigned char* ap = L + ML_VT + (16 * vb + tl) * 272 + (32 * st + 4 * fq) * 2; const u32x2 a0 = *(const LAS u32x2*)ap, a1 = *(const LAS u32x2*)(ap + 32);
                    acc[vb] = __builtin_amdgcn_mfma_f32_16x16x32_bf16(__builtin_bit_cast(bf16x8, (u32x4){a0.x, a0.y, a1.x, a1.y}), bfr, acc[vb], 0, 0, 0); }
            }
        }
        { const float inv = 1.0f / fmaxf(fabsf(den), __builtin_amdgcn_exp2f(lf * 1.4426950408889634f)); float ss = 0.f;
#pragma unroll
          for (int vb = 0; vb < 8; ++vb) { acc[vb] = acc[vb] * inv; ss += (acc[vb][0] * acc[vb][0] + acc[vb][1] * acc[vb][1]) + (acc[vb][2] * acc[vb][2] + acc[vb][3] * acc[vb][3]); }
          ss += __shfl_xor(ss, 16); ss += __shfl_xor(ss, 32);
          const float r = rsqrtf(ss * (1.0f / 128.0f) + EPS);
          bf16* yo = ycat + (tg0 + t) * D + h * 128 + 4 * fq;
#pragma unroll
          for (int vb = 0; vb < 8; ++vb) { const f32x4 gh = *(const f32x4*)(ghead + 16 * vb + 4 * fq);
              const float y0 = acc[vb][0] * r * gh[0] * sigmoidf_fast(bflo(og[vb].x)), y1 = acc[vb][1] * r * gh[1] * sigmoidf_fast(bfhi(og[vb].x));
              const float y2 = acc[vb][2] * r * gh[2] * sigmoidf_fast(bflo(og[vb].y)), y3 = acc[vb][3] * r * gh[3] * sigmoidf_fast(bfhi(og[vb].y));
              *(GAS u32x2*)(yo + 16 * vb) = (u32x2){cvt_pk_bf16(y0, y1), cvt_pk_bf16(y2, y3)}; } }
        __syncthreads();
        { const float decay = __builtin_amdgcn_exp2f((mc - Mn) * 1.4426950408889634f);
#pragma unroll
          for (int db = 0; db < 4; ++db) Cst[db] = Cst[db] * decay;
#pragma unroll
          for (int st = 0; st < 4; ++st) { const bf16x8 a = *(const LAS bf16x8*)(L + ML_VT + (16 * w + tl) * 272 + (32 * st + 8 * fq) * 2);
#pragma unroll
              for (int db = 0; db < 4; ++db) { const bf16x8 bb = *(const LAS bf16x8*)(L + ML_KS + (16 * db + tl) * 272 + (32 * st + 8 * fq) * 2); Cst[db] = __builtin_amdgcn_mfma_f32_16x16x32_bf16(a, bb, Cst[db], 0, 0, 0); } }
#pragma unroll
          for (int db = 0; db < 4; ++db)
#pragma unroll
              for (int r = 0; r < 4; ++r) *(LAS bf16*)(L + ML_CB + (16 * w + 4 * fq + r) * 144 + (16 * db + tl) * 2) = (bf16)f2bf(Cst[db][r]);
          { const int d = tid >> 3, part = tid & 7; const u32x4 k0 = *(const LAS u32x4*)(L + ML_KS + d * 272 + part * 32), k1 = *(const LAS u32x4*)(L + ML_KS + d * 272 + part * 32 + 16);
            float sm = ((bflo(k0.x) + bfhi(k0.x)) + (bflo(k0.y) + bfhi(k0.y))) + ((bflo(k0.z) + bfhi(k0.z)) + (bflo(k0.w) + bfhi(k0.w))) + ((bflo(k1.x) + bfhi(k1.x)) + (bflo(k1.y) + bfhi(k1.y))) + ((bflo(k1.z) + bfhi(k1.z)) + (bflo(k1.w) + bfhi(k1.w)));
            sm += __shfl_xor(sm, 1); sm += __shfl_xor(sm, 2); sm += __shfl_xor(sm, 4);
            if (part == 0) ns[d] = decay * ns[d] + sm; } }
        __syncthreads();
    }
}
constexpr int GM_WB = 0, GM_ZT = 34816;
__device__ __forceinline__ void p2_gmlp_setup(Frame& F, const Args& A, int g) {
    const int tid = opaque(F.tid), t = tid >> 2, s0 = (tid & 3) * 32; const float* src = A.in[6] + ((size_t)g * 128 + t) * 128 + s0;
    __syncthreads();
#pragma unroll
    for (int j = 0; j < 4; ++j) { const f32x4 a = *(const f32x4*)(src + 8 * j), bq = *(const f32x4*)(src + 8 * j + 4); float v[8] = {a[0], a[1], a[2], a[3], bq[0], bq[1], bq[2], bq[3]};
#pragma unroll
        for (int e = 0; e < 8; ++e) if (s0 + 8 * j + e > t) v[e] = 0.f;
        *(LAS u32x4*)(F.lds + GM_WB + t * 272 + (s0 + 8 * j) * 2) = (u32x4){pk2(v[0], v[1]), pk2(v[2], v[3]), pk2(v[4], v[5]), pk2(v[6], v[7])}; }
    __syncthreads();
}
__device__ __forceinline__ void p2_gmlp_unit(Frame& F, const Args& A, int b, int c, int g) {
    const int tid = opaque(F.tid), lane = tid & 63, w = F.wave, tl = lane & 15, fq = lane >> 4; const size_t tg0 = (size_t)b * SEQ + c * 128;
    const bf16* proj = (const bf16*)(F.ws + WS_PROJ); bf16* ycat = (bf16*)(F.ws + WS_R2);
    const float* bsp = A.in[7] + g * 128; const float* gv = A.in[8] + g * 128; const float* go = A.in[9] + g * 128;
    LAS unsigned char* L = F.lds;
    {
        const int s = tid >> 2, p = tid & 3; const bf16* src = proj + (tg0 + s) * NP + 2048 + g * 128 + 32 * p; float z[32]; float ss = 0.f;
#pragma unroll
        for (int j8 = 0; j8 < 4; ++j8) { const u32x4 ww = *(const GAS u32x4*)(src + j8 * 8); const unsigned wv[4] = {ww.x, ww.y, ww.z, ww.w};
#pragma unroll
            for (int e = 0; e < 4; ++e) { z[j8 * 8 + 2 * e] = bflo(wv[e]); z[j8 * 8 + 2 * e + 1] = bfhi(wv[e]); } }
#pragma unroll
        for (int j = 0; j < 32; ++j) ss += z[j] * z[j];
        ss += __shfl_xor(ss, 1); ss += __shfl_xor(ss, 2);
        const float r = rsqrtf(ss * (1.0f / 128.0f) + EPS);
#pragma unroll
        for (int j = 0; j < 32; ++j) *(LAS bf16*)(L + GM_ZT + (32 * p + j) * 272 + s * 2) = (bf16)f2bf(z[j] * r * gv[32 * p + j]);
    }
    const int t = 16 * w + tl;
    u32x2 ug[8];
#pragma unroll
    for (int db = 0; db < 8; ++db) ug[db] = *(const GAS u32x2*)(proj + (tg0 + t) * NP + 1536 + g * 128 + 16 * db + 4 * fq);
    __syncthreads();
    f32x4 acc[8];
#pragma unroll
    for (int db = 0; db < 8; ++db) acc[db] = (f32x4){0.f, 0.f, 0.f, 0.f};
#pragma unroll
    for (int st = 0; st < 4; ++st) {
        if (2 * st <= w) { const bf16x8 bfr = *(const LAS bf16x8*)(L + GM_WB + t * 272 + (32 * st + 8 * fq) * 2);
#pragma unroll
            for (int db = 0; db < 8; ++db) { const bf16x8 a = *(const LAS bf16x8*)(L + GM_ZT + (16 * db + tl) * 272 + (32 * st + 8 * fq) * 2); acc[db] = __builtin_amdgcn_mfma_f32_16x16x32_bf16(a, bfr, acc[db], 0, 0, 0); } }
    }
    const float bias = bsp[t]; float ss = 0.f;
#pragma unroll
    for (int db = 0; db < 8; ++db) { acc[db][0] = bflo(ug[db].x) * (acc[db][0] + bias); acc[db][1] = bfhi(ug[db].x) * (acc[db][1] + bias); acc[db][2] = bflo(ug[db].y) * (acc[db][2] + bias); acc[db][3] = bfhi(ug[db].y) * (acc[db][3] + bias);
        ss += (acc[db][0] * acc[db][0] + acc[db][1] * acc[db][1]) + (acc[db][2] * acc[db][2] + acc[db][3] * acc[db][3]); }
    ss += __shfl_xor(ss, 16); ss += __shfl_xor(ss, 32);
    const float r = rsqrtf(ss * (1.0f / 128.0f) + EPS);
    bf16* yo = ycat + (tg0 + t) * D + 512 + g * 128 + 4 * fq;
#pragma unroll
    for (int db = 0; db < 8; ++db) { const f32x4 gg = *(const f32x4*)(go + 16 * db + 4 * fq);
        *(GAS u32x2*)(yo + 16 * db) = (u32x2){cvt_pk_bf16(acc[db][0] * r * gg[0], acc[db][1] * r * gg[1]), cvt_pk_bf16(acc[db][2] * r * gg[2], acc[db][3] * r * gg[3])}; }
    __syncthreads();
}

constexpr int ATT_KROW = 528, ATT_VROW = 136, ATT_BUF = 34816;
__device__ __forceinline__ void att_load_tile(int i, int b, int h, int tid, const bf16* Km, const bf16* Vt, u32x4 (&r)[4]) {
    if (i < 4) {
#pragma unroll
        for (int j = 0; j < 4; ++j) { const int idx = tid + 512 * j, row = idx >> 5, c = idx & 31; r[j] = *(const GAS u32x4*)(Km + (size_t)(b * 256 + i * 64 + row) * D + h * 256 + c * 8); }
    } else {
#pragma unroll
        for (int j = 0; j < 4; ++j) { const int idx = tid + 512 * j, d = idx >> 3, c = idx & 7; r[j] = *(const GAS u32x4*)(Vt + (size_t)(h * 256 + d) * TM + b * 256 + (i - 4) * 64 + c * 8); }
    }
}
__device__ __forceinline__ void att_store_tile(int i, int tid, LAS unsigned char* buf, const u32x4 (&r)[4]) {
    if (i < 4) {
#pragma unroll
        for (int j = 0; j < 4; ++j) { const int idx = tid + 512 * j, row = idx >> 5, c = idx & 31; *(LAS u32x4*)(buf + row * ATT_KROW + c * 16) = r[j]; }
    } else {
#pragma unroll
        for (int j = 0; j < 4; ++j) { const int idx = tid + 512 * j, d = idx >> 3, c = idx & 7; LAS u32x2* dp = (LAS u32x2*)(buf + d * ATT_VROW + c * 16); dp[0] = (u32x2){r[j].x, r[j].y}; dp[1] = (u32x2){r[j].z, r[j].w}; }
    }
}
__device__ __forceinline__ void p5_attn_unit(Frame& F, int u) {
    const int b = u >> 6, h = (u >> 4) & 3, qt = u & 15, tid = opaque(F.tid), lane = tid & 63, w = F.wave, ql = lane & 15, fq = lane >> 4;
    const bf16* Q = (const bf16*)(F.ws + WS_R2); const bf16* Km = (const bf16*)(F.ws + WS_KM); const bf16* Vt = (const bf16*)(F.ws + WS_VT); bf16* O = (bf16*)(F.ws + WS_R3);
    const size_t tq = (size_t)b * SEQ + qt * 128 + w * 16 + ql;
    bf16x8 qf[8];
#pragma unroll
    for (int ds = 0; ds < 8; ++ds) qf[ds] = *(const GAS bf16x8*)(Q + tq * D + h * 256 + 32 * ds + 8 * fq);
    f32x4 S[16];
#pragma unroll
    for (int i = 0; i < 16; ++i) S[i] = (f32x4){0.f, 0.f, 0.f, 0.f};
    u32x4 pre[4];
    __syncthreads();
    att_load_tile(0, b, h, tid, Km, Vt, pre); att_store_tile(0, tid, F.lds, pre);
    __syncthreads();
#pragma unroll
    for (int kt = 0; kt < 4; ++kt) {
        LAS unsigned char* buf = F.lds + (kt & 1) * ATT_BUF;
        att_load_tile(kt + 1, b, h, tid, Km, Vt, pre);
#pragma unroll
        for (int kb = 0; kb < 4; ++kb)
#pragma unroll
            for (int ds = 0; ds < 8; ++ds) { const bf16x8 a = *(const LAS bf16x8*)(buf + (kb * 16 + ql) * ATT_KROW + (32 * ds + 8 * fq) * 2);
                S[kt * 4 + kb] = __builtin_amdgcn_mfma_f32_16x16x32_bf16(a, qf[ds], S[kt * 4 + kb], 0, 0, 0); }
        att_store_tile(kt + 1, tid, F.lds + ((kt + 1) & 1) * ATT_BUF, pre);
        __syncthreads();
    }
    float mx = -3.0e38f;
#pragma unroll
    for (int i = 0; i < 16; ++i) mx = fmaxf(fmaxf(fmaxf(mx, S[i][0]), fmaxf(S[i][1], S[i][2])), S[i][3]);
    mx = fmaxf(mx, __shfl_xor(mx, 16)); mx = fmaxf(mx, __shfl_xor(mx, 32));
    float l = 0.f; bf16x8 pf[8];
#pragma unroll
    for (int st = 0; st < 8; ++st) { float e[8];
#pragma unroll
        for (int j = 0; j < 4; ++j) { e[j] = __builtin_amdgcn_exp2f((S[2 * st][j] - mx) * 1.4426950408889634f); e[4 + j] = __builtin_amdgcn_exp2f((S[2 * st + 1][j] - mx) * 1.4426950408889634f); }
#pragma unroll
        for (int j = 0; j < 8; ++j) l += e[j];
        const u32x4 pk = (u32x4){cvt_pk_bf16(e[0], e[1]), cvt_pk_bf16(e[2], e[3]), cvt_pk_bf16(e[4], e[5]), cvt_pk_bf16(e[6], e[7])};
        pf[st] = __builtin_bit_cast(bf16x8, pk); }
    l += __shfl_xor(l, 16); l += __shfl_xor(l, 32);
    f32x4 Oa[16];
#pragma unroll
    for (int i = 0; i < 16; ++i) Oa[i] = (f32x4){0.f, 0.f, 0.f, 0.f};
#pragma unroll
    for (int vt = 0; vt < 4; ++vt) {
        LAS unsigned char* buf = F.lds + (vt & 1) * ATT_BUF;
        if (vt < 3) att_load_tile(5 + vt, b, h, tid, Km, Vt, pre);
#pragma unroll
        for (int db = 0; db < 16; ++db)
#pragma unroll
            for (int s2 = 0; s2 < 2; ++s2) { const LAS unsigned char* ap = buf + (db * 16 + ql) * ATT_VROW + (32 * s2 + 4 * fq) * 2;
                const u32x2 a0 = *(const LAS u32x2*)ap, a1 = *(const LAS u32x2*)(ap + 32);
                const bf16x8 a = __builtin_bit_cast(bf16x8, (u32x4){a0.x, a0.y, a1.x, a1.y});
                Oa[db] = __builtin_amdgcn_mfma_f32_16x16x32_bf16(a, pf[vt * 2 + s2], Oa[db], 0, 0, 0); }
        if (vt < 3) { att_store_tile(5 + vt, tid, F.lds + ((vt + 1) & 1) * ATT_BUF, pre); __syncthreads(); }
    }
    const float inv = 1.0f / l; bf16* dst = O + tq * D + h * 256 + 4 * fq;
#pragma unroll
    for (int db = 0; db < 16; ++db) *(GAS u32x2*)(dst + 16 * db) = (u32x2){cvt_pk_bf16(Oa[db][0] * inv, Oa[db][1] * inv), cvt_pk_bf16(Oa[db][2] * inv, Oa[db][3] * inv)};
}

__device__ __forceinline__ void p7_router(Frame& F, const Args& A) {
    const int tid = opaque(F.tid), lane = tid & 63, w = F.wave, tl = lane & 31, kh = lane >> 5;
    const bf16* x2b = (const bf16*)(F.ws + WS_R2); const float* ssq2 = (const float*)(F.ws + WS_SSQ2); float* rr2 = (float*)(F.ws + WS_RR2);
    const float* brt = A.in[18]; int* lpid = (int*)(F.ws + WS_LPID); float* lw = (float*)(F.ws + WS_LW);
    LAS float* wr = (LAS float*)(F.lds + 0);
    LAS int* hist = (LAS int*)(F.lds + LDS_X_OFF); LAS int* basee = hist + 32; LAS int* pinfo = basee + 32; LAS float* pw = (LAS float*)(pinfo + 1024);
    { const float* src = (const float*)(F.ws + WS_WR); for (int i = tid; i < D * NE / 4; i += NTHREADS) ((LAS f32x4*)wr)[i] = ((const GAS f32x4*)src)[i]; }
    if (tid < 32) hist[tid] = 0;
    __syncthreads();
    for (int chunk = F.c; chunk < T / 256; chunk += F.G) {
        const int t = chunk * 256 + 32 * w + tl;
        float acc[32];
#pragma unroll
        for (int e = 0; e < 32; ++e) acc[e] = 0.f;
        const bf16* xr = x2b + (size_t)t * D + 512 * kh;
        for (int k8 = 0; k8 < 64; ++k8) {
            const u32x4 xw = *(const GAS u32x4*)(xr + k8 * 8); const unsigned xx[4] = {xw.x, xw.y, xw.z, xw.w};
#pragma unroll
            for (int q = 0; q < 8; ++q) { const float xv = (q & 1) ? bfhi(xx[q >> 1]) : bflo(xx[q >> 1]); const LAS f32x4* wp = (const LAS f32x4*)(wr + (512 * kh + k8 * 8 + q) * 32);
#pragma unroll
                for (int e4 = 0; e4 < 8; ++e4) { const f32x4 w4 = wp[e4]; acc[e4 * 4] += xv * w4[0]; acc[e4 * 4 + 1] += xv * w4[1]; acc[e4 * 4 + 2] += xv * w4[2]; acc[e4 * 4 + 3] += xv * w4[3]; }
                asm volatile("" ::: "memory"); }
        }
#pragma unroll
        for (int e = 0; e < 32; ++e) acc[e] += __shfl_xor(acc[e], 32);
        const float r = row_rms_from_ssq(ssq2, t);
#pragma unroll
        for (int e = 0; e < 32; ++e) acc[e] = acc[e] * r + brt[e];
        int idx[4]; float val[4];
#pragma unroll
        for (int k = 0; k < 4; ++k) { float best = acc[0];
#pragma unroll
            for (int e = 1; e < 32; ++e) best = fmaxf(best, acc[e]);
            int bi = 31;
#pragma unroll
            for (int e = 30; e >= 0; --e) bi = (acc[e] == best) ? e : bi;
#pragma unroll
            for (int e = 0; e < 32; ++e) acc[e] = (e == bi) ? -3.0e38f : acc[e];
            idx[k] = bi; val[k] = best; }
        float ex[4], sum = 0.f;
#pragma unroll
        for (int k = 0; k < 4; ++k) { ex[k] = expf(val[k] - val[0]); sum += ex[k]; }
        const float inv = 1.0f / sum;
        if (kh == 0) { rr2[t] = r;
#pragma unroll
            for (int k = 0; k < 4; ++k) { const int rank = __hip_atomic_fetch_add(hist + idx[k], 1, __ATOMIC_RELAXED, __HIP_MEMORY_SCOPE_WORKGROUP); pinfo[(32 * w + tl) * 4 + k] = idx[k] | (rank << 5); pw[(32 * w + tl) * 4 + k] = ex[k] * inv; } }
        __syncthreads();
        if (tid < 32) { basee[tid] = (int)__hip_atomic_fetch_add((unsigned*)(F.ctl + CW_CNT + tid), (unsigned)hist[tid], RLX_AGENT); hist[tid] = 0; }
        __syncthreads();
#pragma unroll
        for (int j = 0; j < 2; ++j) { const int i = tid + 512 * j, info = pinfo[i], e = info & 31, pos = basee[e] + (info >> 5); lpid[(size_t)e * LISTCAP + pos] = chunk * 1024 + i; lw[(size_t)e * LISTCAP + pos] = pw[i]; }
        __syncthreads();
    }
}
__device__ __forceinline__ int moe_tables(Frame& F, LAS int*& tpre, LAS int*& cnts) {
    tpre = (LAS int*)(F.lds + LDS_X_OFF); cnts = tpre + 40;
    __syncthreads();
    if (F.tid < 32) cnts[F.tid] = (int)__hip_atomic_load((unsigned*)(F.ctl + CW_CNT + F.tid), RLX_AGENT);
    __syncthreads();
    if (F.tid == 0) { int s = 0; for (int e = 0; e < 32; ++e) { tpre[e] = s; s += (cnts[e] + 255) >> 8; } tpre[32] = s; }
    __syncthreads();
    return __builtin_amdgcn_readfirstlane(tpre[32]);
}
__device__ __forceinline__ void p10_final(Frame& F, const Args& A) {
    const int gw = F.c * NWAVES + F.wave, NGW = F.G * NWAVES, lane = opaque(F.lane);
    const bf16* x2b = (const bf16*)(F.ws + WS_R2); const bf16* Y = (const bf16*)(F.ws + WS_Y); const float* gf = A.in[25]; float* out = A.out;
    f32x4 g[4];
#pragma unroll
    for (int hh = 0; hh < 2; ++hh) { g[2 * hh] = *(const f32x4*)(gf + 512 * hh + 8 * lane); g[2 * hh + 1] = *(const f32x4*)(gf + 512 * hh + 8 * lane + 4); }
    for (int t = gw; t < T; t += NGW) {
        float v[16];
#pragma unroll
        for (int hh = 0; hh < 2; ++hh) { const u32x4 w = *(const GAS u32x4*)(x2b + (size_t)t * D + 512 * hh + 8 * lane); const unsigned ww[4] = {w.x, w.y, w.z, w.w};
#pragma unroll
            for (int e = 0; e < 4; ++e) { v[8 * hh + 2 * e] = bflo(ww[e]); v[8 * hh + 2 * e + 1] = bfhi(ww[e]); } }
#pragma unroll
        for (int k = 0; k < 4; ++k)
#pragma unroll
            for (int hh = 0; hh < 2; ++hh) { const u32x4 w = *(const GAS u32x4*)(Y + ((size_t)t * 4 + k) * D + 512 * hh + 8 * lane); const unsigned ww[4] = {w.x, w.y, w.z, w.w};
#pragma unroll
                for (int e = 0; e < 4; ++e) { v[8 * hh + 2 * e] += bflo(ww[e]); v[8 * hh + 2 * e + 1] += bfhi(ww[e]); } }
        float s = 0.f;
#pragma unroll
        for (int j = 0; j < 16; ++j) s += v[j] * v[j];
        const float r = rsqrtf(wave_sum(s) * (1.0f / D) + EPS);
#pragma unroll
        for (int hh = 0; hh < 2; ++hh) { float* o = out + (size_t)t * D + 512 * hh + 8 * lane;
            *(GAS f32x4*)o = (f32x4){v[8 * hh] * r * g[2 * hh][0], v[8 * hh + 1] * r * g[2 * hh][1], v[8 * hh + 2] * r * g[2 * hh][2], v[8 * hh + 3] * r * g[2 * hh][3]};
            *(GAS f32x4*)(o + 4) = (f32x4){v[8 * hh + 4] * r * g[2 * hh + 1][0], v[8 * hh + 5] * r * g[2 * hh + 1][1], v[8 * hh + 6] * r * g[2 * hh + 1][2], v[8 * hh + 7] * r * g[2 * hh + 1][3]}; }
    }
}

constexpr int NPHASES = 11;
__global__ void __launch_bounds__(NTHREADS, 2) fwd_kernel(Args args) {
    extern __shared__ __attribute__((aligned(16))) unsigned char lds_raw[];
    Frame F;
    F.lds = (LAS unsigned char*)lds_raw;
    F.MISC = (volatile LAS unsigned*)(F.lds + MISC_OFF);
    F.tid = threadIdx.x; F.lane = F.tid & 63; F.wave = __builtin_amdgcn_readfirstlane(F.tid >> 6);
    F.G = gridDim.x; F.c = blockIdx.x; F.ws = args.ws; F.ctl = (gu32*)(args.ws + WS_CTL);
    for (int u = F.tid; u < 1024 / 4; u += NTHREADS) ((LAS unsigned*)(F.lds + LDSCTL_OFF))[u] = 0u;
    __syncthreads();
    const int lo = args.ph_lo, hi = args.ph_hi;
    XcdBarrier bar; bar.bar = (unsigned*)(F.ctl + CW_BAR); bar.x = 0; bar.st = nullptr;
    if (hi - lo > 1) bar = xcd_barrier_post((unsigned*)(F.ctl + CW_BAR), F.MISC + 8);
#ifndef PH_MASK
#define PH_MASK 0x7ff
#endif
#define IN(k) (((PH_MASK >> (k)) & 1) && lo <= (k) && (k) < hi)
#define SEAM(k) do { if (IN(k) && IN((k) + 1)) xcd_barrier(bar); } while (0)
    unsigned char* ws = args.ws;
    if (IN(0)) { p0_prologue(F, args); SEAM(0); }
    if (IN(1)) {
        P1Order S{F.G, F.c, (const char*)ws};
        EpiP1 E{ws};
        pg8::gemm_phase<EpiP1, P1Order>(F.lds + RING_OFF, F.lds + LDS_G_OFF, D, S, E);
        SEAM(1);
    }
    if (IN(2)) {
        if (F.G == 256) {
            if (F.c < 128) p2_mlstm_chain(F, args, F.c);
            else { const int g = F.c & 3, wi = (F.c - 128) >> 2; p2_gmlp_setup(F, args, g);
                   for (int pi = wi; pi < BATCH * 16; pi += 32) p2_gmlp_unit(F, args, pi >> 4, pi & 15, g); }
        } else {
            for (int ch = F.c; ch < BATCH * 4; ch += F.G) p2_mlstm_chain_simple(F, args, ch);
            for (int u = (F.c + F.G - (128 % F.G)) % F.G; u < BATCH * 16 * 4; u += F.G) p2_gmlp_unit_simple(F, args, u);
        }
        SEAM(2);
    }
    if (IN(3)) {
        PlainOrder S{F.G, F.c, T / 256, 4, (const char*)(ws + WS_R2), (const char*)(ws + WS_WOUT)};
        EpiResid<true> E{(const void*)args.in[0], (bf16*)(ws + WS_R1), (float*)(ws + WS_SSQ1)};
        pg8::gemm_phase<EpiResid<true>, PlainOrder>(F.lds + RING_OFF, F.lds + LDS_G_OFF, D, S, E);
        SEAM(3);
    }
    if (IN(4)) {
        PlainOrder S{F.G, F.c, T / 256, 4, (const char*)(ws + WS_R1), (const char*)(ws + WS_WQ)};
        EpiQ E{(bf16*)(ws + WS_R2), (const float*)(ws + WS_SSQ1)};
        pg8::gemm_phase<EpiQ, PlainOrder>(F.lds + RING_OFF, F.lds + LDS_G_OFF, D, S, E);
        SEAM(4);
    }
    if (IN(5)) {
        for (int u = F.c; u < BATCH * 4 * 16; u += F.G) p5_attn_unit(F, u);
        SEAM(5);
    }
    if (IN(6)) {
        PlainOrder S{F.G, F.c, T / 256, 4, (const char*)(ws + WS_R3), (const char*)(ws + WS_WXO)};
        EpiResid<false> E{(const void*)(ws + WS_R1), (bf16*)(ws + WS_R2), (float*)(ws + WS_SSQ2)};
        pg8::gemm_phase<EpiResid<false>, PlainOrder>(F.lds + RING_OFF, F.lds + LDS_G_OFF, D, S, E);
        SEAM(6);
    }
    if (IN(7)) { p7_router(F, args); SEAM(7); }
    if (IN(8)) {
        LAS int *tpre, *cnts; const int NT = moe_tables(F, tpre, cnts);
        MoeOrder<true, 8> S{F.G, F.c, NT, tpre, cnts, (const char*)(ws + WS_R2), nullptr, (const char*)(ws + WS_WGU), (const int*)(ws + WS_LPID)};
        EpiG1 E{(bf16*)args.out, (bf16*)(ws + WS_H2), (const int*)(ws + WS_LPID), (const float*)(ws + WS_RR2), args.in[20], args.in[22], tpre, cnts};
        pg8::gemm_phase<EpiG1, MoeOrder<true, 8>>(F.lds + RING_OFF, F.lds + LDS_G_OFF, D, S, E);
        SEAM(8);
    }
    if (IN(9)) {
        LAS int *tpre, *cnts; const int NT = moe_tables(F, tpre, cnts);
        MoeOrder<false, 4> S{F.G, F.c, NT, tpre, cnts, (const char*)args.out, (const char*)(ws + WS_H2), (const char*)(ws + WS_WD), nullptr};
        EpiG2 E{(bf16*)(ws + WS_Y), (const int*)(ws + WS_LPID), (const float*)(ws + WS_LW), args.in[24], tpre, cnts};
        pg8::gemm_phase<EpiG2, MoeOrder<false, 4>>(F.lds + RING_OFF, F.lds + LDS_G_OFF, FF, S, E);
        SEAM(9);
    }
    if (IN(10)) p10_final(F, args);
#undef IN
#undef SEAM
}

extern "C" void kernel_launch(void* const* d_in, const int* in_sizes, int n_in, void* d_out, int out_size, void* d_ws, size_t ws_size, hipStream_t stream) {
    static int grid = 0;
    if (grid == 0) {
        if (n_in != 26 || in_sizes[0] != T * D || out_size != T * D || ws_size < WS_END) { fprintf(stderr, "kernel_launch: unexpected shapes (n_in %d, in0 %d, out %d, ws %zu)\n", n_in, n_in > 0 ? in_sizes[0] : -1, out_size, ws_size); grid = -1; return; }
        int dev = 0, cus = 0, per_cu = 0;
        if (hipGetDevice(&dev) != hipSuccess || hipDeviceGetAttribute(&cus, hipDeviceAttributeMultiprocessorCount, dev) != hipSuccess) { grid = -1; return; }
        if (hipFuncSetAttribute((const void*)fwd_kernel, hipFuncAttributeMaxDynamicSharedMemorySize, LDS_BYTES) != hipSuccess) { fprintf(stderr, "kernel_launch: hipFuncSetAttribute failed\n"); grid = -1; return; }
        if (hipOccupancyMaxActiveBlocksPerMultiprocessor(&per_cu, (const void*)fwd_kernel, NTHREADS, LDS_BYTES) != hipSuccess || per_cu < 1) { fprintf(stderr, "kernel_launch: occupancy query says %d\n", per_cu); }
        (void)hipGetLastError();
        grid = cus;
    }
    if (grid < 0) return;
    (void)hipMemsetAsync((char*)d_ws + WS_CTL, 0, CTL_ZERO_BYTES, stream);
    Args a{};
    for (int i = 0; i < 26; ++i) a.in[i] = (const float*)d_in[i];
    a.out = (float*)d_out; a.ws = (unsigned char*)d_ws;
#if MK_PER_PHASE
    for (int ph = 0; ph < NPHASES; ++ph) { a.ph_lo = ph; a.ph_hi = ph + 1; hipLaunchKernelGGL(fwd_kernel, dim3(grid), dim3(NTHREADS), LDS_BYTES, stream, a); }
#else
    a.ph_lo = 0; a.ph_hi = NPHASES; hipLaunchKernelGGL(fwd_kernel, dim3(grid), dim3(NTHREADS), LDS_BYTES, stream, a);
#endif
}
```

```cpp
#include <hip/hip_runtime.h>
#include <cstdio>
#include <cstdint>

#ifndef NOISE_PROBE
#define NOISE_PROBE 0
#endif
#ifndef RELAX_P1
#define RELAX_P1 0
#endif
#ifndef PROF_PH
#define PROF_PH 0
#define PROF_SEL 0
#define PROF_MULT 4
#endif
#ifndef P0X_REP
#define P0X_REP 1
#endif
#ifndef P10_REP
#define P10_REP 1
#endif
#ifndef P0_REP
#define P0_REP 1
#endif
#ifndef MK_PER_PHASE
#define MK_PER_PHASE 0
#endif

#define GAS __attribute__((address_space(1)))
#define LAS __attribute__((address_space(3)))
typedef unsigned short bf16;
typedef short bf16x8 __attribute__((ext_vector_type(8)));
typedef short bf16x16 __attribute__((ext_vector_type(16)));
typedef float f32x4 __attribute__((ext_vector_type(4)));
typedef float f32x2 __attribute__((ext_vector_type(2)));
typedef unsigned u32x4 __attribute__((ext_vector_type(4)));
typedef unsigned u32x2 __attribute__((ext_vector_type(2)));

constexpr int BATCH = 32, SEQ = 2048, T = BATCH * SEQ, D = 1024;
constexpr int MEMLEN = 256, TM = BATCH * MEMLEN;
constexpr int NP = 2560, INW = 2568;
constexpr int NE = 32, TOPK = 4, FF = 1024, NPAIR = T * TOPK;
constexpr int MAXTILES = NPAIR / 256 + NE;
constexpr int LISTCAP = 65536;
constexpr float EPS = 1e-6f;
constexpr int NWAVES = 8, NTHREADS = 512;

constexpr size_t MiB = 1u << 20;
constexpr size_t WS_CTL = 0, CTL_ZERO_BYTES = 65536;
constexpr size_t WS_WIN = 1 * MiB;
constexpr size_t WS_WOUT = 6 * MiB;
constexpr size_t WS_WQ = 8 * MiB;
constexpr size_t WS_WKV = 10 * MiB;
constexpr size_t WS_WXO = 14 * MiB;
constexpr size_t WS_WD = 16 * MiB;
constexpr size_t WS_R2 = 80 * MiB;
constexpr size_t WS_WGU = 208 * MiB;
constexpr size_t WS_R1 = 336 * MiB;
constexpr size_t WS_R3 = 464 * MiB;
constexpr size_t WS_KM = 592 * MiB;
constexpr size_t WS_VT = 608 * MiB;
constexpr size_t WS_PROJ = 624 * MiB;
constexpr size_t WS_Y = 208 * MiB;
constexpr size_t WS_H2 = 736 * MiB;
constexpr size_t WS_X1Q = WS_PROJ + 64 * MiB;
constexpr size_t WS_XQ = WS_PROJ;
constexpr size_t WS_MISC = 48 * MiB;
constexpr size_t WS_GATES = WS_MISC;
constexpr size_t WS_SSQ1 = WS_MISC + 2 * MiB;
constexpr size_t WS_SSQ2 = WS_MISC + 6 * MiB;
constexpr size_t WS_RR2 = WS_MISC + 10 * MiB;
constexpr size_t WS_WR = WS_MISC + 11 * MiB;
constexpr size_t WS_LPID = WS_MISC + 12 * MiB;
constexpr size_t WS_PINF = WS_MISC + 20 * MiB;
constexpr size_t WS_PWT = WS_MISC + 21 * MiB;
constexpr size_t WS_SA = WS_MISC + 22 * MiB;
constexpr size_t WS_SAM = WS_SA + 512 * 1024;
constexpr size_t WS_SB = WS_MISC + 23 * MiB;
constexpr size_t WS_SBKV = WS_SB + 16384;
constexpr size_t WS_END = 1024 * MiB;
static_assert(WS_PWT + 1 * MiB <= WS_R2 && WS_WD + 32 * MiB <= WS_MISC && WS_H2 + (size_t)MAXTILES * 256 * 1024 <= WS_END && WS_Y + (size_t)MAXTILES * 256 * 1024 * 2 <= WS_H2, "ws map");
static_assert(WS_PROJ + (size_t)T * NP * 2 <= WS_END, "ws map 2");
constexpr int CW_TMO = 0, CW_CODE = 1, CW_P0CNT = 16  , CW_CNT = 1024  , CW_BAR = 4096, CW_CMAX = 8192  ;

constexpr int RING_OFF = 0, RING_BYTES = 131072;
constexpr int LDSCTL_OFF = RING_BYTES, MISC_OFF = LDSCTL_OFF + 320;
constexpr int LDS_X_OFF = LDSCTL_OFF + 1024;
constexpr int LDS_G_OFF = LDS_X_OFF + 1024;
constexpr int LDS_BYTES = 147456;

#define LDS_WAIT() asm volatile("s_waitcnt lgkmcnt(0)" ::: "memory")
#define VM_WAIT() asm volatile("s_waitcnt vmcnt(0)" ::: "memory")
typedef GAS unsigned gu32;
#define RLX_AGENT __ATOMIC_RELAXED, __HIP_MEMORY_SCOPE_AGENT

__device__ __forceinline__ unsigned f2bf(float f) { unsigned u = __builtin_bit_cast(unsigned, f); return (u + 0x7fffu + ((u >> 16) & 1u)) >> 16; }
__device__ __forceinline__ unsigned pk2(float lo, float hi) { return f2bf(lo) | (f2bf(hi) << 16); }
__device__ __forceinline__ float bf2f(unsigned b) { return __builtin_bit_cast(float, b << 16); }
__device__ __forceinline__ float bflo(unsigned w) { return __builtin_bit_cast(float, w << 16); }
__device__ __forceinline__ float bfhi(unsigned w) { return __builtin_bit_cast(float, w & 0xffff0000u); }
__device__ __forceinline__ unsigned cvt_pk_bf16(float lo, float hi) { unsigned r; asm volatile("v_cvt_pk_bf16_f32 %0, %1, %2" : "=v"(r) : "v"(lo), "v"(hi)); return r; }
__device__ __forceinline__ unsigned pk4_fp8(float a, float b, float c, float d) { int w = __builtin_amdgcn_cvt_pk_fp8_f32(a, b, 0, false); w = __builtin_amdgcn_cvt_pk_fp8_f32(c, d, w, true); return (unsigned)w; }
__device__ __forceinline__ unsigned pk4_i8s(float a, float b, float c, float d, float s) {
    const unsigned ua = __builtin_bit_cast(unsigned, __builtin_fmaf(a, s, 12582912.0f)), ub = __builtin_bit_cast(unsigned, __builtin_fmaf(b, s, 12582912.0f));
    const unsigned uc = __builtin_bit_cast(unsigned, __builtin_fmaf(c, s, 12582912.0f)), ud = __builtin_bit_cast(unsigned, __builtin_fmaf(d, s, 12582912.0f));
    return __builtin_amdgcn_perm(__builtin_amdgcn_perm(ud, uc, 0x0c0c0400u), __builtin_amdgcn_perm(ub, ua, 0x0c0c0400u), 0x05040100u); }
__device__ __forceinline__ unsigned pk4_i8(float a, float b, float c, float d) { return pk4_i8s(a, b, c, d, 1.0f); }
__device__ __forceinline__ int opaque(int x) { asm volatile("" : "+v"(x)); return x; }
template <int CTRL> __device__ __forceinline__ float dpp_f(float v) { return __builtin_bit_cast(float, __builtin_amdgcn_update_dpp(0, __builtin_bit_cast(int, v), CTRL, 0xf, 0xf, false)); }
__device__ __forceinline__ float lane_f(float v, int l) { return __builtin_bit_cast(float, __builtin_amdgcn_readlane(__builtin_bit_cast(int, v), l)); }
__device__ __forceinline__ float wave_sum(float v) {
    v += dpp_f<0x121>(v); v += dpp_f<0x122>(v); v += dpp_f<0x124>(v); v += dpp_f<0x128>(v);
    return (lane_f(v, 0) + lane_f(v, 16)) + (lane_f(v, 32) + lane_f(v, 48));
}
__device__ __forceinline__ float wave_max(float v) {
    v = fmaxf(v, dpp_f<0x121>(v)); v = fmaxf(v, dpp_f<0x122>(v)); v = fmaxf(v, dpp_f<0x124>(v)); v = fmaxf(v, dpp_f<0x128>(v));
    return fmaxf(fmaxf(lane_f(v, 0), lane_f(v, 16)), fmaxf(lane_f(v, 32), lane_f(v, 48)));
}
__device__ __forceinline__ float sum8(float v) {
    v += dpp_f<0xB1>(v); v += dpp_f<0x4E>(v); v += dpp_f<0x141>(v); return v;
}
__device__ __forceinline__ float gelu_tanh(float x) {
    const float z = x * (1.0f + 0.044715f * x * x) * (-2.0f * 0.7978845608028654f * 1.4426950408889634f);
    return x * __builtin_amdgcn_rcpf(1.0f + __builtin_amdgcn_exp2f(z));
}
__device__ __forceinline__ f32x2 gelu_tanh2(f32x2 x) {
    f32x2 z = x * (x * x * 0.044715f + 1.0f) * (-2.0f * 0.7978845608028654f * 1.4426950408889634f);
    z.x = fminf(z.x, 60.0f); z.y = fminf(z.y, 60.0f);
    f32x2 d; d.x = __builtin_amdgcn_exp2f(z.x); d.y = __builtin_amdgcn_exp2f(z.y);
    d = d + 1.0f;
    const float r = __builtin_amdgcn_rcpf(d.x * d.y);
    f32x2 sg; sg.x = r * d.y; sg.y = r * d.x;
    return x * sg;
}
__device__ __forceinline__ float sigmoidf_fast(float x) { return __builtin_amdgcn_rcpf(1.0f + __builtin_amdgcn_exp2f(-1.4426950408889634f * x)); }

namespace pg8 {
constexpr int BM = 256, BK = 64, HALF = 128, HTB = HALF * BK * 2, STAGE_BYTES = 8 * HTB;
__host__ __device__ __forceinline__ int lds_byte(int r, int c) { const int st = (r >> 4) * 2 + (c >> 5), rr = r & 15, cc = c & 31, ob = rr * 64 + cc * 2; return st * 1024 + (ob ^ (((ob >> 9) & 1) << 5)); }
__host__ __device__ __forceinline__ void stage_rc(int b, int& R, int& C) { const int st = b / 1024, sb = b % 1024, swz = sb ^ (((sb >> 9) & 1) << 5); R = (st >> 1) * 16 + swz / 64; C = (st & 1) * 32 + (swz % 64) / 2; }
__host__ __device__ __forceinline__ int perm32(int rho) { const int n = rho >> 4, i = rho & 15; return 8 * (i >> 2) + 4 * n + (i & 3); }
struct Unit { int pm, pn, aux, skip, par; };
template <int NN, int WGM = 8> __device__ __forceinline__ void tile_remap(int L, int nM, int& pm, int& pn) {
    const int nwg = nM * NN; int wgid = L;
    { const int q = nwg >> 3, r = nwg & 7, xcd = wgid & 7, off = wgid >> 3; wgid = (xcd < r ? xcd * (q + 1) : r * (q + 1) + (xcd - r) * q) + off; }
    constexpr int nig = WGM * NN; const int gid = wgid / nig, idx = wgid - gid * nig, fm = gid * WGM, left = nM - fm;
    if (left >= WGM) { pm = fm + (idx % WGM); pn = idx / WGM; } else { pm = fm + (idx % left); pn = idx / left; }
}
typedef int i32x8 __attribute__((ext_vector_type(8)));
typedef int i32x4 __attribute__((ext_vector_type(4)));
template <class Epi, class Sched, bool F8 = false, bool PF = false, bool I8 = false, int PID = -1>
__device__ __forceinline__ void gemm_phase(LAS unsigned char* lds, LAS unsigned char* xlds, const int RP, const int RPB, const int nt, const Sched& S, const Epi& E, const int stagger_ticks) {
    int tid_ = threadIdx.x; asm volatile("" : "+v"(tid_));
    const int tid = tid_, wid = __builtin_amdgcn_readfirstlane(tid >> 6), lane = tid & 63, wr = wid >> 2, wc = wid & 3, fr = lane & 15, fq = lane >> 4;
    int Rr[2], Cc[2]; unsigned voffB[2];
#pragma unroll
    for (int i = 0; i < 2; ++i) { int R, C; stage_rc(tid * 16 + i * 8192, R, C); Rr[i] = R; Cc[i] = C; const int Rb = Epi::PERM ? ((R & ~31) + perm32(R & 31)) : R; voffB[i] = (unsigned)(Rb * RPB + C * 2); }
    const size_t kstep = (size_t)(BK * 2);
    const size_t hstep = (size_t)HALF * RP, hstepB = (size_t)HALF * RPB;
    const unsigned ldsw = (unsigned)wid * 1024u;
    const unsigned ldsb0 = (unsigned)__builtin_amdgcn_readfirstlane((int)(unsigned)(size_t)lds) + ldsw; const unsigned ldsb = ldsb0;
    const int aoff = lds_byte(wr * 64 + fr, fq * 8), boff = lds_byte(wc * 32 + fr, fq * 8);
    const unsigned voffP = (unsigned)((32 * wid + (lane & 31)) * RP + (lane >> 5) * 128);
    const unsigned ldsP = (unsigned)__builtin_amdgcn_readfirstlane((int)(unsigned)(size_t)xlds) + 8192u + (unsigned)wid * 256u;
#define PG8_SA(b, h) (((b) * 2 + (h)) * HTB)
#define PG8_SB(b, h) ((4 + (b) * 2 + (h)) * HTB)
#define PG8_UNI64(p) ((const char*)((((unsigned long long)(unsigned)__builtin_amdgcn_readfirstlane((int)((unsigned long long)(p) >> 32))) << 32) | (unsigned long long)(unsigned)__builtin_amdgcn_readfirstlane((int)(unsigned)(unsigned long long)(p))))
#define PG8_GLDS(gptr, voff32, ldsa) asm volatile("s_mov_b32 m0, %2\n\ts_nop 0\n\tglobal_load_lds_dwordx4 %0, %1" :: "v"(voff32), "s"(gptr), "s"(ldsa) : "memory", "m0")
#define PG8_STAGE(bufoff, gbase, voff) do { PG8_GLDS((const char*)(gbase), (voff)[0], ldsb + (bufoff)); PG8_GLDS((const char*)(gbase), (voff)[1], ldsb + (bufoff) + 8192u); } while (0)
#define PG8_STAGEA(bufoff, gbase, o0, o1) do { PG8_GLDS((const char*)(gbase), (o0), ldsb + (bufoff)); PG8_GLDS((const char*)(gbase), (o1), ldsb + (bufoff) + 8192u); } while (0)
#define PG8_STAGEA1(bufoff, gbase) do { if constexpr (Sched::GATHER) { PG8_STAGEA(bufoff, gbase, vA2, vA3); } else { PG8_STAGEA(bufoff, (gbase) + hstep, vA0, vA1); } } while (0)
#define PG8_LD32(p) __builtin_shufflevector(*(const LAS i32x4*)(p), *(const LAS i32x4*)((p) + 1024), 0, 1, 2, 3, 4, 5, 6, 7)
#define PG8_LDA(dst, b, h) do { if constexpr (F8) { _Pragma("unroll") for (int m = 0; m < 4; ++m) dst##8[m] = PG8_LD32(lds + PG8_SA(b, h) + aoff + m * 2048); } else { \
        _Pragma("unroll") for (int m = 0; m < 4; ++m) _Pragma("unroll") for (int k = 0; k < 2; ++k) dst[m][k] = *(const LAS bf16x8*)(lds + PG8_SA(b, h) + aoff + m * 2048 + k * 1024); } } while (0)
#define PG8_LDB(dst, b, h) do { if constexpr (F8) { _Pragma("unroll") for (int n = 0; n < 2; ++n) dst##8[n] = PG8_LD32(lds + PG8_SB(b, h) + boff + n * 2048); } else { \
        _Pragma("unroll") for (int n = 0; n < 2; ++n) _Pragma("unroll") for (int k = 0; k < 2; ++k) dst[n][k] = *(const LAS bf16x8*)(lds + PG8_SB(b, h) + boff + n * 2048 + k * 1024); } } while (0)
#define PG8_MMA(ai, bj, At, Bt) do { __builtin_amdgcn_s_setprio(1); if constexpr (F8) { _Pragma("unroll") for (int m = 0; m < 4; ++m) _Pragma("unroll") for (int n = 0; n < 2; ++n) \
        acc[ai][bj][m][n] = __builtin_amdgcn_mfma_scale_f32_16x16x128_f8f6f4(Bt##8[n], At##8[m], acc[ai][bj][m][n], 0, 0, 0, 0, 0, 0); } else {         \
        _Pragma("unroll") for (int m = 0; m < 4; ++m) _Pragma("unroll") for (int n = 0; n < 2; ++n) _Pragma("unroll") for (int k = 0; k < 2; ++k) \
        { if constexpr (I8) acc[ai][bj][m][n] = __builtin_bit_cast(f32x4, __builtin_amdgcn_mfma_i32_16x16x64_i8(__builtin_bit_cast(i32x4, Bt[n][k]), __builtin_bit_cast(i32x4, At[m][k]), __builtin_bit_cast(i32x4, acc[ai][bj][m][n]), 0, 0, 0)); \
          else acc[ai][bj][m][n] = __builtin_amdgcn_mfma_f32_16x16x32_bf16(Bt[n][k], At[m][k], acc[ai][bj][m][n], 0, 0, 0); } } __builtin_amdgcn_s_setprio(0); } while (0)
#define PG8_ZERO_ACC() do { f32x2 z2_ = (f32x2){0.f, 0.f}; asm volatile("s_nop 7" : "+v"(z2_)); _Pragma("unroll") for (int a = 0; a < 2; ++a) _Pragma("unroll") for (int b = 0; b < 2; ++b) _Pragma("unroll") for (int m = 0; m < 4; ++m) _Pragma("unroll") for (int n = 0; n < 2; ++n) \
        asm volatile("v_mfma_f32_4x4x4_16b_f16 %0, %1, %1, 0" : "=&v"(acc[a][b][m][n]) : "v"(z2_)); asm volatile("s_nop 7\n\ts_nop 7" ::: "memory"); } while (0)
#define PG8_WAIT_V(n) asm volatile("s_waitcnt vmcnt(" #n ")" ::: "memory")
#define PG8_WAIT_VR() PG8_WAIT_V(8)
#define PG8_WAIT_VX() do { if (relax) asm volatile("s_waitcnt vmcnt(%0)" :: "n"(8 + Epi::RELAX) : "memory"); else PG8_WAIT_V(8); } while (0)
#define PG8_WAIT_L(n) asm volatile("s_waitcnt lgkmcnt(" #n ")" ::: "memory")
#define PG8_BAR __builtin_amdgcn_s_barrier()
#define PG8_SCHED __builtin_amdgcn_sched_barrier(0)
    Unit cur, nxt; int ui = 0; bool epi_ran = false;
    constexpr bool PROF = (PROF_PH != 0) && (PID == PROF_PH);
    unsigned prof_acc = 0, prof_t0 = 0;
#define PROF_BEGIN(sel) do { if constexpr (PROF && PROF_SEL == (sel)) prof_t0 = (unsigned)__builtin_amdgcn_s_memrealtime(); } while (0)
#define PROF_END(sel) do { if constexpr (PROF && PROF_SEL == (sel)) prof_acc += (unsigned)__builtin_amdgcn_s_memrealtime() - prof_t0; } while (0)
    if (!S.next(0, cur)) return;
    if (stagger_ticks > 0) {
        const unsigned long long t0 = __builtin_amdgcn_s_memrealtime(), dt = (unsigned long long)stagger_ticks;
        while (__builtin_amdgcn_s_memrealtime() - t0 < dt) __builtin_amdgcn_s_sleep(8);
    }
    f32x4 acc[2][2][4][2];
    bf16x8 At[4][2], B0[2][2], B1[2][2]; i32x8 At8[4], B08[2], B18[2];
    unsigned vA0, vA1, vA2, vA3;
    { unsigned v[4]; S.a_offsets(cur, Rr, Cc, RP, v); vA0 = v[0]; vA1 = v[1]; vA2 = v[2]; vA3 = v[3]; }
    const char* cA = PG8_UNI64(S.Abase(cur)); const char* cB = PG8_UNI64(S.Bbase(cur));
    bool has_next = S.next(1, nxt);
    if constexpr (Epi::BIAS_DMA) E.bias_dma(cur, xlds + 8192, wid, lane);
    const char* nA = cA; const char* nB = cB;
    LAS u32x4* nslot = (LAS u32x4*)(xlds) + tid;
    if (has_next) { nA = PG8_UNI64(S.Abase(nxt)); nB = PG8_UNI64(S.Bbase(nxt)); }
    if (Sched::GATHER) { unsigned v[4] = {vA0, vA1, vA2, vA3}; if (has_next) S.a_offsets(nxt, Rr, Cc, RP, v); *nslot = (u32x4){v[0], v[1], v[2], v[3]}; }
    PG8_ZERO_ACC();
    PG8_STAGE(PG8_SB(0, 0), cB, voffB); PG8_STAGE(PG8_SB(0, 1), cB + hstepB, voffB); PG8_STAGEA(PG8_SA(0, 0), cA, vA0, vA1); PG8_STAGEA1(PG8_SA(0, 1), cA);
    if (wr == 1) PG8_BAR;
    PG8_WAIT_V(2); PG8_BAR;
    PG8_STAGE(PG8_SB(1, 0), cB + kstep, voffB); PG8_STAGEA(PG8_SA(1, 0), cA + kstep, vA0, vA1); PG8_STAGE(PG8_SB(1, 1), cB + hstepB + kstep, voffB);
    PG8_WAIT_V(6); PG8_BAR;
    for (;;) {
        PROF_BEGIN(1);
#pragma unroll 1
        for (int t = 0; t < nt; t += 2) {
            const bool last = (t == nt - 2);
            unsigned ldsb = ldsb0; asm volatile("" : "+s"(ldsb));
            const char* a1 = cA + (size_t)(t + 1) * kstep;
            const char* a2 = last ? nA : cA + (size_t)(t + 2) * kstep; const char* b2 = last ? nB : cB + (size_t)(t + 2) * kstep;
            const char* a3 = a2 + kstep; const char* b3 = b2 + kstep;
            if constexpr (PF) { const char* pfa = (t + 4 < nt) ? cA + (size_t)(t + 4) * kstep : nA + (size_t)(t + 4 - nt) * kstep;
                asm volatile("s_mov_b32 m0, %2\n\ts_nop 0\n\tglobal_load_lds_dword %0, %1" :: "v"(voffP), "s"(pfa), "s"(ldsP) : "memory", "m0"); }
            const bool relax = (Epi::RELAX > 0) && (t == 0) && epi_ran;
            PG8_LDB(B0, 0, 0); PG8_LDB(B1, 0, 1); PG8_SCHED; PG8_LDA(At, 0, 0); PG8_STAGEA1(PG8_SA(1, 1), a1);
            if (Sched::GATHER) { if (last) { const u32x4 nv = *nslot; vA0 = nv.x; vA1 = nv.y; vA2 = nv.z; vA3 = nv.w; } }
            PG8_WAIT_VX(); PG8_WAIT_L(0); PG8_BAR; PG8_MMA(0, 0, At, B0); PG8_MMA(0, 1, At, B1); PG8_BAR; PG8_SCHED;
            if constexpr (Epi::BIAS_DMA) { if (t == 0 && has_next) E.bias_dma(nxt, xlds + 8192 + ((ui + 1) & 1) * Epi::BIAS_STRIDE, wid, lane); }
            PG8_LDA(At, 0, 1); PG8_STAGE(PG8_SB(0, 0), b2, voffB); PG8_STAGE(PG8_SB(0, 1), b2 + hstepB, voffB); PG8_STAGEA(PG8_SA(0, 0), a2, vA0, vA1);
            PG8_WAIT_VX(); PG8_WAIT_L(0); PG8_BAR; PG8_MMA(1, 0, At, B0); PG8_MMA(1, 1, At, B1); PG8_BAR; PG8_SCHED;
            PG8_LDB(B0, 1, 0); PG8_LDB(B1, 1, 1); PG8_SCHED; PG8_LDA(At, 1, 0); PG8_STAGEA1(PG8_SA(0, 1), a2);
            PG8_WAIT_VR(); PG8_WAIT_L(0); PG8_BAR; PG8_MMA(0, 0, At, B0); PG8_MMA(0, 1, At, B1); PG8_BAR; PG8_SCHED;
            PG8_LDA(At, 1, 1); PG8_STAGE(PG8_SB(1, 0), b3, voffB); PG8_STAGE(PG8_SB(1, 1), b3 + hstepB, voffB); PG8_STAGEA(PG8_SA(1, 0), a3, vA0, vA1);
            PG8_WAIT_VR(); PG8_WAIT_L(0); PG8_BAR; PG8_MMA(1, 0, At, B0); PG8_MMA(1, 1, At, B1); PG8_BAR; PG8_SCHED;
        }
        PROF_END(1); PROF_BEGIN(3);
        if (wr == 0) PG8_BAR;
        Unit nn; bool has_nn = false; unsigned gv[4] = {vA0, vA1, vA2, vA3};
        if (has_next) { has_nn = S.next(ui + 2, nn); if (Sched::GATHER) { if (has_nn) S.a_offsets(nn, Rr, Cc, RP, gv); } }
        cur.par = ui & 1;
        PROF_END(3); PROF_BEGIN(2);
        if (!cur.skip) { const int t2 = opaque((int)threadIdx.x), fr2 = t2 & 15, fq2 = (t2 >> 4) & 3; E(acc, cur, wr, wc, fr2, fq2); }
        epi_ran = !cur.skip;
        PROF_END(2);
        if (!has_next) break;
        PROF_BEGIN(3);
        cur = nxt; cA = nA; cB = nB; ++ui;
        has_next = has_nn; nxt = nn;
        if (has_next) { nA = PG8_UNI64(S.Abase(nxt)); nB = PG8_UNI64(S.Bbase(nxt)); }
        if (Sched::GATHER) { *nslot = (u32x4){gv[0], gv[1], gv[2], gv[3]}; asm volatile("" ::: "memory"); }
        PG8_ZERO_ACC();
        if (wr == 1) PG8_BAR;
        PROF_END(3);
    }
    PG8_WAIT_V(0);
    PG8_BAR;
    if constexpr (PROF) { const unsigned t0 = (unsigned)__builtin_amdgcn_s_memrealtime(); while ((unsigned)__builtin_amdgcn_s_memrealtime() - t0 < prof_acc * PROF_MULT) __builtin_amdgcn_s_sleep(8); }
#undef PROF_BEGIN
#undef PROF_END
#undef PG8_SA
#undef PG8_SB
#undef PG8_STAGE
#undef PG8_STAGEA
#undef PG8_STAGEA1
#undef PG8_GLDS
#undef PG8_UNI64
#undef PG8_LDA
#undef PG8_LD32
#undef PG8_LDB
#undef PG8_MMA
#undef PG8_ZERO_ACC
#undef PG8_WAIT_V
#undef PG8_WAIT_VR
#undef PG8_WAIT_VX
#undef PG8_WAIT_L
#undef PG8_BAR
#undef PG8_SCHED
}
}

#define XB_TMO      128
#define XB_XCNT(j)  (256  + 64 * (j))
#define XB_XSUB(j)  (1280 + 64 * (j))
#define XB_XGEN(j)  (2304 + 64 * (j))
#define XB_TOP      3328
#define XB_TOPGEN   3392
#define XCD_BAR_WORDS 3456
#define XB_SPIN_CAP (1u << 18)
__device__ __forceinline__ unsigned xb_ld(unsigned* p)              { return __hip_atomic_load(p, __ATOMIC_RELAXED, __HIP_MEMORY_SCOPE_AGENT); }
__device__ __forceinline__ unsigned xb_add(unsigned* p, unsigned v) { return __hip_atomic_fetch_add(p, v, __ATOMIC_RELAXED, __HIP_MEMORY_SCOPE_AGENT); }
__device__ __forceinline__ unsigned xb_xcc_id() { return (unsigned)__builtin_amdgcn_s_getreg((3 << 11) | 20) & 0xFu; }
#define XB_SPIN(cond, bar) do { unsigned _sp = 0; while (cond) { __builtin_amdgcn_s_sleep(1); \
    if ((++_sp & 255u) == 0u) { if (xb_ld(&(bar)[XB_TMO])) break; if (_sp > XB_SPIN_CAP) { atomicAdd(&(bar)[XB_TMO], 1u); break; } } } } while (0)
struct XcdBarrier { unsigned* bar; unsigned x; volatile LAS unsigned* st; };
__device__ __forceinline__ XcdBarrier xcd_barrier_post(unsigned* bar, volatile LAS unsigned* st) {
    XcdBarrier b; b.bar = bar; b.x = xb_xcc_id(); b.st = st;
    if (threadIdx.x == 0) (void)xb_add(&bar[XB_XCNT(b.x)], 1u);
    return b;
}
__device__ __forceinline__ void xcd_barrier_complete(unsigned* bar, unsigned x, unsigned& nloc, unsigned& nx) {
    const unsigned G = gridDim.x * gridDim.y * gridDim.z;
    unsigned sum, cnt, mine, sp = 0u;
    for (;;) {
        sum = 0u; cnt = 0u; mine = 0u;
#pragma unroll
        for (unsigned j = 0; j < 16; ++j) { const unsigned c = xb_ld(&bar[XB_XCNT(j)]); sum += c; cnt += (c > 0u) ? 1u : 0u; mine = (j == x) ? c : mine; }
        if (sum == G) break;
        __builtin_amdgcn_s_sleep(1);
        if ((++sp & 255u) == 0u) { if (xb_ld(&bar[XB_TMO])) break; if (sp > XB_SPIN_CAP) { atomicAdd(&bar[XB_TMO], 1u); break; } }
    }
    nloc = mine > 0u ? mine : 1u; nx = cnt > 0u ? cnt : 1u;
}
__device__ __forceinline__ void xcd_barrier(const XcdBarrier& b) {
    asm volatile("s_waitcnt vmcnt(0)" ::: "memory");
    __syncthreads();
    if (threadIdx.x == 0) {
        unsigned* bar = b.bar;
        __builtin_amdgcn_s_waitcnt(0);
        unsigned nloc = b.st[0], nx = b.st[1];
        if (nloc == 0u) { xcd_barrier_complete(bar, b.x, nloc, nx); b.st[0] = nloc; b.st[1] = nx; }
        const unsigned old = xb_add(&bar[XB_XSUB(b.x)], 1u);
        const unsigned gen = old / nloc;
        if (old + 1u == (gen + 1u) * nloc) {
            __builtin_amdgcn_fence(__ATOMIC_RELEASE, "agent");
            asm volatile("s_waitcnt vmcnt(0)" ::: "memory");
            const unsigned og = xb_add(&bar[XB_TOP], 1u);
            const unsigned tg = og / nx;
            if (og + 1u == (tg + 1u) * nx) xb_add(&bar[XB_TOPGEN], 1u);
            else XB_SPIN(xb_ld(&bar[XB_TOPGEN]) == tg, bar);
            __builtin_amdgcn_fence(__ATOMIC_ACQUIRE, "agent");
            xb_add(&bar[XB_XGEN(b.x)], 1u);
            asm volatile("s_waitcnt vmcnt(0)" ::: "memory");
        } else {
            XB_SPIN(xb_ld(&bar[XB_XGEN(b.x)]) == gen, bar);
            __builtin_amdgcn_fence(__ATOMIC_ACQUIRE, "agent");
            asm volatile("s_waitcnt vmcnt(0)" ::: "memory");
        }
    }
    __syncthreads();
}

struct Frame {
    LAS unsigned char* lds;
    volatile LAS unsigned* MISC;
    gu32* ctl;
    int tid, lane, wave, G, c;
    unsigned char* ws;
};
struct Args { const float* in[26]; float* out; unsigned char* ws; int ph_lo, ph_hi; };

__device__ __forceinline__ void p0_transpose_item(const float* W, int ldw, int csrc0, int k0, const float* gain, bf16* WT, int Kd, int drow0, LAS float* scr, int lane) {
    { f32x4 v[8]; const int r8 = lane >> 3, c4 = (lane & 7) * 4;
#pragma unroll
      for (int i = 0; i < 8; ++i) v[i] = *(const GAS f32x4*)(W + (size_t)(k0 + 8 * i + r8) * ldw + csrc0 + c4);
#pragma unroll
      for (int i = 0; i < 8; ++i) { const int kk = 8 * i + r8; const float g = gain ? gain[k0 + kk] : 1.0f; scr[kk * 33 + c4] = v[i][0] * g; scr[kk * 33 + c4 + 1] = v[i][1] * g; scr[kk * 33 + c4 + 2] = v[i][2] * g; scr[kk * 33 + c4 + 3] = v[i][3] * g; } }
    LDS_WAIT(); asm volatile("" ::: "memory");
    const int c = lane & 7;
#pragma unroll
    for (int j = 0; j < 4; ++j) { const int n = (lane >> 3) + 8 * j; const LAS float* s = scr + (8 * c) * 33 + n;
        u32x4 o; o.x = pk2(s[0 * 33], s[1 * 33]); o.y = pk2(s[2 * 33], s[3 * 33]); o.z = pk2(s[4 * 33], s[5 * 33]); o.w = pk2(s[6 * 33], s[7 * 33]);
        *(GAS u32x4*)(WT + (size_t)(drow0 + n) * Kd + k0 + 8 * c) = o; }
    LDS_WAIT(); asm volatile("" ::: "memory");
}

__device__ __forceinline__ void p0_transpose_item_f8(const float* W, int ldw, int csrc0, int k0, const float* gain, float scale, unsigned char* WT, int Kd, int drow0, LAS float* scr, int lane) {
    { f32x4 v[8]; const int r8 = lane >> 3, c4 = (lane & 7) * 4;
#pragma unroll
      for (int i = 0; i < 8; ++i) v[i] = *(const GAS f32x4*)(W + (size_t)(k0 + 8 * i + r8) * ldw + csrc0 + c4);
#pragma unroll
      for (int i = 0; i < 8; ++i) { const int kk = 8 * i + r8; const float g = gain ? gain[k0 + kk] * scale : scale; scr[kk * 33 + c4] = v[i][0] * g; scr[kk * 33 + c4 + 1] = v[i][1] * g; scr[kk * 33 + c4 + 2] = v[i][2] * g; scr[kk * 33 + c4 + 3] = v[i][3] * g; } }
    LDS_WAIT(); asm volatile("" ::: "memory");
    const int c = lane & 7;
#pragma unroll
    for (int j = 0; j < 4; ++j) { const int n = (lane >> 3) + 8 * j; const LAS float* s = scr + (8 * c) * 33 + n;
        *(GAS u32x2*)(WT + (size_t)(drow0 + n) * Kd + k0 + 8 * c) = (u32x2){pk4_fp8(s[0 * 33], s[1 * 33], s[2 * 33], s[3 * 33]), pk4_fp8(s[4 * 33], s[5 * 33], s[6 * 33], s[7 * 33])}; }
    LDS_WAIT(); asm volatile("" ::: "memory");
}
__device__ __forceinline__ void p0_colmax_item(const float* W, int ldw, int csrc0, int k0, gu32* cmax, int lane) {
    const int r8 = lane >> 3, c4 = (lane & 7) * 4; f32x4 v[8];
#pragma unroll
    for (int i = 0; i < 8; ++i) v[i] = *(const GAS f32x4*)(W + (size_t)(k0 + 8 * i + r8) * ldw + csrc0 + c4);
    float m0 = 0.f, m1 = 0.f, m2 = 0.f, m3 = 0.f;
#pragma unroll
    for (int i = 0; i < 8; ++i) { m0 = fmaxf(m0, fabsf(v[i].x)); m1 = fmaxf(m1, fabsf(v[i].y)); m2 = fmaxf(m2, fabsf(v[i].z)); m3 = fmaxf(m3, fabsf(v[i].w)); }
#pragma unroll
    for (int o = 8; o < 64; o <<= 1) { m0 = fmaxf(m0, __shfl_xor(m0, o)); m1 = fmaxf(m1, __shfl_xor(m1, o)); m2 = fmaxf(m2, __shfl_xor(m2, o)); m3 = fmaxf(m3, __shfl_xor(m3, o)); }
    if (lane < 8) { unsigned* cm = (unsigned*)(cmax + c4);
        (void)__hip_atomic_fetch_max(cm + 0, __builtin_bit_cast(unsigned, m0), RLX_AGENT); (void)__hip_atomic_fetch_max(cm + 1, __builtin_bit_cast(unsigned, m1), RLX_AGENT);
        (void)__hip_atomic_fetch_max(cm + 2, __builtin_bit_cast(unsigned, m2), RLX_AGENT); (void)__hip_atomic_fetch_max(cm + 3, __builtin_bit_cast(unsigned, m3), RLX_AGENT); }
}
__device__ __forceinline__ void p0_transpose_item_i8(const float* W, int ldw, int csrc0, int k0, gu32* cmax, float* sbout, unsigned char* WT, int Kd, int drow0, LAS float* scr, int lane) {
    { f32x4 v[8]; const int r8 = lane >> 3, c4 = (lane & 7) * 4;
#pragma unroll
      for (int i = 0; i < 8; ++i) v[i] = *(const GAS f32x4*)(W + (size_t)(k0 + 8 * i + r8) * ldw + csrc0 + c4);
      f32x4 sc;
#pragma unroll
      for (int c = 0; c < 4; ++c) { const float mx = __builtin_bit_cast(float, __hip_atomic_load((unsigned*)(cmax + c4 + c), RLX_AGENT)); sc[c] = mx > 0.f ? 127.0f / mx : 0.f; if (k0 == 0 && r8 == 0) sbout[c4 + c] = mx * (1.0f / 127.0f); }
#pragma unroll
      for (int i = 0; i < 8; ++i) { const int kk = 8 * i + r8; scr[kk * 33 + c4] = v[i][0] * sc[0]; scr[kk * 33 + c4 + 1] = v[i][1] * sc[1]; scr[kk * 33 + c4 + 2] = v[i][2] * sc[2]; scr[kk * 33 + c4 + 3] = v[i][3] * sc[3]; } }
    LDS_WAIT(); asm volatile("" ::: "memory");
    const int c = lane & 7;
#pragma unroll
    for (int j = 0; j < 4; ++j) { const int n = (lane >> 3) + 8 * j; const LAS float* s = scr + (8 * c) * 33 + n;
        *(GAS u32x2*)(WT + (size_t)(drow0 + n) * Kd + k0 + 8 * c) = (u32x2){pk4_i8(s[0 * 33], s[1 * 33], s[2 * 33], s[3 * 33]), pk4_i8(s[4 * 33], s[5 * 33], s[6 * 33], s[7 * 33])}; }
    LDS_WAIT(); asm volatile("" ::: "memory");
}
__device__ __forceinline__ void p0_prologue(Frame& F, const Args& A) {
    LAS float* scr = (LAS float*)(F.lds + RING_OFF + F.wave * 16384);
    const int gw = F.c * NWAVES + F.wave, NGW = F.G * NWAVES, lane = opaque(F.tid) & 63;
    unsigned char* ws = F.ws;
    constexpr int I_IN = 16 * (NP / 32), I_SQ = 16 * 32, I_KV = 16 * 64, I_EXP = 16 * 32;
    constexpr int NITEMS = 2 * I_SQ + 3 * NE * I_EXP;
    gu32* cmax = F.ctl + CW_CMAX;
    for (int it = gw; it < I_IN + I_KV; it += NGW) {
        if (it < I_IN) { const int kb = it / (NP / 32), nb = it % (NP / 32), n0 = nb * 32; p0_colmax_item(A.in[3], INW, n0 + (n0 >= 1536 ? 8 : 0), kb * 64, cmax + n0, lane); }
        else { const int r = it - I_IN; p0_colmax_item(A.in[14], 2 * D, (r % 64) * 32, (r / 64) * 64, cmax + NP + (r % 64) * 32, lane); }
    }
    __builtin_amdgcn_fence(__ATOMIC_RELEASE, "agent");
    __syncthreads();
    if (F.tid == 0) (void)__hip_atomic_fetch_add((unsigned*)(F.ctl + CW_P0CNT), 1u, RLX_AGENT);
#pragma unroll 1
    for (int rep0 = 0; rep0 < P0_REP; ++rep0)
    for (int it = gw; it < NITEMS; it += NGW) {
        int r = it;
        if (r < I_SQ) { p0_transpose_item(A.in[10], D, (r % 32) * 32, (r / 32) * 64, nullptr, (bf16*)(ws + WS_WOUT), D, (r % 32) * 32, scr, lane); continue; } r -= I_SQ;
        if (r < I_SQ) { p0_transpose_item(A.in[15], D, (r % 32) * 32, (r / 32) * 64, nullptr, (bf16*)(ws + WS_WXO), D, (r % 32) * 32, scr, lane); continue; } r -= I_SQ;
        const int which = r / (NE * I_EXP); r -= which * (NE * I_EXP);
        const int e = r / I_EXP, q = r % I_EXP, kb = q / 32, nb = q % 32, n0 = nb * 32;
        if (which == 2) p0_transpose_item_f8(A.in[23] + (size_t)e * FF * D, D, n0, kb * 64, nullptr, 64.0f, ws + WS_WD, FF, e * D + n0, scr, lane);
        else { const int p = n0 >> 7, drow = e * 2048 + p * 256 + which * 128 + (n0 & 127);
               p0_transpose_item_f8(A.in[which == 0 ? 19 : 21] + (size_t)e * D * FF, FF, n0, kb * 64, A.in[16], 64.0f, ws + WS_WGU, D, drow, scr, lane); }
    }
    { const float* wq = A.in[13]; const float* gx = A.in[11]; bf16* o = (bf16*)(ws + WS_WQ);
      for (int i = (F.c * NTHREADS + F.tid); i < D * D / 8; i += F.G * NTHREADS) { const f32x4 a = *(const GAS f32x4*)(wq + 8 * (size_t)i), b2 = *(const GAS f32x4*)(wq + 8 * (size_t)i + 4); const float g = gx[i >> 7] * (1.0f / 16.0f);
          *(GAS u32x4*)(o + 8 * (size_t)i) = (u32x4){pk2(a[0] * g, a[1] * g), pk2(a[2] * g, a[3] * g), pk2(b2[0] * g, b2[1] * g), pk2(b2[2] * g, b2[3] * g)}; } }
    { const float* wr = A.in[17]; const float* gm = A.in[16]; unsigned char* o = ws + WS_WR;
      for (int i = (F.c * NTHREADS + F.tid); i < 64 * 128; i += F.G * NTHREADS) { const int rho = i >> 7, ch = i & 127, e = rho & 31; unsigned pk[4];
#pragma unroll
          for (int j = 0; j < 4; ++j) { float v0 = wr[(size_t)(8 * ch + 2 * j) * NE + e] * gm[8 * ch + 2 * j], v1 = wr[(size_t)(8 * ch + 2 * j + 1) * NE + e] * gm[8 * ch + 2 * j + 1];
              const unsigned h0 = f2bf(v0), h1 = f2bf(v1); if (rho >= 32) { v0 -= bf2f(h0); v1 -= bf2f(h1); pk[j] = pk2(v0, v1); } else pk[j] = h0 | (h1 << 16); }
          *(GAS u32x4*)(o + rho * 2048 + ((ch ^ (rho & 15)) << 4)) = (u32x4){pk[0], pk[1], pk[2], pk[3]}; } }
    if (F.tid == 0) { unsigned sp = 0; while (__hip_atomic_load((unsigned*)(F.ctl + CW_P0CNT), RLX_AGENT) < (unsigned)F.G) { __builtin_amdgcn_s_sleep(2); if (++sp > (1u << 22)) break; } }
    __syncthreads();
    for (int it = gw; it < I_IN + I_KV; it += NGW) {
        if (it < I_IN) { const int kb = it / (NP / 32), nb = it % (NP / 32), n0 = nb * 32; p0_transpose_item_i8(A.in[3], INW, n0 + (n0 >= 1536 ? 8 : 0), kb * 64, cmax + n0, (float*)(ws + WS_SB) + n0, ws + WS_WIN, D, n0, scr, lane); }
        else { const int r = it - I_IN, n0 = (r % 64) * 32; p0_transpose_item_i8(A.in[14], 2 * D, n0, (r / 64) * 64, cmax + NP + n0, (float*)(ws + WS_SBKV) + n0, ws + WS_WKV, D, n0, scr, lane); }
    }
    __syncthreads();
    LAS float* wgs = (LAS float*)(F.lds + RING_OFF);
    for (int i = F.tid; i < 8 * D; i += NTHREADS) { const int k = i >> 3, j = i & 7; wgs[j * D + k] = A.in[3][(size_t)k * INW + 1536 + j]; }
    __syncthreads();
    {
        const float* x = A.in[0]; const float* gmix = A.in[2]; const float* bg = A.in[4];
        unsigned char* xn = ws + WS_R1; float* rsc = (float*)(ws + WS_SA); float* gates = (float*)(ws + WS_GATES);
        f32x4 g[4];
#pragma unroll
        for (int j = 0; j < 4; ++j) g[j] = *(const f32x4*)(gmix + 4 * lane + 256 * j);
#pragma unroll 1
        for (int repx = 0; repx < P0X_REP; ++repx)
        for (int m0 = gw; m0 < T; m0 += 2 * NGW) {
            f32x4 vv[2][4];
#pragma unroll
            for (int rr = 0; rr < 2; ++rr) { const int m = m0 + rr * NGW; const GAS f32x4* xr = (const GAS f32x4*)(x + (size_t)(m < T ? m : m0) * D) + lane;
#pragma unroll
                for (int j = 0; j < 4; ++j) vv[rr][j] = xr[64 * j]; }
#pragma unroll
            for (int rr = 0; rr < 2; ++rr) { const int mraw = m0 + rr * NGW; const bool mvalid = mraw < T; const int m = mvalid ? mraw : m0;
                f32x4 v[4]; float s = 0.f;
#pragma unroll
                for (int j = 0; j < 4; ++j) { v[j] = vv[rr][j]; s += (v[j].x * v[j].x + v[j].y * v[j].y) + (v[j].z * v[j].z + v[j].w * v[j].w); }
                const float r = rsqrtf(wave_sum(s) * (1.f / D) + EPS);
#pragma unroll
                for (int j = 0; j < 4; ++j) v[j] = v[j] * r * g[j];
                { float mx = 0.f;
#pragma unroll
                  for (int j = 0; j < 4; ++j) mx = fmaxf(fmaxf(mx, fmaxf(fabsf(v[j].x), fabsf(v[j].y))), fmaxf(fabsf(v[j].z), fabsf(v[j].w)));
                  mx = wave_max(mx); const float qs = mx > 0.f ? 127.0f / mx : 0.f;
                  GAS unsigned* o4 = (GAS unsigned*)(xn + (size_t)m * D) + lane;
                  if (mvalid) {
#pragma unroll
                  for (int j = 0; j < 4; ++j) o4[64 * j] = pk4_i8s(v[j].x, v[j].y, v[j].z, v[j].w, qs);
                  if (lane == 0) rsc[m] = mx * (1.0f / 127.0f); } }
                float gs[8];
#pragma unroll
                for (int jg = 0; jg < 8; ++jg) { float a = 0.f;
#pragma unroll
                    for (int j = 0; j < 4; ++j) { const f32x4 w = *(const LAS f32x4*)(wgs + jg * D + 4 * lane + 256 * j); a += (v[j].x * w.x + v[j].y * w.y) + (v[j].z * w.z + v[j].w * w.w); }
                    gs[jg] = a; }
                float g4[4], g2[2], g1;
                { const bool hi = (lane & 32) != 0;
#pragma unroll
                  for (int q = 0; q < 4; ++q) { const float keep = hi ? gs[4 + q] : gs[q], send = hi ? gs[q] : gs[4 + q]; g4[q] = keep + __shfl_xor(send, 32); } }
                { const bool hi = (lane & 16) != 0;
#pragma unroll
                  for (int q = 0; q < 2; ++q) { const float keep = hi ? g4[2 + q] : g4[q], send = hi ? g4[q] : g4[2 + q]; g2[q] = keep + __shfl_xor(send, 16); } }
                { const bool hi = (lane & 8) != 0; const float keep = hi ? g2[1] : g2[0], send = hi ? g2[0] : g2[1]; g1 = keep + __shfl_xor(send, 8); }
                g1 = sum8(g1);
                if ((lane & 7) == 0 && mvalid) { const int jg = lane >> 3; const float pre = g1 + bg[jg];
                    const float sc = 15.0f * tanhf(pre * (1.0f / 15.0f));
                    float o = sc;
                    if (jg >= 4) o = -log1pf(expf(-sc));
                    gates[(size_t)m * 8 + jg] = o; }
            }
        }
    }
    {
        const float* x = A.in[1]; const float* gmem = A.in[12]; unsigned char* mn = ws + WS_R3;
        f32x4 g[4];
#pragma unroll
        for (int j = 0; j < 4; ++j) g[j] = *(const f32x4*)(gmem + 4 * lane + 256 * j);
        for (int m = gw; m < TM; m += NGW) {
            const GAS f32x4* xr = (const GAS f32x4*)(x + (size_t)m * D) + lane;
            f32x4 v[4]; float s = 0.f;
#pragma unroll
            for (int j = 0; j < 4; ++j) { v[j] = xr[64 * j]; s += (v[j].x * v[j].x + v[j].y * v[j].y) + (v[j].z * v[j].z + v[j].w * v[j].w); }
            const float r = rsqrtf(wave_sum(s) * (1.f / D) + EPS);
#pragma unroll
            for (int j = 0; j < 4; ++j) v[j] = v[j] * r * g[j];
            float mx = 0.f;
#pragma unroll
            for (int j = 0; j < 4; ++j) mx = fmaxf(fmaxf(mx, fmaxf(fabsf(v[j].x), fabsf(v[j].y))), fmaxf(fabsf(v[j].z), fabsf(v[j].w)));
            mx = wave_max(mx); const float qs = mx > 0.f ? 127.0f / mx : 0.f;
            GAS unsigned* o4 = (GAS unsigned*)(mn + (size_t)m * D) + lane;
#pragma unroll
            for (int j = 0; j < 4; ++j) o4[64 * j] = pk4_i8s(v[j].x, v[j].y, v[j].z, v[j].w, qs);
            if (lane == 0) ((float*)(ws + WS_SAM))[m] = mx * (1.0f / 127.0f);
        }
    }
}

constexpr size_t TS1K = (size_t)256 * 1024 * 2;
constexpr size_t TSF8 = (size_t)256 * 1024;
#ifndef P1_WGM
#define P1_WGM 8
#endif
struct P1Order {
    static constexpr bool GATHER = false;
    int G, c; const char* ws;
    __device__ __forceinline__ bool next(int i, pg8::Unit& u) const {
        const int L = i * G + c; if (L >= 2816) return false;
        int pm, pn, aux;
        if (L < 2560) { pg8::tile_remap<10, P1_WGM>(L, 256, pm, pn); pm = 255 - pm; aux = 0; }
        else { const int Lp = L - 2560; aux = 1; pm = Lp >> 3; pn = Lp & 7; }
        u.pm = pm; u.pn = pn; u.aux = aux; u.skip = 0;
        return true;
    }
    __device__ __forceinline__ const char* Abase(const pg8::Unit& u) const { size_t o = WS_R1; if (u.aux == 1) o = WS_R3; return ws + o + (size_t)u.pm * TSF8; }
    __device__ __forceinline__ const char* Bbase(const pg8::Unit& u) const { size_t o = WS_WIN; if (u.aux == 1) o = WS_WKV; return ws + o + (size_t)u.pn * TSF8; }
    __device__ __forceinline__ void a_offsets(const pg8::Unit&, const int (&R)[2], const int (&C)[2], int RP, unsigned (&v)[4]) const {
#pragma unroll
        for (int h = 0; h < 2; ++h)
#pragma unroll
            for (int i = 0; i < 2; ++i) v[h * 2 + i] = (unsigned)((h * 128 + R[i]) * RP + C[i] * 2); }
};
struct PlainOrder {
    static constexpr bool GATHER = false;
    int G, c, nM, nN; const char *A, *Bt; int bsel; unsigned ts; int rev;
    __device__ __forceinline__ bool next(int i, pg8::Unit& u) const { const int L = i * G + c; if (L >= nM * 4) return false; int pm, pn; pg8::tile_remap<4>(L, nM, pm, pn); if (rev) pm = nM - 1 - pm; u.pm = pm; u.pn = pn; u.aux = 0; u.skip = 0; return true; }
    __device__ __forceinline__ const char* Abase(const pg8::Unit& u) const { return A + (size_t)u.pm * ts; }
    __device__ __forceinline__ const char* Bbase(const pg8::Unit& u) const { return Bt + (size_t)((u.pm >> 3) * bsel * 4 + u.pn) * ts; }
    __device__ __forceinline__ void a_offsets(const pg8::Unit&, const int (&R)[2], const int (&C)[2], int RP, unsigned (&v)[4]) const {
#pragma unroll
        for (int h = 0; h < 2; ++h)
#pragma unroll
            for (int i = 0; i < 2; ++i) v[h * 2 + i] = (unsigned)((h * 128 + R[i]) * RP + C[i] * 2); }
};
template <int WHICH> struct PreOrder {
    static constexpr bool GATHER = false;
    int first, stride, nmine; const char* ws;
    __device__ __forceinline__ bool next(int i, pg8::Unit& u) const { const int L = first + i * stride; if (i >= nmine || L >= 512) return false; u.pm = L & 3; u.pn = (L >> 2) & 3; u.aux = L >> 4; u.skip = 0; return true; }
    __device__ __forceinline__ const char* Abase(const pg8::Unit& u) const { return WHICH == 0 ? ws + WS_KM + (size_t)u.aux * 256 * 4096 + u.pn * 512 : ws + WS_WXO + (size_t)u.pm * 256 * 2048 + u.pn * 512; }
    __device__ __forceinline__ const char* Bbase(const pg8::Unit& u) const { return WHICH == 0 ? ws + WS_WQ + (size_t)u.pm * 256 * 2048 + u.pn * 512 : ws + WS_KM + (size_t)u.aux * 256 * 4096 + 2048 + u.pn * 512; }
    __device__ __forceinline__ void a_offsets(const pg8::Unit&, const int (&R)[2], const int (&C)[2], int RP, unsigned (&v)[4]) const {
#pragma unroll
        for (int h = 0; h < 2; ++h)
#pragma unroll
            for (int i = 0; i < 2; ++i) v[h * 2 + i] = (unsigned)((h * 128 + R[i]) * RP + C[i] * 2); }
};
template <bool GATH, int NN>
struct MoeOrder {
    static constexpr bool GATHER = GATH;
    int G, c, NT; const LAS int* tpre; const char* ws;
    __device__ __forceinline__ bool next(int i, pg8::Unit& u) const {
        const int L = i * G + c; if (L >= NT * NN) return false; pg8::tile_remap<NN>(L, NT, u.pm, u.pn);
        if (!GATH) u.pm = NT - 1 - u.pm;
        u.aux = __builtin_amdgcn_readfirstlane((int)((const LAS unsigned char*)tpre + 11264)[u.pm]); u.skip = 0; return true; }
    __device__ __forceinline__ const char* Abase(const pg8::Unit& u) const { if (GATH) return ws + WS_XQ; return ws + WS_H2 + (size_t)u.pm * TSF8; }
    __device__ __forceinline__ const char* Bbase(const pg8::Unit& u) const { return ws + (GATH ? WS_WGU : WS_WD) + (size_t)(u.aux * NN + u.pn) * TSF8; }
    __device__ __forceinline__ void a_offsets(const pg8::Unit& u, const int (&R)[2], const int (&C)[2], int RP, unsigned (&v)[4]) const {
        if (GATH) { const int base = (u.pm - tpre[u.aux]) * 256, cnt = tpre[40 + u.aux]; const int* lpid = (const int*)(ws + WS_LPID);
#pragma unroll
            for (int h = 0; h < 2; ++h)
#pragma unroll
                for (int i = 0; i < 2; ++i) { const int pos = base + h * 128 + R[i]; const int pid = lpid[u.aux * LISTCAP + (pos < cnt ? pos : 0)]; v[h * 2 + i] = (unsigned)((pid >> 2) * RP + C[i] * 2); }
        } else {
#pragma unroll
            for (int h = 0; h < 2; ++h)
#pragma unroll
                for (int i = 0; i < 2; ++i) v[h * 2 + i] = (unsigned)((h * 128 + R[i]) * RP + C[i] * 2); } }
};

#ifndef STAGGER_TICKS
#define STAGGER_TICKS 0
#endif
#ifndef EPI_TWICE_P1
#define EPI_TWICE_P1 false
#endif
#ifndef P7_REP
#define P7_REP 1
#endif
#ifndef P2_PROBE
#define P2_PROBE 0
#endif
#ifndef KTWICE_MASK
#define KTWICE_MASK 0
#endif
template <class Base, bool TW> struct Twice : Base {
    __device__ __forceinline__ bool next(int i, pg8::Unit& u) const { if (!TW) { const bool r = Base::next(i, u); u.skip = 0; return r; } const bool r = Base::next(i >> 1, u); u.skip = !(i & 1); return r; }
};
struct EpiP1 {
    static constexpr int NST = 16; static constexpr int RELAX = RELAX_P1; static constexpr bool TWICE = EPI_TWICE_P1; static constexpr bool BIAS_DMA = true; static constexpr int BIAS_STRIDE = 2048;
    static constexpr bool PERM = true;
    unsigned char* ws; LAS unsigned char* btab;
    __device__ __forceinline__ void bias_dma(const pg8::Unit& u, LAS unsigned char* tab, int wid, int lane) const {
        size_t so = WS_SA, co = WS_SB; if (u.aux == 1) { so = WS_SAM; co = WS_SBKV; }
        const float* src = (const float*)(ws + co) + u.pn * 256 + wid * 64; if (wid >= 4) src = (const float*)(ws + so) + u.pm * 256 + (wid - 4) * 64;
        const float* srcu = (const float*)((((unsigned long long)(unsigned)__builtin_amdgcn_readfirstlane((int)((unsigned long long)src >> 32))) << 32) | (unsigned long long)(unsigned)__builtin_amdgcn_readfirstlane((int)(unsigned)(unsigned long long)src));
        const unsigned la = (unsigned)__builtin_amdgcn_readfirstlane((int)(unsigned)(size_t)tab) + (unsigned)wid * 256u; const unsigned vo = (unsigned)lane * 4u;
        asm volatile("s_mov_b32 m0, %2\n\ts_nop 0\n\tglobal_load_lds_dword %0, %1" :: "v"(vo), "s"(srcu), "s"(la) : "memory", "m0"); }
    __device__ __forceinline__ void operator()(const f32x4 (&acc)[2][2][4][2], const pg8::Unit& u, int wr, int wc, int fr, int fq) const {
        const int row0 = u.pm * 256 + wr * 64 + fr, col0 = u.pn * 256 + wc * 32 + 8 * fq;
        size_t bo = WS_PROJ; int ld = NP; if (u.aux == 1) { bo = WS_KM; ld = 2 * D; }
        bf16* base = (bf16*)(ws + bo);
        const bool act = (u.aux == 0 && u.pn >= 6);
        f32x4 cb[2][2]; float ra[2][4];
        { const LAS float* sb = (const LAS float*)(btab + u.par * 2048) + wc * 32 + 8 * fq; const LAS float* sa = (const LAS float*)(btab + u.par * 2048 + 1024) + wr * 64 + fr;
#pragma unroll
          for (int bj = 0; bj < 2; ++bj) { cb[bj][0] = *(const LAS f32x4*)(sb + bj * 128); cb[bj][1] = *(const LAS f32x4*)(sb + bj * 128 + 4); }
#pragma unroll
          for (int ai = 0; ai < 2; ++ai)
#pragma unroll
              for (int m = 0; m < 4; ++m) ra[ai][m] = sa[ai * 128 + m * 16]; }
#if NOISE_PROBE
        float nss = 0.f;
#pragma unroll
        for (int ai = 0; ai < 2; ++ai)
#pragma unroll
            for (int bj = 0; bj < 2; ++bj)
#pragma unroll
                for (int m = 0; m < 4; ++m)
#pragma unroll
                    for (int n = 0; n < 2; ++n) { const f32x4 a = acc[ai][bj][m][n]; nss += (a[0] * a[0] + a[1] * a[1]) + (a[2] * a[2] + a[3] * a[3]); }
        const float nsc = sqrtf(nss * (1.0f / 128.0f)) * (NOISE_PROBE * 0.0001f * 3.4641016f) * (1.0f / 16777216.0f);
#endif
#pragma unroll
        for (int ai = 0; ai < 2; ++ai)
#pragma unroll
            for (int m = 0; m < 4; ++m) { bf16* rowp = base + (size_t)(row0 + ai * 128 + m * 16) * ld + col0;
#pragma unroll
                for (int bj = 0; bj < 2; ++bj) { f32x4 v0 = __builtin_convertvector(__builtin_bit_cast(pg8::i32x4, acc[ai][bj][m][0]), f32x4) * (cb[bj][0] * ra[ai][m]), v1 = __builtin_convertvector(__builtin_bit_cast(pg8::i32x4, acc[ai][bj][m][1]), f32x4) * (cb[bj][1] * ra[ai][m]);
#if NOISE_PROBE
                    { const unsigned idx0 = (unsigned)((row0 + ai * 128 + m * 16) * 4096 + col0 + bj * 128) + (u.aux ? 0x40000000u : 0u);
#pragma unroll
                      for (int j = 0; j < 8; ++j) { unsigned h = (idx0 + j) * 0x9E3779B1u; h ^= h >> 15; h *= 0x85EBCA77u; h ^= h >> 13; h *= 0xC2B2AE3Du; h ^= h >> 16;
                          const float un = (float)(int)(h >> 8) - 8388608.0f; if (j < 4) v0[j] += nsc * un; else v1[j - 4] += nsc * un; } }
#endif
                    if (act) { const f32x2 a = gelu_tanh2((f32x2){v0[0], v0[1]}), b2 = gelu_tanh2((f32x2){v0[2], v0[3]}), c2 = gelu_tanh2((f32x2){v1[0], v1[1]}), d2 = gelu_tanh2((f32x2){v1[2], v1[3]});
                        v0 = (f32x4){a.x, a.y, b2.x, b2.y}; v1 = (f32x4){c2.x, c2.y, d2.x, d2.y}; }
                    u32x4 w; w.x = cvt_pk_bf16(v0[0], v0[1]); w.y = cvt_pk_bf16(v0[2], v0[3]); w.z = cvt_pk_bf16(v1[0], v1[1]); w.w = cvt_pk_bf16(v1[2], v1[3]);
                    *(u32x4*)(rowp + bj * 128) = w; } }
    }
};
template <bool BASE_F32> struct EpiResid {
    static constexpr bool PERM = true; static constexpr int NST = 24; static constexpr int RELAX = 0; static constexpr bool TWICE = false; static constexpr bool BIAS_DMA = false;
    const void* base; bf16* out; float* ssq; unsigned char* q8;
    __device__ __forceinline__ void operator()(const f32x4 (&acc)[2][2][4][2], const pg8::Unit& u, int wr, int wc, int fr, int fq) const {
        const int row0 = u.pm * 256 + wr * 64 + fr, col0 = u.pn * 256 + wc * 32 + 8 * fq;
#pragma unroll
        for (int ai = 0; ai < 2; ++ai) {
            f32x4 b0[4][2], b1[4][2];
#pragma unroll
            for (int m = 0; m < 4; ++m)
#pragma unroll
                for (int bj = 0; bj < 2; ++bj) { const size_t off = (size_t)(row0 + ai * 128 + m * 16) * D + col0 + bj * 128;
                    if (BASE_F32) { b0[m][bj] = *(const f32x4*)((const float*)base + off); b1[m][bj] = *(const f32x4*)((const float*)base + off + 4); }
                    else { const u32x4 w = *(const u32x4*)((const bf16*)base + off); b0[m][bj] = (f32x4){bflo(w.x), bfhi(w.x), bflo(w.y), bfhi(w.y)}; b1[m][bj] = (f32x4){bflo(w.z), bfhi(w.z), bflo(w.w), bfhi(w.w)}; } }
            asm volatile("" ::: "memory");
#pragma unroll
            for (int m = 0; m < 4; ++m) { const int row = row0 + ai * 128 + m * 16; float ss = 0.f;
#pragma unroll
                for (int bj = 0; bj < 2; ++bj) { const size_t off = (size_t)row * D + col0 + bj * 128;
                    const float asc = BASE_F32 ? 1.0f : (1.0f / 256.0f);
                    const f32x4 v0 = acc[ai][bj][m][0] * asc + b0[m][bj], v1 = acc[ai][bj][m][1] * asc + b1[m][bj];
                    ss += (v0[0] * v0[0] + v0[1] * v0[1]) + (v0[2] * v0[2] + v0[3] * v0[3]) + (v1[0] * v1[0] + v1[1] * v1[1]) + (v1[2] * v1[2] + v1[3] * v1[3]);
                    u32x4 w; w.x = cvt_pk_bf16(v0[0], v0[1]); w.y = cvt_pk_bf16(v0[2], v0[3]); w.z = cvt_pk_bf16(v1[0], v1[1]); w.w = cvt_pk_bf16(v1[2], v1[3]);
                    *(u32x4*)(out + off) = w;
                    if (BASE_F32) *(u32x2*)(q8 + off) = (u32x2){pk4_fp8(v0[0], v0[1], v0[2], v0[3]), pk4_fp8(v1[0], v1[1], v1[2], v1[3])}; }
                ss += __shfl_xor(ss, 16); ss += __shfl_xor(ss, 32);
                if (fq == 0) ssq[(size_t)row * 16 + u.pn * 4 + wc] = ss; }
        }
    }
};
__device__ __forceinline__ float row_rms_from_ssq(const float* ssq, int row) {
    const f32x4* p = (const f32x4*)(ssq + (size_t)row * 16); const f32x4 a = p[0], b = p[1], c = p[2], d = p[3];
    const float s = (((a[0] + a[1]) + (a[2] + a[3])) + ((b[0] + b[1]) + (b[2] + b[3]))) + (((c[0] + c[1]) + (c[2] + c[3])) + ((d[0] + d[1]) + (d[2] + d[3])));
    return rsqrtf(s * (1.0f / D) + EPS);
}
template <int WHICH> struct EpiPre {
    static constexpr bool PERM = true; static constexpr int NST = 16; static constexpr int RELAX = 0; static constexpr bool TWICE = false; static constexpr bool BIAS_DMA = false;
    unsigned char* out;
    __device__ __forceinline__ void operator()(const f32x4 (&acc)[2][2][4][2], const pg8::Unit& u, int wr, int wc, int fr, int fq) const {
        const int rt = WHICH == 0 ? u.pn : u.pm, ct = WHICH == 0 ? u.pm : u.pn; const float sc = WHICH == 0 ? 64.0f : 1.0f;
        unsigned char* base = out + ((size_t)u.aux * 1024 + rt * 256 + wr * 64 + fr) * 1024 + ct * 256 + wc * 32 + 8 * fq;
#pragma unroll
        for (int ai = 0; ai < 2; ++ai)
#pragma unroll
            for (int m = 0; m < 4; ++m)
#pragma unroll
                for (int bj = 0; bj < 2; ++bj) { const f32x4 v0 = acc[ai][bj][m][0] * sc, v1 = acc[ai][bj][m][1] * sc;
                    *(u32x2*)(base + (size_t)(ai * 128 + m * 16) * 1024 + bj * 128) = (u32x2){pk4_fp8(v0[0], v0[1], v0[2], v0[3]), pk4_fp8(v1[0], v1[1], v1[2], v1[3])}; }
    }
};
struct EpiSoftmax {
    static constexpr bool PERM = true; static constexpr int NST = 16; static constexpr int RELAX = 0; static constexpr bool TWICE = false; static constexpr bool BIAS_DMA = false;
    unsigned char* out; const float* ssq; LAS float* xch;
    __device__ __forceinline__ void operator()(f32x4 (&acc)[2][2][4][2], const pg8::Unit& u, int wr, int wc, int fr, int fq) const {
        const int row0 = u.pm * 256 + wr * 64 + fr, col0 = u.pn * 256 + wc * 32 + 8 * fq;
#pragma unroll
        for (int ai = 0; ai < 2; ++ai)
#pragma unroll
            for (int m = 0; m < 4; ++m) { if (m & 1) asm volatile("" ::: "memory");
                const float r = row_rms_from_ssq(ssq, row0 + ai * 128 + m * 16) * (1.4426950408889634f / 64.0f);
                float mm = -3.0e38f;
#pragma unroll
                for (int bj = 0; bj < 2; ++bj)
#pragma unroll
                    for (int n = 0; n < 2; ++n) { acc[ai][bj][m][n] = acc[ai][bj][m][n] * r; const f32x4 v = acc[ai][bj][m][n]; mm = fmaxf(fmaxf(fmaxf(mm, v[0]), fmaxf(v[1], v[2])), v[3]); }
                mm = fmaxf(mm, __shfl_xor(mm, 16)); mm = fmaxf(mm, __shfl_xor(mm, 32));
                if (fq == 0) xch[(ai * 128 + wr * 64 + m * 16 + fr) * 4 + wc] = mm; }
        asm volatile("s_waitcnt lgkmcnt(0)" ::: "memory"); __builtin_amdgcn_s_barrier(); asm volatile("" ::: "memory");
#pragma unroll
        for (int ai = 0; ai < 2; ++ai)
#pragma unroll
            for (int m = 0; m < 4; ++m) { const int rl = ai * 128 + wr * 64 + m * 16 + fr; const f32x4 q = *(const LAS f32x4*)(xch + rl * 4); const float M = fmaxf(fmaxf(q[0], q[1]), fmaxf(q[2], q[3]));
                float sm = 0.f;
#pragma unroll
                for (int bj = 0; bj < 2; ++bj)
#pragma unroll
                    for (int n = 0; n < 2; ++n) { f32x4 v = acc[ai][bj][m][n];
#pragma unroll
                        for (int j = 0; j < 4; ++j) { v[j] = __builtin_amdgcn_exp2f(v[j] - M); sm += v[j]; }
                        acc[ai][bj][m][n] = v; }
                sm += __shfl_xor(sm, 16); sm += __shfl_xor(sm, 32);
                if (fq == 0) xch[1024 + rl * 4 + wc] = sm; }
        asm volatile("s_waitcnt lgkmcnt(0)" ::: "memory"); __builtin_amdgcn_s_barrier(); asm volatile("" ::: "memory");
#pragma unroll
        for (int ai = 0; ai < 2; ++ai)
#pragma unroll
            for (int m = 0; m < 4; ++m) { const int rl = ai * 128 + wr * 64 + m * 16 + fr; const f32x4 q = *(const LAS f32x4*)(xch + 1024 + rl * 4); const float inv = 256.0f / ((q[0] + q[1]) + (q[2] + q[3]));
#pragma unroll
                for (int bj = 0; bj < 2; ++bj) { const f32x4 v0 = acc[ai][bj][m][0] * inv, v1 = acc[ai][bj][m][1] * inv;
                    *(u32x2*)(out + (size_t)(row0 + ai * 128 + m * 16) * D + col0 + bj * 128) = (u32x2){pk4_fp8(v0[0], v0[1], v0[2], v0[3]), pk4_fp8(v1[0], v1[1], v1[2], v1[3])}; } }
    }
};
struct EpiG1 {
    static constexpr bool PERM = true; static constexpr int NST = 8; static constexpr int RELAX = 0; static constexpr bool TWICE = false; static constexpr bool BIAS_DMA = false;
    unsigned char* ws; const float* bgate; const float* bup;
    static __device__ __forceinline__ f32x2 act2(f32x2 g, f32x2 u) {
        g.x = __builtin_amdgcn_fmed3f(g.x, -24.0f, 7.0f); g.y = __builtin_amdgcn_fmed3f(g.y, -24.0f, 7.0f);
        u.x = __builtin_amdgcn_fmed3f(u.x, -7.0f, 7.0f); u.y = __builtin_amdgcn_fmed3f(u.y, -7.0f, 7.0f);
        f32x2 z = g * (-1.702f * 1.4426950408889634f);
        f32x2 d; d.x = __builtin_amdgcn_exp2f(z.x); d.y = __builtin_amdgcn_exp2f(z.y);
        d = d + 1.0f;
        const float r = __builtin_amdgcn_rcpf(d.x * d.y);
        f32x2 sg; sg.x = r * d.y; sg.y = r * d.x;
        return (u + 1.0f) * (g * sg);
    }
    __device__ __forceinline__ void operator()(const f32x4 (&acc)[2][2][4][2], const pg8::Unit& u, int wr, int wc, int fr, int fq) const {
        const int e = u.aux;
        unsigned char* Ht = ws + WS_H2 + (size_t)u.pm * TSF8;
        const int hc = u.pn * 128 + wc * 32 + 8 * fq;
        const f32x4 bg0 = *(const f32x4*)(bgate + e * FF + hc), bg1 = *(const f32x4*)(bgate + e * FF + hc + 4);
        const f32x4 bu0 = *(const f32x4*)(bup + e * FF + hc), bu1 = *(const f32x4*)(bup + e * FF + hc + 4);
#pragma unroll
        for (int ai = 0; ai < 2; ++ai)
#pragma unroll
            for (int m = 0; m < 4; ++m) { const int rl = ai * 128 + wr * 64 + m * 16 + fr;
                const f32x4 g0 = acc[ai][0][m][0] * (1.0f / 64.0f) + bg0, g1 = acc[ai][0][m][1] * (1.0f / 64.0f) + bg1, u0 = acc[ai][1][m][0] * (1.0f / 64.0f) + bu0, u1 = acc[ai][1][m][1] * (1.0f / 64.0f) + bu1;
                const f32x2 h0 = act2((f32x2){g0[0], g0[1]}, (f32x2){u0[0], u0[1]}), h1 = act2((f32x2){g0[2], g0[3]}, (f32x2){u0[2], u0[3]});
                const f32x2 h2 = act2((f32x2){g1[0], g1[1]}, (f32x2){u1[0], u1[1]}), h3 = act2((f32x2){g1[2], g1[3]}, (f32x2){u1[2], u1[3]});
                *(u32x2*)(Ht + (size_t)rl * FF + hc) = (u32x2){pk4_fp8(h0.x, h0.y, h1.x, h1.y), pk4_fp8(h2.x, h2.y, h3.x, h3.y)}; }
    }
};
struct EpiG2 {
    static constexpr bool PERM = true; static constexpr int NST = 16; static constexpr int RELAX = 0; static constexpr bool TWICE = false; static constexpr bool BIAS_DMA = true; static constexpr int BIAS_STRIDE = 1024;
    unsigned char* ws; const float* bdown; LAS unsigned char* btab;
    __device__ __forceinline__ void bias_dma(const pg8::Unit& u, LAS unsigned char* tab, int wid, int lane) const {
        if (wid < 4) { const float* src = bdown + u.aux * D + u.pn * 256 + wid * 64;
            const float* srcu = (const float*)((((unsigned long long)(unsigned)__builtin_amdgcn_readfirstlane((int)((unsigned long long)src >> 32))) << 32) | (unsigned long long)(unsigned)__builtin_amdgcn_readfirstlane((int)(unsigned)(unsigned long long)src));
            const unsigned la = (unsigned)__builtin_amdgcn_readfirstlane((int)(unsigned)(size_t)tab) + (unsigned)wid * 256u; const unsigned vo = (unsigned)lane * 4u;
            asm volatile("s_mov_b32 m0, %2\n\ts_nop 0\n\tglobal_load_lds_dword %0, %1" :: "v"(vo), "s"(srcu), "s"(la) : "memory", "m0"); } }
    __device__ __forceinline__ void operator()(const f32x4 (&acc)[2][2][4][2], const pg8::Unit& u, int wr, int wc, int fr, int fq) const {
        const int col0 = u.pn * 256 + wc * 32 + 8 * fq;
        unsigned char* Yt = ws + WS_Y + (size_t)u.pm * TSF8;
        f32x4 bd[2][2];
#pragma unroll
        for (int bj = 0; bj < 2; ++bj) { const LAS float* bt = (const LAS float*)(btab + u.par * 1024) + bj * 128 + wc * 32 + 8 * fq; bd[bj][0] = *(const LAS f32x4*)bt; bd[bj][1] = *(const LAS f32x4*)(bt + 4); }
#pragma unroll
        for (int ai = 0; ai < 2; ++ai)
#pragma unroll
            for (int m = 0; m < 4; ++m) { const int rl = ai * 128 + wr * 64 + m * 16 + fr;
#pragma unroll
                for (int bj = 0; bj < 2; ++bj) { const f32x4 v0 = acc[ai][bj][m][0] * (1.0f / 64.0f) + bd[bj][0], v1 = acc[ai][bj][m][1] * (1.0f / 64.0f) + bd[bj][1];
                    *(u32x2*)(Yt + (size_t)rl * D + col0 + bj * 128) = (u32x2){pk4_fp8(v0[0], v0[1], v0[2], v0[3]), pk4_fp8(v1[0], v1[1], v1[2], v1[3])}; } }
    }
};


__device__ __forceinline__ void ld16_to_lds(LAS bf16* dst, const bf16* src) { *(LAS u32x4*)dst = *(const GAS u32x4*)src; }

__device__ __forceinline__ void p2_mlstm_chain_simple(Frame& F, const Args& A, int ch) {
    const int b = ch >> 2, h = ch & 3, tid = F.tid, t = tid >> 2, p = tid & 3;
    const bf16* proj = (const bf16*)(F.ws + WS_PROJ); const float* gates = (const float*)(F.ws + WS_GATES); bf16* ycat = (bf16*)(F.ws + WS_R2);
    const float* ghead = A.in[5];
    LAS bf16* qs = (LAS bf16*)(F.lds + 0); LAS bf16* ks = (LAS bf16*)(F.lds + 16384); LAS bf16* vs = (LAS bf16*)(F.lds + 32768);
    LAS float* Cs = (LAS float*)(F.lds + 65536); LAS float* ns = (LAS float*)(F.lds + 98304);
    LAS float* ibs = ns + 64; LAS float* fbs = ibs + 128; LAS float* As = fbs + 128; LAS float* Mts = As + 128; LAS float* bcs = Mts + 128; LAS float* wks = bcs + 128; LAS float* scal = wks + 128;
    for (int i = tid; i < 128 * 64; i += NTHREADS) Cs[i] = 0.f;
    if (tid < 64) ns[tid] = 0.f;
    float mstate = 0.f;
    for (int c = 0; c < 16; ++c) {
        const int tg0 = b * SEQ + c * 128;
        __syncthreads();
#pragma unroll
        for (int j = 0; j < 2; ++j) { const int i = tid + 512 * j, row = i >> 3, part = i & 7; const bf16* src = proj + (size_t)(tg0 + row) * NP + h * 64 + part * 8;
            ld16_to_lds(qs + row * 64 + part * 8, src); ld16_to_lds(ks + row * 64 + part * 8, src + 256); }
#pragma unroll
        for (int j = 0; j < 4; ++j) { const int i = tid + 512 * j, row = i >> 4, part = i & 15; ld16_to_lds(vs + row * 128 + part * 8, proj + (size_t)(tg0 + row) * NP + 512 + h * 128 + part * 8); }
        if (tid < 128) { ibs[tid] = gates[(size_t)(tg0 + tid) * 8 + h]; fbs[tid] = gates[(size_t)(tg0 + tid) * 8 + 4 + h]; }
        __syncthreads();
        if (tid == 0) { float bs = 0.f, pm = -3.0e38f;
            for (int s = 0; s < 128; ++s) { bs += fbs[s]; bcs[s] = bs; const float a = ibs[s] - bs; As[s] = a; pm = fmaxf(pm, a); Mts[s] = fmaxf(mstate, pm); }
            scal[0] = fmaxf(mstate, pm); scal[1] = bs; }
        __syncthreads();
        const float Mnew = scal[0], bL = scal[1];
        if (tid < 128) wks[tid] = expf(As[tid] - Mnew);
        {
            const float Mt = Mts[t];
            float qd[16];
#pragma unroll
            for (int j = 0; j < 16; ++j) qd[j] = bf2f(qs[t * 64 + 16 * p + j]) * 0.125f;
            float acc[32]; float den = 0.f;
#pragma unroll
            for (int j = 0; j < 32; ++j) acc[j] = 0.f;
            for (int s = 0; s <= t; ++s) {
                float dot = 0.f;
#pragma unroll
                for (int j = 0; j < 16; ++j) dot += qd[j] * bf2f(ks[s * 64 + 16 * p + j]);
                dot += __shfl_xor(dot, 1); dot += __shfl_xor(dot, 2);
                const float val = dot * expf(As[s] - Mt);
                den += val;
#pragma unroll
                for (int j = 0; j < 32; ++j) acc[j] += val * bf2f(vs[s * 128 + 32 * p + j]);
            }
            const float winter = expf(mstate - Mt);
            float acc2[32]; float nq = 0.f;
#pragma unroll
            for (int j = 0; j < 32; ++j) acc2[j] = 0.f;
            for (int d = 0; d < 64; d += 4) {
                float q4[4];
#pragma unroll
                for (int e = 0; e < 4; ++e) q4[e] = bf2f(qs[t * 64 + d + e]) * 0.125f;
#pragma unroll
                for (int j = 0; j < 32; ++j) { const f32x4 c4 = *(const LAS f32x4*)(Cs + (32 * p + j) * 64 + d); acc2[j] += (c4[0] * q4[0] + c4[1] * q4[1]) + (c4[2] * q4[2] + c4[3] * q4[3]); }
                const f32x4 n4 = *(const LAS f32x4*)(ns + d); nq += (n4[0] * q4[0] + n4[1] * q4[1]) + (n4[2] * q4[2] + n4[3] * q4[3]);
            }
            den += winter * nq;
            const float dn = fmaxf(fabsf(den), expf(-(bcs[t] + Mt)));
            const float inv = 1.0f / dn; float ss = 0.f;
#pragma unroll
            for (int j = 0; j < 32; ++j) { acc[j] = (acc[j] + winter * acc2[j]) * inv; ss += acc[j] * acc[j]; }
            ss += __shfl_xor(ss, 1); ss += __shfl_xor(ss, 2);
            const float r = rsqrtf(ss * (1.0f / 128.0f) + EPS);
            const bf16* og = proj + (size_t)(tg0 + t) * NP + 1024 + h * 128 + 32 * p; bf16* yo = ycat + (size_t)(tg0 + t) * D + h * 128 + 32 * p; const float* gh = ghead + h * 128 + 32 * p;
#pragma unroll
            for (int j8 = 0; j8 < 4; ++j8) { const u32x4 ow = *(const GAS u32x4*)(og + j8 * 8); const unsigned oww[4] = {ow.x, ow.y, ow.z, ow.w}; unsigned res[4];
#pragma unroll
                for (int e = 0; e < 4; ++e) { const int j = j8 * 8 + 2 * e; const float o0 = bflo(oww[e]), o1 = bfhi(oww[e]);
                    const float y0 = acc[j] * r * gh[j] * (1.0f / (1.0f + expf(-o0))), y1 = acc[j + 1] * r * gh[j + 1] * (1.0f / (1.0f + expf(-o1))); res[e] = pk2(y0, y1); }
                *(GAS u32x4*)(yo + j8 * 8) = (u32x4){res[0], res[1], res[2], res[3]}; }
        }
        __syncthreads();
        {
            const float decay = expf(mstate - Mnew); const int v = tid >> 2, d0 = 16 * (tid & 3);
            float cn[16];
#pragma unroll
            for (int j = 0; j < 16; ++j) cn[j] = decay * Cs[v * 64 + d0 + j];
            for (int s = 0; s < 128; ++s) { const float wv = wks[s] * bf2f(vs[s * 128 + v]);
#pragma unroll
                for (int j = 0; j < 16; ++j) cn[j] += wv * bf2f(ks[s * 64 + d0 + j]); }
#pragma unroll
            for (int j = 0; j < 16; ++j) Cs[v * 64 + d0 + j] = cn[j];
            if (tid < 64) { float a = decay * ns[tid]; for (int s = 0; s < 128; ++s) a += wks[s] * bf2f(ks[s * 64 + tid]); ns[tid] = a; }
            mstate = bL + Mnew;
        }
    }
    __syncthreads();
}

__device__ __forceinline__ void p2_gmlp_unit_simple(Frame& F, const Args& A, int u) {
    const int b = u >> 6, c = (u >> 2) & 15, g = u & 3, tid = F.tid, t = tid >> 2, p = tid & 3, tg0 = b * SEQ + c * 128;
    const bf16* proj = (const bf16*)(F.ws + WS_PROJ); bf16* ycat = (bf16*)(F.ws + WS_R2);
    const float* wsp = A.in[6] + (size_t)g * 128 * 128; const float* bsp = A.in[7] + g * 128; const float* gv = A.in[8] + g * 128; const float* go = A.in[9] + g * 128;
    LAS float* zs = (LAS float*)(F.lds + 0);
    __syncthreads();
    {
        const bf16* src = proj + (size_t)(tg0 + t) * NP + 2048 + g * 128 + 32 * p; float z[32]; float ss = 0.f;
#pragma unroll
        for (int j8 = 0; j8 < 4; ++j8) { const u32x4 w = *(const GAS u32x4*)(src + j8 * 8); const unsigned ww[4] = {w.x, w.y, w.z, w.w};
#pragma unroll
            for (int e = 0; e < 4; ++e) { z[j8 * 8 + 2 * e] = bflo(ww[e]); z[j8 * 8 + 2 * e + 1] = bfhi(ww[e]); } }
#pragma unroll
        for (int j = 0; j < 32; ++j) ss += z[j] * z[j];
        ss += __shfl_xor(ss, 1); ss += __shfl_xor(ss, 2);
        const float r = rsqrtf(ss * (1.0f / 128.0f) + EPS);
#pragma unroll
        for (int j = 0; j < 32; ++j) zs[t * 128 + 32 * p + j] = z[j] * r * gv[32 * p + j];
    }
    __syncthreads();
    {
        float acc[32];
#pragma unroll
        for (int j = 0; j < 32; ++j) acc[j] = 0.f;
        for (int s = 0; s <= t; ++s) { const float w = wsp[t * 128 + s];
#pragma unroll
            for (int j = 0; j < 32; ++j) acc[j] += w * zs[s * 128 + 32 * p + j]; }
        const float bias = bsp[t];
        const bf16* us = proj + (size_t)(tg0 + t) * NP + 1536 + g * 128 + 32 * p; float ss = 0.f;
#pragma unroll
        for (int j8 = 0; j8 < 4; ++j8) { const u32x4 w = *(const GAS u32x4*)(us + j8 * 8); const unsigned ww[4] = {w.x, w.y, w.z, w.w};
#pragma unroll
            for (int e = 0; e < 4; ++e) { const int j = j8 * 8 + 2 * e; acc[j] = bflo(ww[e]) * (acc[j] + bias); acc[j + 1] = bfhi(ww[e]) * (acc[j + 1] + bias); ss += acc[j] * acc[j] + acc[j + 1] * acc[j + 1]; } }
        ss += __shfl_xor(ss, 1); ss += __shfl_xor(ss, 2);
        const float r = rsqrtf(ss * (1.0f / 128.0f) + EPS);
        bf16* yo = ycat + (size_t)(tg0 + t) * D + 512 + g * 128 + 32 * p;
#pragma unroll
        for (int j8 = 0; j8 < 4; ++j8) { unsigned res[4];
#pragma unroll
            for (int e = 0; e < 4; ++e) { const int j = j8 * 8 + 2 * e; res[e] = pk2(acc[j] * r * go[32 * p + j], acc[j + 1] * r * go[32 * p + j + 1]); }
            *(GAS u32x4*)(yo + j8 * 8) = (u32x4){res[0], res[1], res[2], res[3]}; }
    }
}

__device__ __forceinline__ void p5_attn_unit_simple(Frame& F, int u) {
    const int b = u >> 7, h = (u >> 5) & 3, qt = u & 31, tid = F.tid, ql = tid >> 3, p = tid & 7;
    const bf16* Q = (const bf16*)(F.ws + WS_R2); const bf16* Km = (const bf16*)(F.ws + WS_KM); const bf16* Vt = (const bf16*)(F.ws + WS_VT); bf16* O = (bf16*)(F.ws + WS_R3);
    LAS bf16* Ks = (LAS bf16*)(F.lds + 0); LAS bf16* Vs = (LAS bf16*)(F.lds + 32768);
    const size_t tq = (size_t)b * SEQ + qt * 64 + ql;
    float qf[32], acc[32];
    { const bf16* src = Q + tq * D + h * 256 + 32 * p;
#pragma unroll
      for (int j8 = 0; j8 < 4; ++j8) { const u32x4 w = *(const GAS u32x4*)(src + j8 * 8); const unsigned ww[4] = {w.x, w.y, w.z, w.w};
#pragma unroll
          for (int e = 0; e < 4; ++e) { qf[j8 * 8 + 2 * e] = bflo(ww[e]); qf[j8 * 8 + 2 * e + 1] = bfhi(ww[e]); } } }
#pragma unroll
    for (int j = 0; j < 32; ++j) acc[j] = 0.f;
    float mrun = -1.0e30f, l = 0.f;
    for (int kt = 0; kt < 4; ++kt) {
        __syncthreads();
#pragma unroll
        for (int j = 0; j < 4; ++j) { const int i = tid + 512 * j, row = i >> 5, part = i & 31; ld16_to_lds(Ks + row * 256 + part * 8, Km + (size_t)(b * 256 + kt * 64 + row) * D + h * 256 + part * 8); }
#pragma unroll
        for (int j = 0; j < 4; ++j) { const int i = tid + 512 * j, d = i >> 3, part = i & 7; const u32x4 w = *(const GAS u32x4*)(Vt + (size_t)(h * 256 + d) * TM + b * 256 + kt * 64 + part * 8); const unsigned ww[4] = {w.x, w.y, w.z, w.w};
#pragma unroll
            for (int e = 0; e < 4; ++e) { Vs[(part * 8 + 2 * e) * 256 + d] = (bf16)(ww[e] & 0xffffu); Vs[(part * 8 + 2 * e + 1) * 256 + d] = (bf16)(ww[e] >> 16); } }
        __syncthreads();
        for (int mb = 0; mb < 8; ++mb) {
            float s8[8]; float mx = mrun;
#pragma unroll
            for (int e = 0; e < 8; ++e) { const int m = mb * 8 + e; float dot = 0.f;
#pragma unroll
                for (int j8 = 0; j8 < 4; ++j8) { const u32x4 w = *(const LAS u32x4*)(Ks + m * 256 + 32 * p + j8 * 8); const unsigned ww[4] = {w.x, w.y, w.z, w.w};
#pragma unroll
                    for (int q = 0; q < 4; ++q) dot += qf[j8 * 8 + 2 * q] * bflo(ww[q]) + qf[j8 * 8 + 2 * q + 1] * bfhi(ww[q]); }
                dot += __shfl_xor(dot, 1); dot += __shfl_xor(dot, 2); dot += __shfl_xor(dot, 4); s8[e] = dot; mx = fmaxf(mx, dot); }
            const float corr = expf(mrun - mx); mrun = mx; l *= corr;
#pragma unroll
            for (int j = 0; j < 32; ++j) acc[j] *= corr;
#pragma unroll
            for (int e = 0; e < 8; ++e) { const int m = mb * 8 + e; const float pe = expf(s8[e] - mx); l += pe;
#pragma unroll
                for (int j8 = 0; j8 < 4; ++j8) { const u32x4 w = *(const LAS u32x4*)(Vs + m * 256 + 32 * p + j8 * 8); const unsigned ww[4] = {w.x, w.y, w.z, w.w};
#pragma unroll
                    for (int q = 0; q < 4; ++q) { acc[j8 * 8 + 2 * q] += pe * bflo(ww[q]); acc[j8 * 8 + 2 * q + 1] += pe * bfhi(ww[q]); } } }
        }
    }
    const float inv = 1.0f / l; bf16* dst = O + tq * D + h * 256 + 32 * p;
#pragma unroll
    for (int j8 = 0; j8 < 4; ++j8) { u32x4 w; w.x = pk2(acc[j8 * 8] * inv, acc[j8 * 8 + 1] * inv); w.y = pk2(acc[j8 * 8 + 2] * inv, acc[j8 * 8 + 3] * inv); w.z = pk2(acc[j8 * 8 + 4] * inv, acc[j8 * 8 + 5] * inv); w.w = pk2(acc[j8 * 8 + 6] * inv, acc[j8 * 8 + 7] * inv);
        *(GAS u32x4*)(dst + j8 * 8) = w; }
}

constexpr int ML_QS = 0, ML_KS = 18432, ML_VS = 34816, ML_CT = 67584, ML_NS = 83968, ML_WK = 84480, ML_A = 86016, ML_M = ML_A + 8192, ML_LF = ML_M + 8192, ML_MC = ML_LF + 8192;
typedef short s16x4 __attribute__((ext_vector_type(4)));
__device__ __forceinline__ int swzf(int r) { return (r & 3) | ((((r >> 2) ^ (r >> 3)) & 1) << 2); }
__device__ __forceinline__ int swzg(int r) { return ((r >> 1) & 1) | (((r >> 3) & 1) << 1); }
__device__ __forceinline__ int offV(int r, int c) { return 256 * r + 32 * ((c >> 4) ^ swzf(r)) + 2 * (c & 15); }
__device__ __forceinline__ int offK(int r, int c) { return 128 * r + 32 * ((c >> 4) ^ swzg(r)) + 2 * (c & 15); }
__device__ __forceinline__ bf16x8 tr_frag_V(const LAS unsigned char* base, int rA, int rB, int cb, int gi) {
    const int q = gi >> 2, p4 = (gi & 3) * 4;
    const s16x4 x = __builtin_bit_cast(s16x4, __builtin_amdgcn_ds_read_tr16_b64_v4i16((LAS s16x4*)(base + offV(rA + q, 16 * cb + p4))));
    const s16x4 y = __builtin_bit_cast(s16x4, __builtin_amdgcn_ds_read_tr16_b64_v4i16((LAS s16x4*)(base + offV(rB + q, 16 * cb + p4))));
    return __builtin_shufflevector(x, y, 0, 1, 2, 3, 4, 5, 6, 7);
}
__device__ __forceinline__ bf16x8 tr_frag_K(const LAS unsigned char* base, int rA, int rB, int cb, int gi) {
    const int q = gi >> 2, p4 = (gi & 3) * 4;
    const s16x4 x = __builtin_bit_cast(s16x4, __builtin_amdgcn_ds_read_tr16_b64_v4i16((LAS s16x4*)(base + offK(rA + q, 16 * cb + p4))));
    const s16x4 y = __builtin_bit_cast(s16x4, __builtin_amdgcn_ds_read_tr16_b64_v4i16((LAS s16x4*)(base + offK(rB + q, 16 * cb + p4))));
    return __builtin_shufflevector(x, y, 0, 1, 2, 3, 4, 5, 6, 7);
}
__device__ __forceinline__ bf16x8 scale_frag(bf16x8 f, float sc) {
    const u32x4 w = __builtin_bit_cast(u32x4, f);
    return __builtin_bit_cast(bf16x8, (u32x4){cvt_pk_bf16(bflo(w.x) * sc, bfhi(w.x) * sc), cvt_pk_bf16(bflo(w.y) * sc, bfhi(w.y) * sc), cvt_pk_bf16(bflo(w.z) * sc, bfhi(w.z) * sc), cvt_pk_bf16(bflo(w.w) * sc, bfhi(w.w) * sc)});
}
__device__ __forceinline__ bf16x8 scale_frag8(bf16x8 f, f32x4 s0, f32x4 s1) {
    const u32x4 w = __builtin_bit_cast(u32x4, f);
    return __builtin_bit_cast(bf16x8, (u32x4){cvt_pk_bf16(bflo(w.x) * s0[0], bfhi(w.x) * s0[1]), cvt_pk_bf16(bflo(w.y) * s0[2], bfhi(w.y) * s0[3]), cvt_pk_bf16(bflo(w.z) * s1[0], bfhi(w.z) * s1[1]), cvt_pk_bf16(bflo(w.w) * s1[2], bfhi(w.w) * s1[3])});
}
__device__ __forceinline__ void p2_mlstm_chain(Frame& F, const Args& A, int ch) {
    const int b = ch >> 2, h = ch & 3, tid = opaque(F.tid), lane = tid & 63, w = F.wave, tl = lane & 15, fq = lane >> 4;
    const bf16* proj = (const bf16*)(F.ws + WS_PROJ); const float* gates = (const float*)(F.ws + WS_GATES); bf16* ycat = (bf16*)(F.ws + WS_R2);
    const float* ghead = A.in[5] + h * 128;
    LAS unsigned char* L = F.lds;
    LAS float* sA = (LAS float*)(L + ML_A); LAS float* sM = (LAS float*)(L + ML_M); LAS float* sLF = (LAS float*)(L + ML_LF); LAS float* sMC = (LAS float*)(L + ML_MC);
    LAS float* ns = (LAS float*)(L + ML_NS); LAS float* sWK = (LAS float*)(L + ML_WK);
    __syncthreads();
    {
#pragma unroll
      for (int cc = 0; cc < 2; ++cc) { const int c = 2 * w + cc, p0 = c * 128 + 2 * lane; const size_t gi = ((size_t)b * SEQ + p0) * 8;
          const float i0 = gates[gi + h], f0 = gates[gi + 4 + h], i1 = gates[gi + 8 + h], f1 = gates[gi + 12 + h];
          float sc = f0 + f1;
#pragma unroll
          for (int o = 1; o < 64; o <<= 1) { const float t = __shfl_up(sc, o); if (lane >= o) sc += t; }
          const float b1 = sc, b0 = sc - f1, a0 = i0 - b0, a1 = i1 - b1;
          float pm = fmaxf(a0, a1);
#pragma unroll
          for (int o = 1; o < 64; o <<= 1) { const float t = __shfl_up(pm, o); if (lane >= o) pm = fmaxf(pm, t); }
          float pe = __shfl_up(pm, 1); if (lane == 0) pe = -3.0e38f;
          sA[p0] = a0; sA[p0 + 1] = a1; sLF[p0] = b0; sLF[p0 + 1] = b1; sM[p0] = fmaxf(pe, a0); sM[p0 + 1] = pm; }
      __syncthreads();
      if (tid == 0) { float m = 0.f; for (int c = 0; c < 16; ++c) { sMC[c] = m; const float Mn = fmaxf(m, sM[c * 128 + 127]); sMC[32 + c] = Mn; m = sLF[c * 128 + 127] + Mn; } sMC[16] = m; }
      __syncthreads();
#pragma unroll
      for (int j = 0; j < 4; ++j) { const int p = tid + 512 * j; const float Mt = fmaxf(sMC[p >> 7], sM[p]); sM[p] = Mt; sLF[p] = -(sLF[p] + Mt); }
      for (int i = tid; i < 64 * 256 / 4; i += NTHREADS) ((LAS unsigned*)(L + ML_CT))[i] = 0u;
      if (tid < 64) ns[tid] = 0.f;
      __syncthreads(); }
    f32x4 Cst[4]; f32x4 Nst = (f32x4){0.f, 0.f, 0.f, 0.f};
#pragma unroll
    for (int i = 0; i < 4; ++i) Cst[i] = (f32x4){0.f, 0.f, 0.f, 0.f};
    u32x4 qreg[2], kreg[2], vreg[4];
    { const size_t tg0 = (size_t)b * SEQ;
#pragma unroll
      for (int j = 0; j < 2; ++j) { const int idx = tid + 512 * j, row = idx >> 3, part = idx & 7; const bf16* src = proj + (tg0 + row) * NP + h * 64 + part * 8; qreg[j] = *(const GAS u32x4*)src; kreg[j] = *(const GAS u32x4*)(src + 256); }
#pragma unroll
      for (int j = 0; j < 4; ++j) { const int idx = tid + 512 * j, row = idx >> 4, part = idx & 15; vreg[j] = *(const GAS u32x4*)(proj + (tg0 + row) * NP + 512 + h * 128 + part * 8); } }
#pragma unroll 1
    for (int c = 0; c < 16; ++c) {
        const size_t tg0 = (size_t)b * SEQ + c * 128; const int t = 16 * w + tl;
#pragma unroll
        for (int j = 0; j < 2; ++j) { const int idx = tid + 512 * j, row = idx >> 3, part = idx & 7; *(LAS u32x4*)(L + ML_QS + row * 144 + part * 16) = qreg[j];
            *(LAS u32x4*)(L + ML_KS + 128 * row + 32 * ((part >> 1) ^ swzg(row)) + 16 * (part & 1)) = kreg[j]; }
#pragma unroll
        for (int j = 0; j < 4; ++j) { const int idx = tid + 512 * j, row = idx >> 4, part = idx & 15; *(LAS u32x4*)(L + ML_VS + 256 * row + 32 * ((part >> 1) ^ swzf(row)) + 16 * (part & 1)) = vreg[j]; }
        const float mc = sMC[c], Mn = sMC[32 + c], Mt = sM[c * 128 + t], lf = sLF[c * 128 + t];
        if (tid < 128) sWK[tid] = __builtin_amdgcn_exp2f((sA[c * 128 + tid] - Mn) * 1.4426950408889634f);
        __syncthreads();
        if (c < 15) { const size_t tn = tg0 + 128;
#pragma unroll
            for (int j = 0; j < 2; ++j) { const int idx = tid + 512 * j, row = idx >> 3, part = idx & 7; const bf16* src = proj + (tn + row) * NP + h * 64 + part * 8; qreg[j] = *(const GAS u32x4*)src; kreg[j] = *(const GAS u32x4*)(src + 256); }
#pragma unroll
            for (int j = 0; j < 4; ++j) { const int idx = tid + 512 * j, row = idx >> 4, part = idx & 15; vreg[j] = *(const GAS u32x4*)(proj + (tn + row) * NP + 512 + h * 128 + part * 8); } }
        u32x2 og[8];
#pragma unroll
        for (int vb = 0; vb < 8; ++vb) og[vb] = *(const GAS u32x2*)(proj + (tg0 + t) * NP + 1024 + h * 128 + 16 * vb + 4 * fq);
        bf16x8 qf[2];
#pragma unroll
        for (int ds = 0; ds < 2; ++ds) qf[ds] = *(const LAS bf16x8*)(L + ML_QS + t * 144 + ds * 64 + fq * 16);
        unsigned sfr[4][4];
#pragma unroll
        for (int i = 0; i < 4; ++i)
#pragma unroll
            for (int j = 0; j < 4; ++j) sfr[i][j] = 0u;
        float den = 0.f;
#pragma unroll
        for (int sb = 0; sb < 8; ++sb) {
            if (sb <= w) {
                f32x4 G = (f32x4){0.f, 0.f, 0.f, 0.f}; const int sr = 16 * sb + tl;
#pragma unroll
                for (int ds = 0; ds < 2; ++ds) { const bf16x8 a = *(const LAS bf16x8*)(L + ML_KS + 128 * sr + 32 * ((2 * ds + (fq >> 1)) ^ swzg(sr)) + 16 * (fq & 1)); G = __builtin_amdgcn_mfma_f32_16x16x32_bf16(a, qf[ds], G, 0, 0, 0); }
                const f32x4 as = *(const LAS f32x4*)(sA + c * 128 + 16 * sb + 4 * fq);
                float sw[4];
#pragma unroll
                for (int r = 0; r < 4; ++r) { const int s = 16 * sb + 4 * fq + r; float wg = __builtin_amdgcn_exp2f((as[r] - Mt) * 1.4426950408889634f) * 0.125f; if (s > t) wg = 0.f; sw[r] = G[r] * wg; den += sw[r]; }
                sfr[sb >> 1][(sb & 1) * 2] = cvt_pk_bf16(sw[0], sw[1]); sfr[sb >> 1][(sb & 1) * 2 + 1] = cvt_pk_bf16(sw[2], sw[3]);
            }
        }
        den += __shfl_xor(den, 16); den += __shfl_xor(den, 32);
        const float winter = __builtin_amdgcn_exp2f((mc - Mt) * 1.4426950408889634f);
        { float nq = 0.f;
#pragma unroll
          for (int ds = 0; ds < 2; ++ds) { const u32x4 qw = __builtin_bit_cast(u32x4, qf[ds]); const f32x4 n0 = *(const LAS f32x4*)(ns + ds * 32 + fq * 8), n1 = *(const LAS f32x4*)(ns + ds * 32 + fq * 8 + 4);
              nq += (bflo(qw.x) * n0[0] + bfhi(qw.x) * n0[1]) + (bflo(qw.y) * n0[2] + bfhi(qw.y) * n0[3]) + (bflo(qw.z) * n1[0] + bfhi(qw.z) * n1[1]) + (bflo(qw.w) * n1[2] + bfhi(qw.w) * n1[3]); }
          nq += __shfl_xor(nq, 16); nq += __shfl_xor(nq, 32);
          den += winter * nq * 0.125f; }
        f32x4 acc[8];
#pragma unroll
        for (int vb = 0; vb < 8; ++vb) acc[vb] = (f32x4){0.f, 0.f, 0.f, 0.f};
        { bf16x8 qw[2]; qw[0] = scale_frag(qf[0], winter * 0.125f); qw[1] = scale_frag(qf[1], winter * 0.125f);
#pragma unroll
          for (int vb = 0; vb < 8; ++vb)
#pragma unroll
              for (int ds = 0; ds < 2; ++ds) { const bf16x8 a = tr_frag_V(L + ML_CT, 32 * ds + 8 * fq, 32 * ds + 8 * fq + 4, vb, tl); acc[vb] = __builtin_amdgcn_mfma_f32_16x16x32_bf16(a, qw[ds], acc[vb], 0, 0, 0); } }
#pragma unroll
        for (int st = 0; st < 4; ++st) {
            if (2 * st <= w) {
                const bf16x8 bfr = __builtin_bit_cast(bf16x8, (u32x4){sfr[st][0], sfr[st][1], sfr[st][2], sfr[st][3]});
#pragma unroll
                for (int vb = 0; vb < 8; ++vb) { const bf16x8 a = tr_frag_V(L + ML_VS, 32 * st + 4 * fq, 32 * st + 16 + 4 * fq, vb, tl); acc[vb] = __builtin_amdgcn_mfma_f32_16x16x32_bf16(a, bfr, acc[vb], 0, 0, 0); }
            }
        }
        { const float inv = 1.0f / fmaxf(fabsf(den), __builtin_amdgcn_exp2f(lf * 1.4426950408889634f)); float ss = 0.f;
#pragma unroll
          for (int vb = 0; vb < 8; ++vb) { acc[vb] = acc[vb] * inv; ss += (acc[vb][0] * acc[vb][0] + acc[vb][1] * acc[vb][1]) + (acc[vb][2] * acc[vb][2] + acc[vb][3] * acc[vb][3]); }
          ss += __shfl_xor(ss, 16); ss += __shfl_xor(ss, 32);
          const float r = rsqrtf(ss * (1.0f / 128.0f) + EPS);
          bf16* yo = ycat + (tg0 + t) * D + h * 128 + 4 * fq;
#pragma unroll
          for (int vb = 0; vb < 8; ++vb) { const f32x4 gh = *(const f32x4*)(ghead + 16 * vb + 4 * fq);
              const float y0 = acc[vb][0] * r * gh[0] * sigmoidf_fast(bflo(og[vb].x)), y1 = acc[vb][1] * r * gh[1] * sigmoidf_fast(bfhi(og[vb].x));
              const float y2 = acc[vb][2] * r * gh[2] * sigmoidf_fast(bflo(og[vb].y)), y3 = acc[vb][3] * r * gh[3] * sigmoidf_fast(bfhi(og[vb].y));
              *(GAS u32x2*)(yo + 16 * vb) = (u32x2){cvt_pk_bf16(y0, y1), cvt_pk_bf16(y2, y3)}; } }
        { const float decay = __builtin_amdgcn_exp2f((mc - Mn) * 1.4426950408889634f);
#pragma unroll
          for (int db = 0; db < 4; ++db) Cst[db] = Cst[db] * decay;
          Nst = Nst * decay;
#pragma unroll
          for (int st = 0; st < 4; ++st) { const f32x4 k0 = *(const LAS f32x4*)(sWK + 32 * st + 8 * fq), k1 = *(const LAS f32x4*)(sWK + 32 * st + 8 * fq + 4);
              const bf16x8 a = scale_frag8(tr_frag_V(L + ML_VS, 32 * st + 8 * fq, 32 * st + 8 * fq + 4, w, tl), k0, k1);
              const u32x4 wkp = (u32x4){cvt_pk_bf16(k0[0], k0[1]), cvt_pk_bf16(k0[2], k0[3]), cvt_pk_bf16(k1[0], k1[1]), cvt_pk_bf16(k1[2], k1[3])};
              const bf16x8 an = __builtin_bit_cast(bf16x8, tl == 0 ? wkp : (u32x4){0u, 0u, 0u, 0u});
#pragma unroll
              for (int db = 0; db < 4; ++db) { const bf16x8 bb = tr_frag_K(L + ML_KS, 32 * st + 8 * fq, 32 * st + 8 * fq + 4, db, tl); Cst[db] = __builtin_amdgcn_mfma_f32_16x16x32_bf16(a, bb, Cst[db], 0, 0, 0);
                  if (db == w) Nst = __builtin_amdgcn_mfma_f32_16x16x32_bf16(an, bb, Nst, 0, 0, 0); } } }
        __syncthreads();
#pragma unroll
        for (int db = 0; db < 4; ++db) { const int d = 16 * db + tl; *(LAS u32x2*)(L + ML_CT + 256 * d + 32 * (w ^ swzf(d)) + 8 * fq) = (u32x2){cvt_pk_bf16(Cst[db][0], Cst[db][1]), cvt_pk_bf16(Cst[db][2], Cst[db][3])}; }
        if (w < 4 && fq == 0) ns[16 * w + tl] = Nst[0];
    }
    __syncthreads();
}
constexpr int GM_WB = 0, GM_ZS = 34816;
__device__ __forceinline__ void p2_gmlp_setup(Frame& F, const Args& A, int g) {
    const int tid = opaque(F.tid), t = tid >> 2, s0 = (tid & 3) * 32; const float* src = A.in[6] + ((size_t)g * 128 + t) * 128 + s0;
    __syncthreads();
#pragma unroll
    for (int j = 0; j < 4; ++j) { const f32x4 a = *(const f32x4*)(src + 8 * j), bq = *(const f32x4*)(src + 8 * j + 4); float v[8] = {a[0], a[1], a[2], a[3], bq[0], bq[1], bq[2], bq[3]};
#pragma unroll
        for (int e = 0; e < 8; ++e) if (s0 + 8 * j + e > t) v[e] = 0.f;
        *(LAS u32x4*)(F.lds + GM_WB + t * 272 + (s0 + 8 * j) * 2) = (u32x4){pk2(v[0], v[1]), pk2(v[2], v[3]), pk2(v[4], v[5]), pk2(v[6], v[7])}; }
    __syncthreads();
}
__device__ __forceinline__ void p2_gmlp_unit(Frame& F, const Args& A, int b, int c, int g, u32x4 (&zreg)[4], u32x2 (&ugn)[8], bool has_next, int nb, int nc, const f32x4 (&gvr)[8], const f32x4 (&gor)[8], const float bias) {
    const int tid = opaque(F.tid), lane = tid & 63, w = F.wave, tl = lane & 15, fq = lane >> 4; const size_t tg0 = (size_t)b * SEQ + c * 128;
    const bf16* proj = (const bf16*)(F.ws + WS_PROJ); bf16* ycat = (bf16*)(F.ws + WS_R2);
    LAS unsigned char* L = F.lds;
    {
        const int s = tid >> 2, p = tid & 3; float z[32]; float ss = 0.f;
#pragma unroll
        for (int j8 = 0; j8 < 4; ++j8) { const unsigned wv[4] = {zreg[j8].x, zreg[j8].y, zreg[j8].z, zreg[j8].w};
#pragma unroll
            for (int e = 0; e < 4; ++e) { z[j8 * 8 + 2 * e] = bflo(wv[e]); z[j8 * 8 + 2 * e + 1] = bfhi(wv[e]); } }
#pragma unroll
        for (int j = 0; j < 32; ++j) ss += z[j] * z[j];
        ss += __shfl_xor(ss, 1); ss += __shfl_xor(ss, 2);
        const float r = rsqrtf(ss * (1.0f / 128.0f) + EPS);
#pragma unroll
        for (int j8 = 0; j8 < 4; ++j8) { const int pp = 4 * p + j8; const f32x4 g0 = gvr[2 * j8], g1 = gvr[2 * j8 + 1];
            *(LAS u32x4*)(L + GM_ZS + 256 * s + 32 * ((pp >> 1) ^ swzf(s)) + 16 * (pp & 1)) = (u32x4){cvt_pk_bf16(z[j8 * 8] * r * g0[0], z[j8 * 8 + 1] * r * g0[1]), cvt_pk_bf16(z[j8 * 8 + 2] * r * g0[2], z[j8 * 8 + 3] * r * g0[3]),
                cvt_pk_bf16(z[j8 * 8 + 4] * r * g1[0], z[j8 * 8 + 5] * r * g1[1]), cvt_pk_bf16(z[j8 * 8 + 6] * r * g1[2], z[j8 * 8 + 7] * r * g1[3])}; }
    }
    const int t = 16 * w + tl;
    u32x2 ug[8];
#pragma unroll
    for (int db = 0; db < 8; ++db) ug[db] = ugn[db];
    __syncthreads();
    if (has_next) { const size_t tn = (size_t)nb * SEQ + nc * 128; const int s = tid >> 2, p = tid & 3;
#pragma unroll
        for (int j8 = 0; j8 < 4; ++j8) zreg[j8] = *(const GAS u32x4*)(proj + (tn + s) * NP + 2048 + g * 128 + 32 * p + j8 * 8);
#pragma unroll
        for (int db = 0; db < 8; ++db) ugn[db] = *(const GAS u32x2*)(proj + (tn + t) * NP + 1536 + g * 128 + 16 * db + 4 * fq); }
    f32x4 acc[8];
#pragma unroll
    for (int db = 0; db < 8; ++db) acc[db] = (f32x4){0.f, 0.f, 0.f, 0.f};
#pragma unroll
    for (int st = 0; st < 4; ++st) {
        if (2 * st <= w) { const bf16x8 bfr = *(const LAS bf16x8*)(L + GM_WB + t * 272 + (32 * st + 8 * fq) * 2);
#pragma unroll
            for (int db = 0; db < 8; ++db) { const bf16x8 a = tr_frag_V(L + GM_ZS, 32 * st + 8 * fq, 32 * st + 8 * fq + 4, db, tl); acc[db] = __builtin_amdgcn_mfma_f32_16x16x32_bf16(a, bfr, acc[db], 0, 0, 0); } }
    }
    float ss = 0.f;
#pragma unroll
    for (int db = 0; db < 8; ++db) { acc[db][0] = bflo(ug[db].x) * (acc[db][0] + bias); acc[db][1] = bfhi(ug[db].x) * (acc[db][1] + bias); acc[db][2] = bflo(ug[db].y) * (acc[db][2] + bias); acc[db][3] = bfhi(ug[db].y) * (acc[db][3] + bias);
        ss += (acc[db][0] * acc[db][0] + acc[db][1] * acc[db][1]) + (acc[db][2] * acc[db][2] + acc[db][3] * acc[db][3]); }
    ss += __shfl_xor(ss, 16); ss += __shfl_xor(ss, 32);
    const float r = rsqrtf(ss * (1.0f / 128.0f) + EPS);
    bf16* yo = ycat + (tg0 + t) * D + 512 + g * 128 + 4 * fq;
#pragma unroll
    for (int db = 0; db < 8; ++db) { const f32x4 gg = gor[db];
        *(GAS u32x2*)(yo + 16 * db) = (u32x2){cvt_pk_bf16(acc[db][0] * r * gg[0], acc[db][1] * r * gg[1]), cvt_pk_bf16(acc[db][2] * r * gg[2], acc[db][3] * r * gg[3])}; }
    __syncthreads();
}

constexpr int ATT_KROW = 528, ATT_VROW = 136, ATT_BUF = 34816;
__device__ __forceinline__ void att_load_tile(int i, int b, int h, int tid, const bf16* Km, const bf16* Vt, u32x4 (&r)[4]) {
    if (i < 4) {
#pragma unroll
        for (int j = 0; j < 4; ++j) { const int idx = tid + 512 * j, row = idx >> 5, c = idx & 31; r[j] = *(const GAS u32x4*)(Km + (size_t)(b * 256 + i * 64 + row) * D + h * 256 + c * 8); }
    } else {
#pragma unroll
        for (int j = 0; j < 4; ++j) { const int idx = tid + 512 * j, d = idx >> 3, c = idx & 7; r[j] = *(const GAS u32x4*)(Vt + (size_t)(h * 256 + d) * TM + b * 256 + (i - 4) * 64 + c * 8); }
    }
}
__device__ __forceinline__ void att_store_tile(int i, int tid, LAS unsigned char* buf, const u32x4 (&r)[4]) {
    if (i < 4) {
#pragma unroll
        for (int j = 0; j < 4; ++j) { const int idx = tid + 512 * j, row = idx >> 5, c = idx & 31; *(LAS u32x4*)(buf + row * ATT_KROW + c * 16) = r[j]; }
    } else {
#pragma unroll
        for (int j = 0; j < 4; ++j) { const int idx = tid + 512 * j, d = idx >> 3, c = idx & 7; LAS u32x2* dp = (LAS u32x2*)(buf + d * ATT_VROW + c * 16); dp[0] = (u32x2){r[j].x, r[j].y}; dp[1] = (u32x2){r[j].z, r[j].w}; }
    }
}
__device__ __forceinline__ void p5_attn_unit(Frame& F, int u) {
    const int b = u >> 6, h = (u >> 4) & 3, qt = u & 15, tid = opaque(F.tid), lane = tid & 63, w = F.wave, ql = lane & 15, fq = lane >> 4;
    const bf16* Q = (const bf16*)(F.ws + WS_R2); const bf16* Km = (const bf16*)(F.ws + WS_KM); const bf16* Vt = (const bf16*)(F.ws + WS_VT); bf16* O = (bf16*)(F.ws + WS_R3);
    const size_t tq = (size_t)b * SEQ + qt * 128 + w * 16 + ql;
    bf16x8 qf[8];
#pragma unroll
    for (int ds = 0; ds < 8; ++ds) qf[ds] = *(const GAS bf16x8*)(Q + tq * D + h * 256 + 32 * ds + 8 * fq);
    f32x4 S[16];
#pragma unroll
    for (int i = 0; i < 16; ++i) S[i] = (f32x4){0.f, 0.f, 0.f, 0.f};
    u32x4 pre[4];
    __syncthreads();
    att_load_tile(0, b, h, tid, Km, Vt, pre); att_store_tile(0, tid, F.lds, pre);
    __syncthreads();
#pragma unroll
    for (int kt = 0; kt < 4; ++kt) {
        LAS unsigned char* buf = F.lds + (kt & 1) * ATT_BUF;
        att_load_tile(kt + 1, b, h, tid, Km, Vt, pre);
#pragma unroll
        for (int kb = 0; kb < 4; ++kb)
#pragma unroll
            for (int ds = 0; ds < 8; ++ds) { const bf16x8 a = *(const LAS bf16x8*)(buf + (kb * 16 + ql) * ATT_KROW + (32 * ds + 8 * fq) * 2);
                S[kt * 4 + kb] = __builtin_amdgcn_mfma_f32_16x16x32_bf16(a, qf[ds], S[kt * 4 + kb], 0, 0, 0); }
        att_store_tile(kt + 1, tid, F.lds + ((kt + 1) & 1) * ATT_BUF, pre);
        __syncthreads();
    }
    float mx = -3.0e38f;
#pragma unroll
    for (int i = 0; i < 16; ++i) mx = fmaxf(fmaxf(fmaxf(mx, S[i][0]), fmaxf(S[i][1], S[i][2])), S[i][3]);
    mx = fmaxf(mx, __shfl_xor(mx, 16)); mx = fmaxf(mx, __shfl_xor(mx, 32));
    float l = 0.f; bf16x8 pf[8];
#pragma unroll
    for (int st = 0; st < 8; ++st) { float e[8];
#pragma unroll
        for (int j = 0; j < 4; ++j) { e[j] = __builtin_amdgcn_exp2f((S[2 * st][j] - mx) * 1.4426950408889634f); e[4 + j] = __builtin_amdgcn_exp2f((S[2 * st + 1][j] - mx) * 1.4426950408889634f); }
#pragma unroll
        for (int j = 0; j < 8; ++j) l += e[j];
        const u32x4 pk = (u32x4){cvt_pk_bf16(e[0], e[1]), cvt_pk_bf16(e[2], e[3]), cvt_pk_bf16(e[4], e[5]), cvt_pk_bf16(e[6], e[7])};
        pf[st] = __builtin_bit_cast(bf16x8, pk); }
    l += __shfl_xor(l, 16); l += __shfl_xor(l, 32);
    f32x4 Oa[16];
#pragma unroll
    for (int i = 0; i < 16; ++i) Oa[i] = (f32x4){0.f, 0.f, 0.f, 0.f};
#pragma unroll
    for (int vt = 0; vt < 4; ++vt) {
        LAS unsigned char* buf = F.lds + (vt & 1) * ATT_BUF;
        if (vt < 3) att_load_tile(5 + vt, b, h, tid, Km, Vt, pre);
#pragma unroll
        for (int db = 0; db < 16; ++db)
#pragma unroll
            for (int s2 = 0; s2 < 2; ++s2) { const LAS unsigned char* ap = buf + (db * 16 + ql) * ATT_VROW + (32 * s2 + 4 * fq) * 2;
                const u32x2 a0 = *(const LAS u32x2*)ap, a1 = *(const LAS u32x2*)(ap + 32);
                const bf16x8 a = __builtin_bit_cast(bf16x8, (u32x4){a0.x, a0.y, a1.x, a1.y});
                Oa[db] = __builtin_amdgcn_mfma_f32_16x16x32_bf16(a, pf[vt * 2 + s2], Oa[db], 0, 0, 0); }
        if (vt < 3) { att_store_tile(5 + vt, tid, F.lds + ((vt + 1) & 1) * ATT_BUF, pre); __syncthreads(); }
    }
    const float inv = 1.0f / l; bf16* dst = O + tq * D + h * 256 + 4 * fq;
#pragma unroll
    for (int db = 0; db < 16; ++db) *(GAS u32x2*)(dst + 16 * db) = (u32x2){cvt_pk_bf16(Oa[db][0] * inv, Oa[db][1] * inv), cvt_pk_bf16(Oa[db][2] * inv, Oa[db][3] * inv)};
}

__device__ __forceinline__ void p7_router(Frame& F, const Args& A) {
    const int tid = opaque(F.tid), lane = tid & 63, w = F.wave, tl = lane & 15, fq = lane >> 4;
    const bf16* x2b = (const bf16*)(F.ws + WS_R2); const float* ssq2 = (const float*)(F.ws + WS_SSQ2);
    const float* brt = A.in[18]; int* lpid = (int*)(F.ws + WS_LPID); int* pinf = (int*)(F.ws + WS_PINF); float* pwt = (float*)(F.ws + WS_PWT); unsigned char* xq = F.ws + WS_XQ;
    LAS unsigned char* Wt = F.lds;
    LAS int* hist = (LAS int*)(F.lds + LDS_X_OFF); LAS int* basee = hist + 32; LAS int* pinfo = basee + 32; LAS float* pw = (LAS float*)(pinfo + 1024);
    { const unsigned char* src = F.ws + WS_WR; for (int i = tid; i < 131072 / 16; i += NTHREADS) ((LAS u32x4*)Wt)[i] = ((const GAS u32x4*)src)[i]; }
    if (tid < 32) hist[tid] = 0;
    __syncthreads();
    float bias[8];
#pragma unroll
    for (int j = 0; j < 8; ++j) bias[j] = brt[16 * (j >> 2) + 4 * fq + (j & 3)];
    for (int chunk = F.c; chunk < T / 256; chunk += F.G) {
        const int t0 = chunk * 256 + 32 * w + tl;
        const float r0 = row_rms_from_ssq(ssq2, t0), r1 = row_rms_from_ssq(ssq2, t0 + 16);
        f32x4 acc[4][2];
#pragma unroll
        for (int rb = 0; rb < 4; ++rb) { acc[rb][0] = (f32x4){0.f, 0.f, 0.f, 0.f}; acc[rb][1] = (f32x4){0.f, 0.f, 0.f, 0.f}; }
        const bf16* xr0 = x2b + (size_t)t0 * D + 8 * fq; const bf16* xr1 = xr0 + 16 * D;
        unsigned char* xo0 = xq + (size_t)t0 * D + 8 * fq; unsigned char* xo1 = xo0 + 16 * D;
        u32x4 b0 = *(const GAS u32x4*)xr0, b1 = *(const GAS u32x4*)xr1;
#pragma unroll 2
        for (int ks = 0; ks < 32; ++ks) {
            const u32x4 c0 = b0, c1 = b1;
            if (ks < 31) { b0 = *(const GAS u32x4*)(xr0 + 32 * (ks + 1)); b1 = *(const GAS u32x4*)(xr1 + 32 * (ks + 1)); }
            *(GAS u32x2*)(xo0 + 32 * ks) = (u32x2){pk4_fp8(bflo(c0.x) * r0, bfhi(c0.x) * r0, bflo(c0.y) * r0, bfhi(c0.y) * r0), pk4_fp8(bflo(c0.z) * r0, bfhi(c0.z) * r0, bflo(c0.w) * r0, bfhi(c0.w) * r0)};
            *(GAS u32x2*)(xo1 + 32 * ks) = (u32x2){pk4_fp8(bflo(c1.x) * r1, bfhi(c1.x) * r1, bflo(c1.y) * r1, bfhi(c1.y) * r1), pk4_fp8(bflo(c1.z) * r1, bfhi(c1.z) * r1, bflo(c1.w) * r1, bfhi(c1.w) * r1)};
            const bf16x8 f0 = __builtin_bit_cast(bf16x8, c0), f1 = __builtin_bit_cast(bf16x8, c1);
#pragma unroll
            for (int rb = 0; rb < 4; ++rb) { const int rho = 16 * rb + tl; const bf16x8 a = *(const LAS bf16x8*)(Wt + rho * 2048 + (((4 * ks + fq) ^ tl) << 4));
                acc[rb][0] = __builtin_amdgcn_mfma_f32_16x16x32_bf16(a, f0, acc[rb][0], 0, 0, 0); acc[rb][1] = __builtin_amdgcn_mfma_f32_16x16x32_bf16(a, f1, acc[rb][1], 0, 0, 0); }
        }
#pragma unroll
        for (int tb = 0; tb < 2; ++tb) {
            const float r = tb ? r1 : r0; float v[8];
#pragma unroll
            for (int j = 0; j < 8; ++j) v[j] = (acc[j >> 2][tb][j & 3] + acc[2 + (j >> 2)][tb][j & 3]) * r + bias[j];
            int idx[4]; float val[4];
#pragma unroll
            for (int k = 0; k < 4; ++k) {
                float best = v[0]; int bi = 4 * fq;
#pragma unroll
                for (int j = 1; j < 8; ++j) { const int e = 16 * (j >> 2) + 4 * fq + (j & 3); const bool gt = v[j] > best; best = gt ? v[j] : best; bi = gt ? e : bi; }
#pragma unroll
                for (int o = 16; o <= 32; o <<= 1) { const float ob = __shfl_xor(best, o); const int oi = __shfl_xor(bi, o); const bool take = (ob > best) || (ob == best && oi < bi); best = take ? ob : best; bi = take ? oi : bi; }
#pragma unroll
                for (int j = 0; j < 8; ++j) { const int e = 16 * (j >> 2) + 4 * fq + (j & 3); v[j] = (e == bi) ? -3.0e38f : v[j]; }
                idx[k] = bi; val[k] = best; }
            float ex[4], sum = 0.f;
#pragma unroll
            for (int k = 0; k < 4; ++k) { ex[k] = expf(val[k] - val[0]); sum += ex[k]; }
            const float inv = 1.0f / sum;
            if (fq == 0) { const int tloc = 32 * w + 16 * tb + tl;
#pragma unroll
                for (int k = 0; k < 4; ++k) { const int rank = __hip_atomic_fetch_add(hist + idx[k], 1, __ATOMIC_RELAXED, __HIP_MEMORY_SCOPE_WORKGROUP); pinfo[tloc * 4 + k] = idx[k] | (rank << 5); pw[tloc * 4 + k] = ex[k] * inv; } }
        }
        __syncthreads();
        if (tid < 32) { basee[tid] = (int)__hip_atomic_fetch_add((unsigned*)(F.ctl + CW_CNT + tid), (unsigned)hist[tid], RLX_AGENT); hist[tid] = 0; }
        __syncthreads();
#pragma unroll
        for (int j = 0; j < 2; ++j) { const int i = tid + 512 * j, info = pinfo[i], e = info & 31, pos = basee[e] + (info >> 5); lpid[(size_t)e * LISTCAP + pos] = chunk * 1024 + i; pinf[chunk * 1024 + i] = e | (pos << 5); pwt[chunk * 1024 + i] = pw[i]; }
        __syncthreads();
    }
}
__device__ __forceinline__ int moe_tables(Frame& F, LAS int*& tpre, LAS int*& cnts) {
    tpre = (LAS int*)(F.lds + LDS_X_OFF); cnts = tpre + 40;
    __syncthreads();
    if (F.tid < 32) cnts[F.tid] = (int)__hip_atomic_load((unsigned*)(F.ctl + CW_CNT + F.tid), RLX_AGENT);
    __syncthreads();
    if (F.tid == 0) { int s = 0; for (int e = 0; e < 32; ++e) { tpre[e] = s; s += (cnts[e] + 255) >> 8; } tpre[32] = s; }
    __syncthreads();
    { LAS unsigned char* t2e = (LAS unsigned char*)tpre + 11264;
      for (int i = F.tid; i < MAXTILES; i += NTHREADS) { int e = 0; for (int j = 1; j < NE; ++j) e += (tpre[j] <= i) ? 1 : 0; t2e[i] = (unsigned char)e; } }
    __syncthreads();
    return __builtin_amdgcn_readfirstlane(tpre[32]);
}
__device__ __forceinline__ void p10_final(Frame& F, const Args& A) {
    LAS int *tpre, *cnts; (void)moe_tables(F, tpre, cnts);
    const int gw = F.c * NWAVES + F.wave, NGW = F.G * NWAVES, lane = opaque(F.tid) & 63;
    const bf16* x2b = (const bf16*)(F.ws + WS_R2); const unsigned char* Y = F.ws + WS_Y; const float* gf = A.in[25]; float* out = A.out;
    const int* pinf = (const int*)(F.ws + WS_PINF); const float* pwt = (const float*)(F.ws + WS_PWT);
    f32x4 g[4];
#pragma unroll
    for (int hh = 0; hh < 2; ++hh) { g[2 * hh] = *(const f32x4*)(gf + 512 * hh + 8 * lane); g[2 * hh + 1] = *(const f32x4*)(gf + 512 * hh + 8 * lane + 4); }
#pragma unroll 1
    for (int rep10 = 0; rep10 < P10_REP; ++rep10)
    for (int t = gw; t < T; t += NGW) {
        float v[16];
        const int4 pi = *(const int4*)(pinf + 4 * t); const f32x4 pw4 = *(const f32x4*)(pwt + 4 * t);
        const int pinfo4[4] = {pi.x, pi.y, pi.z, pi.w};
#pragma unroll
        for (int hh = 0; hh < 2; ++hh) { const u32x4 w = *(const GAS u32x4*)(x2b + (size_t)t * D + 512 * hh + 8 * lane); const unsigned ww[4] = {w.x, w.y, w.z, w.w};
#pragma unroll
            for (int e = 0; e < 4; ++e) { v[8 * hh + 2 * e] = bflo(ww[e]); v[8 * hh + 2 * e + 1] = bfhi(ww[e]); } }
#pragma unroll
        for (int k = 0; k < 4; ++k) { const int e = pinfo4[k] & 31, pos = pinfo4[k] >> 5; const size_t row = (size_t)tpre[e] * 256 + pos; const float wk = pw4[k];
#pragma unroll
            for (int hh = 0; hh < 2; ++hh) { const u32x2 w = *(const GAS u32x2*)(Y + row * D + 512 * hh + 8 * lane);
                const f32x2 a0 = __builtin_amdgcn_cvt_pk_f32_fp8((int)w.x, false), a1 = __builtin_amdgcn_cvt_pk_f32_fp8((int)w.x, true), a2 = __builtin_amdgcn_cvt_pk_f32_fp8((int)w.y, false), a3 = __builtin_amdgcn_cvt_pk_f32_fp8((int)w.y, true);
                v[8 * hh] += wk * a0[0]; v[8 * hh + 1] += wk * a0[1]; v[8 * hh + 2] += wk * a1[0]; v[8 * hh + 3] += wk * a1[1]; v[8 * hh + 4] += wk * a2[0]; v[8 * hh + 5] += wk * a2[1]; v[8 * hh + 6] += wk * a3[0]; v[8 * hh + 7] += wk * a3[1]; } }
        float s = 0.f;
#pragma unroll
        for (int j = 0; j < 16; ++j) s += v[j] * v[j];
        const float r = rsqrtf(wave_sum(s) * (1.0f / D) + EPS);
#pragma unroll
        for (int hh = 0; hh < 2; ++hh) { float* o = out + (size_t)t * D + 512 * hh + 8 * lane;
            *(GAS f32x4*)o = (f32x4){v[8 * hh] * r * g[2 * hh][0], v[8 * hh + 1] * r * g[2 * hh][1], v[8 * hh + 2] * r * g[2 * hh][2], v[8 * hh + 3] * r * g[2 * hh][3]};
            *(GAS f32x4*)(o + 4) = (f32x4){v[8 * hh + 4] * r * g[2 * hh + 1][0], v[8 * hh + 5] * r * g[2 * hh + 1][1], v[8 * hh + 6] * r * g[2 * hh + 1][2], v[8 * hh + 7] * r * g[2 * hh + 1][3]}; }
    }
}

constexpr int NPHASES = 11;
__global__ void __launch_bounds__(NTHREADS, 2) fwd_kernel(Args args) {
    extern __shared__ __attribute__((aligned(16))) unsigned char lds_raw[];
    Frame F;
    F.lds = (LAS unsigned char*)lds_raw;
    F.MISC = (volatile LAS unsigned*)(F.lds + MISC_OFF);
    F.tid = threadIdx.x; F.lane = F.tid & 63; F.wave = __builtin_amdgcn_readfirstlane(F.tid >> 6);
    F.G = gridDim.x; F.c = blockIdx.x; F.ws = args.ws; F.ctl = (gu32*)(args.ws + WS_CTL);
    for (int u = F.tid; u < 1024 / 4; u += NTHREADS) ((LAS unsigned*)(F.lds + LDSCTL_OFF))[u] = 0u;
    __syncthreads();
    const int lo = args.ph_lo, hi = args.ph_hi;
    XcdBarrier bar; bar.bar = (unsigned*)(F.ctl + CW_BAR); bar.x = 0; bar.st = nullptr;
    if (hi - lo > 1) bar = xcd_barrier_post((unsigned*)(F.ctl + CW_BAR), F.MISC + 8);
#ifndef PH_MASK
#define PH_MASK 0x7ff
#endif
#define IN(k) (((PH_MASK >> (k)) & 1) && lo <= (k) && (k) < hi)
#define SEAM(k) do { if (IN(k) && IN((k) == 4 ? 6 : (k) + 1)) xcd_barrier(bar); } while (0)
#ifndef REPEAT_MASK
#define REPEAT_MASK 0
#endif
#define REPS(k) ((((REPEAT_MASK) >> (k)) & 1) ? 2 : 1)
#define REP_BEGIN(k) for (int rep_ = 0; rep_ < REPS(k); ++rep_) {
#define REP_END(k) if (rep_ + 1 < REPS(k)) xcd_barrier(bar); }
    unsigned char* ws = args.ws;
    if (IN(0)) { REP_BEGIN(0) p0_prologue(F, args); REP_END(0) SEAM(0); }
    if (IN(1)) { REP_BEGIN(1)
        Twice<P1Order, (KTWICE_MASK >> 1) & 1> S{{F.G, F.c, (const char*)ws}};
        EpiP1 E{ws, F.lds + LDS_G_OFF + 8192};
        pg8::gemm_phase<EpiP1, Twice<P1Order, (KTWICE_MASK >> 1) & 1>, false, false, true, 1>(F.lds + RING_OFF, F.lds + LDS_G_OFF, D, D, 8, S, E, 0);
        REP_END(1)
        SEAM(1);
    }
    if (IN(2)) { REP_BEGIN(2)
        unsigned p2acc = 0, p2t0 = 0;
#define P2B(sel) do { if (PROF_PH == 2 && PROF_SEL == (sel)) p2t0 = (unsigned)__builtin_amdgcn_s_memrealtime(); } while (0)
#define P2E(sel) do { if (PROF_PH == 2 && PROF_SEL == (sel)) p2acc += (unsigned)__builtin_amdgcn_s_memrealtime() - p2t0; } while (0)
        if (F.G == 256) {
            if (F.c < 128) { P2B(1); p2_mlstm_chain(F, args, F.c); if (P2_PROBE == 1) p2_mlstm_chain(F, args, F.c); P2E(1); }
            else { P2B(2); const int g = F.c & 3, wi = (F.c - 128) >> 2; p2_gmlp_setup(F, args, g);
                   u32x4 zreg[4]; f32x4 gvr[8], gor[8]; float gbias;
                   { const int tid = F.tid, p = tid & 3, lane = tid & 63, fq = lane >> 4, tl = lane & 15; const float* gv = args.in[8] + g * 128; const float* go = args.in[9] + g * 128;
#pragma unroll
                     for (int j8 = 0; j8 < 4; ++j8) { gvr[2 * j8] = *(const f32x4*)(gv + 8 * (4 * p + j8)); gvr[2 * j8 + 1] = *(const f32x4*)(gv + 8 * (4 * p + j8) + 4); }
#pragma unroll
                     for (int db = 0; db < 8; ++db) gor[db] = *(const f32x4*)(go + 16 * db + 4 * fq);
                     gbias = args.in[7][g * 128 + 16 * F.wave + tl]; }
                   u32x2 ugn[8];
                   { const int tid = F.tid, lane = tid & 63, fq = lane >> 4, tl = lane & 15; const size_t t0 = (size_t)(wi >> 4) * SEQ + (wi & 15) * 128 + 16 * F.wave + tl;
#pragma unroll
                     for (int db = 0; db < 8; ++db) ugn[db] = *(const GAS u32x2*)((const bf16*)(ws + WS_PROJ) + t0 * NP + 1536 + g * 128 + 16 * db + 4 * fq); }
                   { const int tid = F.tid, s = tid >> 2, p = tid & 3; const size_t t0 = (size_t)(wi >> 4) * SEQ + (wi & 15) * 128;
#pragma unroll
                     for (int j8 = 0; j8 < 4; ++j8) zreg[j8] = *(const GAS u32x4*)((const bf16*)(ws + WS_PROJ) + (t0 + s) * NP + 2048 + g * 128 + 32 * p + j8 * 8); }
#pragma unroll 1
                   for (int rp = 0; rp < (P2_PROBE == 2 ? 2 : 1); ++rp)
#pragma unroll 1
                   for (int pi = wi; pi < BATCH * 16; pi += 32) { int pn = pi + 32; if (P2_PROBE == 2 && rp == 0 && pn >= BATCH * 16) pn = wi; p2_gmlp_unit(F, args, pi >> 4, pi & 15, g, zreg, ugn, pn < BATCH * 16, pn >> 4, pn & 15, gvr, gor, gbias); } P2E(2); }
        } else {
            for (int ch = F.c; ch < BATCH * 4; ch += F.G) p2_mlstm_chain_simple(F, args, ch);
            for (int u = (F.c + F.G - (128 % F.G)) % F.G; u < BATCH * 16 * 4; u += F.G) p2_gmlp_unit_simple(F, args, u);
        }
        P2B(3);
        const bool split = (F.G == 256), chainwg = split && F.c < 128; const int jw = F.c & 127;
        { PreOrder<0> S{split ? jw : F.c, split ? 128 : F.G, split ? (chainwg ? 0 : 4) : 512, (const char*)ws}; EpiPre<0> E{(unsigned char*)args.out};
          pg8::gemm_phase<EpiPre<0>, PreOrder<0>>(F.lds + RING_OFF, F.lds + LDS_G_OFF, 4096, 2048, 4, S, E, 0); }
        { PreOrder<1> S{split ? (chainwg ? 384 + jw : jw) : F.c, split ? 128 : F.G, split ? (chainwg ? 1 : 3) : 512, (const char*)ws}; EpiPre<1> E{(unsigned char*)args.out + (size_t)BATCH * 1024 * 1024};
          pg8::gemm_phase<EpiPre<1>, PreOrder<1>>(F.lds + RING_OFF, F.lds + LDS_G_OFF, 2048, 4096, 4, S, E, 0); }
        P2E(3);
        if (PROF_PH == 2) { const unsigned t0 = (unsigned)__builtin_amdgcn_s_memrealtime(); while ((unsigned)__builtin_amdgcn_s_memrealtime() - t0 < p2acc * PROF_MULT) __builtin_amdgcn_s_sleep(8); }
#undef P2B
#undef P2E
        REP_END(2)
        SEAM(2);
    }
    if (IN(3)) { REP_BEGIN(3)
        PlainOrder S{F.G, F.c, T / 256, 4, (const char*)(ws + WS_R2), (const char*)(ws + WS_WOUT), 0, (unsigned)TS1K, 1};
        EpiResid<true> E{(const void*)args.in[0], (bf16*)(ws + WS_R1), (float*)(ws + WS_SSQ1), ws + WS_X1Q};
        pg8::gemm_phase<EpiResid<true>, PlainOrder, false, false, false, 3>(F.lds + RING_OFF, F.lds + LDS_G_OFF, D * 2, D * 2, 16, S, E, 0);
        REP_END(3)
        SEAM(3);
    }
    if (IN(4)) { REP_BEGIN(4)
        PlainOrder S{F.G, F.c, T / 256, 4, (const char*)(ws + WS_X1Q), (const char*)args.out, 1, (unsigned)TSF8, 0};
        EpiSoftmax E{ws + WS_R3, (const float*)(ws + WS_SSQ1), (LAS float*)(F.lds + LDS_G_OFF)};
        pg8::gemm_phase<EpiSoftmax, PlainOrder, true, false, false, 4>(F.lds + RING_OFF, F.lds + LDS_G_OFF, D, D, 8, S, E, 0);
        REP_END(4)
        SEAM(4);
    }
    if (IN(6)) { REP_BEGIN(6)
        PlainOrder S{F.G, F.c, T / 256, 4, (const char*)(ws + WS_R3), (const char*)((const unsigned char*)args.out + (size_t)BATCH * 1024 * 1024), 1, (unsigned)TSF8, 1};
        EpiResid<false> E{(const void*)(ws + WS_R1), (bf16*)(ws + WS_R2), (float*)(ws + WS_SSQ2), nullptr};
        pg8::gemm_phase<EpiResid<false>, PlainOrder, true, false, false, 6>(F.lds + RING_OFF, F.lds + LDS_G_OFF, D, D, 8, S, E, 0);
        REP_END(6)
        SEAM(6);
    }
    if (IN(7)) { p7_router(F, args); SEAM(7); }
    if (IN(8)) { REP_BEGIN(8)
        LAS int *tpre, *cnts; const int NT = moe_tables(F, tpre, cnts);
        Twice<MoeOrder<true, 8>, (KTWICE_MASK >> 8) & 1> S{{F.G, F.c, NT, tpre, (const char*)ws}};
        EpiG1 E{ws, args.in[20], args.in[22]};
        pg8::gemm_phase<EpiG1, Twice<MoeOrder<true, 8>, (KTWICE_MASK >> 8) & 1>, true, false, false, 8>(F.lds + RING_OFF, F.lds + LDS_G_OFF, D, D, 8, S, E, 0);
        REP_END(8)
        SEAM(8);
    }
    if (IN(9)) { REP_BEGIN(9)
        LAS int *tpre, *cnts; const int NT = moe_tables(F, tpre, cnts);
        MoeOrder<false, 4> S{F.G, F.c, NT, tpre, (const char*)ws};
        EpiG2 E{ws, args.in[24], F.lds + LDS_G_OFF + 8192};
        pg8::gemm_phase<EpiG2, MoeOrder<false, 4>, true, false, false, 9>(F.lds + RING_OFF, F.lds + LDS_G_OFF, FF, FF, 8, S, E, 0);
        REP_END(9)
        SEAM(9);
    }
    if (IN(10)) { REP_BEGIN(10) p10_final(F, args); REP_END(10) }
#undef IN
#undef SEAM
}

extern "C" void kernel_launch(void* const* d_in, const int* in_sizes, int n_in, void* d_out, int out_size, void* d_ws, size_t ws_size, hipStream_t stream) {
    static int grid = 0;
    if (grid == 0) {
        if (n_in != 26 || in_sizes[0] != T * D || out_size != T * D || ws_size < WS_END) { fprintf(stderr, "kernel_launch: unexpected shapes (n_in %d, in0 %d, out %d, ws %zu)\n", n_in, n_in > 0 ? in_sizes[0] : -1, out_size, ws_size); grid = -1; return; }
        int dev = 0, cus = 0, per_cu = 0;
        if (hipGetDevice(&dev) != hipSuccess || hipDeviceGetAttribute(&cus, hipDeviceAttributeMultiprocessorCount, dev) != hipSuccess) { grid = -1; return; }
        if (hipFuncSetAttribute((const void*)fwd_kernel, hipFuncAttributeMaxDynamicSharedMemorySize, LDS_BYTES) != hipSuccess) { fprintf(stderr, "kernel_launch: hipFuncSetAttribute failed\n"); grid = -1; return; }
        if (hipOccupancyMaxActiveBlocksPerMultiprocessor(&per_cu, (const void*)fwd_kernel, NTHREADS, LDS_BYTES) != hipSuccess || per_cu < 1) { fprintf(stderr, "kernel_launch: occupancy query says %d\n", per_cu); }
        (void)hipGetLastError();
        grid = cus;
    }
    if (grid < 0) return;
    (void)hipMemsetAsync((char*)d_ws + WS_CTL, 0, CTL_ZERO_BYTES, stream);
    Args a{};
    for (int i = 0; i < 26; ++i) a.in[i] = (const float*)d_in[i];
    a.out = (float*)d_out; a.ws = (unsigned char*)d_ws;
#if MK_PER_PHASE
    for (int ph = 0; ph < NPHASES; ++ph) { a.ph_lo = ph; a.ph_hi = ph + 1; hipLaunchKernelGGL(fwd_kernel, dim3(grid), dim3(NTHREADS), LDS_BYTES, stream, a); }
#else
    a.ph_lo = 0; a.ph_hi = NPHASES; hipLaunchKernelGGL(fwd_kernel, dim3(grid), dim3(NTHREADS), LDS_BYTES, stream, a);
#endif
}
```

```cpp
#include <hip/hip_runtime.h>
#include <cstdio>
#include <cstdint>

#ifndef NOISE_PROBE
#define NOISE_PROBE 0
#endif
#ifndef RELAX_P1
#define RELAX_P1 0
#endif
#ifndef PROF_PH
#define PROF_PH 0
#define PROF_SEL 0
#define PROF_MULT 4
#endif
#ifndef P0X_REP
#define P0X_REP 1
#endif
#ifndef P10_REP
#define P10_REP 1
#endif
#ifndef P0_REP
#define P0_REP 1
#endif
#ifndef MK_PER_PHASE
#define MK_PER_PHASE 0
#endif

#define GAS __attribute__((address_space(1)))
#define LAS __attribute__((address_space(3)))
typedef unsigned short bf16;
typedef short bf16x8 __attribute__((ext_vector_type(8)));
typedef short bf16x16 __attribute__((ext_vector_type(16)));
typedef float f32x4 __attribute__((ext_vector_type(4)));
typedef float f32x2 __attribute__((ext_vector_type(2)));
typedef unsigned u32x4 __attribute__((ext_vector_type(4)));
typedef unsigned u32x2 __attribute__((ext_vector_type(2)));

constexpr int BATCH = 32, SEQ = 2048, T = BATCH * SEQ, D = 1024;
constexpr int MEMLEN = 256, TM = BATCH * MEMLEN;
constexpr int NP = 2560, INW = 2568;
constexpr int NE = 32, TOPK = 4, FF = 1024, NPAIR = T * TOPK;
constexpr int MAXTILES = NPAIR / 256 + NE;
constexpr int LISTCAP = 65536;
constexpr float EPS = 1e-6f;
constexpr int NWAVES = 8, NTHREADS = 512;

constexpr size_t MiB = 1u << 20;
constexpr size_t WS_CTL = 0, CTL_ZERO_BYTES = 65536;
constexpr size_t WS_WIN = 1 * MiB;
constexpr size_t WS_WOUT = 6 * MiB;
constexpr size_t WS_WQ = 8 * MiB;
constexpr size_t WS_WKV = 10 * MiB;
constexpr size_t WS_WXO = 14 * MiB;
constexpr size_t WS_WD = 16 * MiB;
constexpr size_t WS_R2 = 80 * MiB;
constexpr size_t WS_WGU = 208 * MiB;
constexpr size_t WS_R1 = 336 * MiB;
constexpr size_t WS_R3 = 464 * MiB;
constexpr size_t WS_KM = 592 * MiB;
constexpr size_t WS_VT = 608 * MiB;
constexpr size_t WS_PROJ = 624 * MiB;
constexpr size_t WS_Y = 208 * MiB;
constexpr size_t WS_H2 = 736 * MiB;
constexpr size_t WS_X1Q = WS_PROJ + 64 * MiB;
constexpr size_t WS_XQ = WS_PROJ;
constexpr size_t WS_MISC = 48 * MiB;
constexpr size_t WS_GATES = WS_MISC;
constexpr size_t WS_SSQ1 = WS_MISC + 2 * MiB;
constexpr size_t WS_SSQ2 = WS_MISC + 6 * MiB;
constexpr size_t WS_RR2 = WS_MISC + 10 * MiB;
constexpr size_t WS_WR = WS_MISC + 11 * MiB;
constexpr size_t WS_LPID = WS_MISC + 12 * MiB;
constexpr size_t WS_PINF = WS_MISC + 20 * MiB;
constexpr size_t WS_PWT = WS_MISC + 21 * MiB;
constexpr size_t WS_SA = WS_MISC + 22 * MiB;
constexpr size_t WS_SAM = WS_SA + 512 * 1024;
constexpr size_t WS_SB = WS_MISC + 23 * MiB;
constexpr size_t WS_SBKV = WS_SB + 16384;
constexpr size_t WS_END = 1024 * MiB;
static_assert(WS_PWT + 1 * MiB <= WS_R2 && WS_WD + 32 * MiB <= WS_MISC && WS_H2 + (size_t)MAXTILES * 256 * 1024 <= WS_END && WS_Y + (size_t)MAXTILES * 256 * 1024 * 2 <= WS_H2, "ws map");
static_assert(WS_PROJ + (size_t)T * NP * 2 <= WS_END, "ws map 2");
constexpr int CW_TMO = 0, CW_CODE = 1, CW_P0CNT = 16  , CW_CNT = 1024  , CW_BAR = 4096, CW_CMAX = 8192  ;

constexpr int RING_OFF = 0, RING_BYTES = 131072;
constexpr int LDSCTL_OFF = RING_BYTES, MISC_OFF = LDSCTL_OFF + 320;
constexpr int LDS_X_OFF = LDSCTL_OFF + 1024;
constexpr int LDS_G_OFF = LDS_X_OFF + 1024;
constexpr int LDS_BYTES = 147456;

#define LDS_WAIT() asm volatile("s_waitcnt lgkmcnt(0)" ::: "memory")
#define VM_WAIT() asm volatile("s_waitcnt vmcnt(0)" ::: "memory")
typedef GAS unsigned gu32;
#define RLX_AGENT __ATOMIC_RELAXED, __HIP_MEMORY_SCOPE_AGENT

__device__ __forceinline__ unsigned f2bf(float f) { unsigned u = __builtin_bit_cast(unsigned, f); return (u + 0x7fffu + ((u >> 16) & 1u)) >> 16; }
__device__ __forceinline__ unsigned pk2(float lo, float hi) { return f2bf(lo) | (f2bf(hi) << 16); }
__device__ __forceinline__ float bf2f(unsigned b) { return __builtin_bit_cast(float, b << 16); }
__device__ __forceinline__ float bflo(unsigned w) { return __builtin_bit_cast(float, w << 16); }
__device__ __forceinline__ float bfhi(unsigned w) { return __builtin_bit_cast(float, w & 0xffff0000u); }
__device__ __forceinline__ unsigned cvt_pk_bf16(float lo, float hi) { unsigned r; asm volatile("v_cvt_pk_bf16_f32 %0, %1, %2" : "=v"(r) : "v"(lo), "v"(hi)); return r; }
__device__ __forceinline__ unsigned pk4_fp8(float a, float b, float c, float d) { int w = __builtin_amdgcn_cvt_pk_fp8_f32(a, b, 0, false); w = __builtin_amdgcn_cvt_pk_fp8_f32(c, d, w, true); return (unsigned)w; }
__device__ __forceinline__ unsigned pk4_i8s(float a, float b, float c, float d, float s) {
    const unsigned ua = __builtin_bit_cast(unsigned, __builtin_fmaf(a, s, 12582912.0f)), ub = __builtin_bit_cast(unsigned, __builtin_fmaf(b, s, 12582912.0f));
    const unsigned uc = __builtin_bit_cast(unsigned, __builtin_fmaf(c, s, 12582912.0f)), ud = __builtin_bit_cast(unsigned, __builtin_fmaf(d, s, 12582912.0f));
    return __builtin_amdgcn_perm(__builtin_amdgcn_perm(ud, uc, 0x0c0c0400u), __builtin_amdgcn_perm(ub, ua, 0x0c0c0400u), 0x05040100u); }
__device__ __forceinline__ unsigned pk4_i8(float a, float b, float c, float d) { return pk4_i8s(a, b, c, d, 1.0f); }
__device__ __forceinline__ int opaque(int x) { asm volatile("" : "+v"(x)); return x; }
template <int CTRL> __device__ __forceinline__ float dpp_f(float v) { return __builtin_bit_cast(float, __builtin_amdgcn_update_dpp(0, __builtin_bit_cast(int, v), CTRL, 0xf, 0xf, false)); }
__device__ __forceinline__ float lane_f(float v, int l) { return __builtin_bit_cast(float, __builtin_amdgcn_readlane(__builtin_bit_cast(int, v), l)); }
__device__ __forceinline__ float wave_sum(float v) {
    v += dpp_f<0x121>(v); v += dpp_f<0x122>(v); v += dpp_f<0x124>(v); v += dpp_f<0x128>(v);
    return (lane_f(v, 0) + lane_f(v, 16)) + (lane_f(v, 32) + lane_f(v, 48));
}
__device__ __forceinline__ float wave_max(float v) {
    v = fmaxf(v, dpp_f<0x121>(v)); v = fmaxf(v, dpp_f<0x122>(v)); v = fmaxf(v, dpp_f<0x124>(v)); v = fmaxf(v, dpp_f<0x128>(v));
    return fmaxf(fmaxf(lane_f(v, 0), lane_f(v, 16)), fmaxf(lane_f(v, 32), lane_f(v, 48)));
}
__device__ __forceinline__ float sum8(float v) {
    v += dpp_f<0xB1>(v); v += dpp_f<0x4E>(v); v += dpp_f<0x141>(v); return v;
}
__device__ __forceinline__ float gelu_tanh(float x) {
    const float z = x * (1.0f + 0.044715f * x * x) * (-2.0f * 0.7978845608028654f * 1.4426950408889634f);
    return x * __builtin_amdgcn_rcpf(1.0f + __builtin_amdgcn_exp2f(z));
}
__device__ __forceinline__ f32x2 gelu_tanh2(f32x2 x) {
    f32x2 z = x * (x * x * 0.044715f + 1.0f) * (-2.0f * 0.7978845608028654f * 1.4426950408889634f);
    z.x = fminf(z.x, 60.0f); z.y = fminf(z.y, 60.0f);
    f32x2 d; d.x = __builtin_amdgcn_exp2f(z.x); d.y = __builtin_amdgcn_exp2f(z.y);
    d = d + 1.0f;
    const float r = __builtin_amdgcn_rcpf(d.x * d.y);
    f32x2 sg; sg.x = r * d.y; sg.y = r * d.x;
    return x * sg;
}
__device__ __forceinline__ float sigmoidf_fast(float x) { return __builtin_amdgcn_rcpf(1.0f + __builtin_amdgcn_exp2f(-1.4426950408889634f * x)); }

namespace pg8 {
constexpr int BM = 256, BK = 64, HALF = 128, HTB = HALF * BK * 2, STAGE_BYTES = 8 * HTB;
__host__ __device__ __forceinline__ int lds_byte(int r, int c) { const int st = (r >> 4) * 2 + (c >> 5), rr = r & 15, cc = c & 31, ob = rr * 64 + cc * 2; return st * 1024 + (ob ^ (((ob >> 9) & 1) << 5)); }
__host__ __device__ __forceinline__ void stage_rc(int b, int& R, int& C) { const int st = b / 1024, sb = b % 1024, swz = sb ^ (((sb >> 9) & 1) << 5); R = (st >> 1) * 16 + swz / 64; C = (st & 1) * 32 + (swz % 64) / 2; }
__host__ __device__ __forceinline__ int perm32(int rho) { const int n = rho >> 4, i = rho & 15; return 8 * (i >> 2) + 4 * n + (i & 3); }
__host__ __device__ __forceinline__ int permB(int R) { const int n = (R >> 4) & 1, i = R & 15; return 64 * (R >> 5) + 16 * (i >> 2) + 4 * n + (i & 3); }
struct Unit { int pm, pn, aux, skip, par; };
template <int NN, int WGM = 8> __device__ __forceinline__ void tile_remap(int L, int nM, int& pm, int& pn) {
    const int nwg = nM * NN; int wgid = L;
    { const int q = nwg >> 3, r = nwg & 7, xcd = wgid & 7, off = wgid >> 3; wgid = (xcd < r ? xcd * (q + 1) : r * (q + 1) + (xcd - r) * q) + off; }
    constexpr int nig = WGM * NN; const int gid = wgid / nig, idx = wgid - gid * nig, fm = gid * WGM, left = nM - fm;
    if (left >= WGM) { pm = fm + (idx % WGM); pn = idx / WGM; } else { pm = fm + (idx % left); pn = idx / left; }
}
typedef int i32x8 __attribute__((ext_vector_type(8)));
typedef int i32x4 __attribute__((ext_vector_type(4)));
template <class Epi, class Sched, bool F8 = false, bool PF = false, bool I8 = false, int PID = -1>
__device__ __forceinline__ void gemm_phase(LAS unsigned char* lds, LAS unsigned char* xlds, const int RP, const int RPB, const int nt, const Sched& S, const Epi& E, const int stagger_ticks) {
    int tid_ = threadIdx.x; asm volatile("" : "+v"(tid_));
    const int tid = tid_, wid = __builtin_amdgcn_readfirstlane(tid >> 6), lane = tid & 63, wr = wid >> 2, wc = wid & 3, fr = lane & 15, fq = lane >> 4;
    int Rr[2], Cc[2]; unsigned voffB[2];
#pragma unroll
    for (int i = 0; i < 2; ++i) { int R, C; stage_rc(tid * 16 + i * 8192, R, C); Rr[i] = R; Cc[i] = C; const int Rb = Epi::PERM ? permB(R) : R; voffB[i] = (unsigned)(Rb * RPB + C * 2); }
    const size_t kstep = (size_t)(BK * 2);
    const size_t hstep = (size_t)HALF * RP, hstepB = (size_t)(Epi::PERM ? 8 : HALF) * RPB;
    const unsigned ldsw = (unsigned)wid * 1024u;
    const unsigned ldsb0 = (unsigned)__builtin_amdgcn_readfirstlane((int)(unsigned)(size_t)lds) + ldsw; const unsigned ldsb = ldsb0;
    const int aoff = lds_byte(wr * 64 + fr, fq * 8), boff = lds_byte(wc * 32 + fr, fq * 8);
    const unsigned voffP = (unsigned)((32 * wid + (lane & 31)) * RP + (lane >> 5) * 128);
    const unsigned ldsP = (unsigned)__builtin_amdgcn_readfirstlane((int)(unsigned)(size_t)xlds) + 8192u + (unsigned)wid * 256u;
#define PG8_SA(b, h) (((b) * 2 + (h)) * HTB)
#define PG8_SB(b, h) ((4 + (b) * 2 + (h)) * HTB)
#define PG8_UNI64(p) ((const char*)((((unsigned long long)(unsigned)__builtin_amdgcn_readfirstlane((int)((unsigned long long)(p) >> 32))) << 32) | (unsigned long long)(unsigned)__builtin_amdgcn_readfirstlane((int)(unsigned)(unsigned long long)(p))))
#define PG8_GLDS(gptr, voff32, ldsa) asm volatile("s_mov_b32 m0, %2\n\ts_nop 0\n\tglobal_load_lds_dwordx4 %0, %1" :: "v"(voff32), "s"(gptr), "s"(ldsa) : "memory", "m0")
#define PG8_STAGE(bufoff, gbase, voff) do { PG8_GLDS((const char*)(gbase), (voff)[0], ldsb + (bufoff)); PG8_GLDS((const char*)(gbase), (voff)[1], ldsb + (bufoff) + 8192u); } while (0)
#define PG8_STAGEA(bufoff, gbase, o0, o1) do { PG8_GLDS((const char*)(gbase), (o0), ldsb + (bufoff)); PG8_GLDS((const char*)(gbase), (o1), ldsb + (bufoff) + 8192u); } while (0)
#define PG8_STAGEA1(bufoff, gbase) do { if constexpr (Sched::GATHER) { PG8_STAGEA(bufoff, gbase, vA2, vA3); } else { PG8_STAGEA(bufoff, (gbase) + hstep, vA0, vA1); } } while (0)
#define PG8_LD32(p) __builtin_shufflevector(*(const LAS i32x4*)(p), *(const LAS i32x4*)((p) + 1024), 0, 1, 2, 3, 4, 5, 6, 7)
#define PG8_LDA(dst, b, h) do { if constexpr (F8) { _Pragma("unroll") for (int m = 0; m < 4; ++m) dst##8[m] = PG8_LD32(lds + PG8_SA(b, h) + aoff + m * 2048); } else { \
        _Pragma("unroll") for (int m = 0; m < 4; ++m) _Pragma("unroll") for (int k = 0; k < 2; ++k) dst[m][k] = *(const LAS bf16x8*)(lds + PG8_SA(b, h) + aoff + m * 2048 + k * 1024); } } while (0)
#define PG8_LDB(dst, b, h) do { if constexpr (F8) { _Pragma("unroll") for (int n = 0; n < 2; ++n) dst##8[n] = PG8_LD32(lds + PG8_SB(b, h) + boff + n * 2048); } else { \
        _Pragma("unroll") for (int n = 0; n < 2; ++n) _Pragma("unroll") for (int k = 0; k < 2; ++k) dst[n][k] = *(const LAS bf16x8*)(lds + PG8_SB(b, h) + boff + n * 2048 + k * 1024); } } while (0)
#define PG8_MMA(ai, bj, At, Bt) do { __builtin_amdgcn_s_setprio(1); if constexpr (F8) { _Pragma("unroll") for (int m = 0; m < 4; ++m) _Pragma("unroll") for (int n = 0; n < 2; ++n) \
        acc[ai][bj][m][n] = __builtin_amdgcn_mfma_scale_f32_16x16x128_f8f6f4(Bt##8[n], At##8[m], acc[ai][bj][m][n], 0, 0, 0, 0, 0, 0); } else {         \
        _Pragma("unroll") for (int m = 0; m < 4; ++m) _Pragma("unroll") for (int n = 0; n < 2; ++n) _Pragma("unroll") for (int k = 0; k < 2; ++k) \
        { if constexpr (I8) acc[ai][bj][m][n] = __builtin_bit_cast(f32x4, __builtin_amdgcn_mfma_i32_16x16x64_i8(__builtin_bit_cast(i32x4, Bt[n][k]), __builtin_bit_cast(i32x4, At[m][k]), __builtin_bit_cast(i32x4, acc[ai][bj][m][n]), 0, 0, 0)); \
          else acc[ai][bj][m][n] = __builtin_amdgcn_mfma_f32_16x16x32_bf16(Bt[n][k], At[m][k], acc[ai][bj][m][n], 0, 0, 0); } } __builtin_amdgcn_s_setprio(0); } while (0)
#define PG8_ZERO_ACC() do { f32x2 z2_ = (f32x2){0.f, 0.f}; asm volatile("s_nop 7" : "+v"(z2_)); _Pragma("unroll") for (int a = 0; a < 2; ++a) _Pragma("unroll") for (int b = 0; b < 2; ++b) _Pragma("unroll") for (int m = 0; m < 4; ++m) _Pragma("unroll") for (int n = 0; n < 2; ++n) \
        asm volatile("v_mfma_f32_4x4x4_16b_f16 %0, %1, %1, 0" : "=&v"(acc[a][b][m][n]) : "v"(z2_)); asm volatile("s_nop 7\n\ts_nop 7" ::: "memory"); } while (0)
#define PG8_WAIT_V(n) asm volatile("s_waitcnt vmcnt(" #n ")" ::: "memory")
#define PG8_WAIT_VR() PG8_WAIT_V(8)
#define PG8_WAIT_VX() do { if (relax) asm volatile("s_waitcnt vmcnt(%0)" :: "n"(8 + Epi::RELAX) : "memory"); else PG8_WAIT_V(8); } while (0)
#define PG8_WAIT_L(n) asm volatile("s_waitcnt lgkmcnt(" #n ")" ::: "memory")
#define PG8_BAR __builtin_amdgcn_s_barrier()
#define PG8_SCHED __builtin_amdgcn_sched_barrier(0)
    Unit cur, nxt; int ui = 0; bool epi_ran = false;
    constexpr bool PROF = (PROF_PH != 0) && (PID == PROF_PH);
    unsigned prof_acc = 0, prof_t0 = 0;
#define PROF_BEGIN(sel) do { if constexpr (PROF && PROF_SEL == (sel)) prof_t0 = (unsigned)__builtin_amdgcn_s_memrealtime(); } while (0)
#define PROF_END(sel) do { if constexpr (PROF && PROF_SEL == (sel)) prof_acc += (unsigned)__builtin_amdgcn_s_memrealtime() - prof_t0; } while (0)
    if (!S.next(0, cur)) return;
    if (stagger_ticks > 0) {
        const unsigned long long t0 = __builtin_amdgcn_s_memrealtime(), dt = (unsigned long long)stagger_ticks;
        while (__builtin_amdgcn_s_memrealtime() - t0 < dt) __builtin_amdgcn_s_sleep(8);
    }
    f32x4 acc[2][2][4][2];
    bf16x8 At[4][2], B0[2][2], B1[2][2]; i32x8 At8[4], B08[2], B18[2];
    unsigned vA0, vA1, vA2, vA3;
    { unsigned v[4]; S.a_offsets(cur, Rr, Cc, RP, v); vA0 = v[0]; vA1 = v[1]; vA2 = v[2]; vA3 = v[3]; }
    const char* cA = PG8_UNI64(S.Abase(cur)); const char* cB = PG8_UNI64(S.Bbase(cur));
    bool has_next = S.next(1, nxt);
    if constexpr (Epi::BIAS_DMA) E.bias_dma(cur, xlds + 8192, wid, lane);
    const char* nA = cA; const char* nB = cB;
    LAS u32x4* nslot = (LAS u32x4*)(xlds) + tid;
    if (has_next) { nA = PG8_UNI64(S.Abase(nxt)); nB = PG8_UNI64(S.Bbase(nxt)); }
    if (Sched::GATHER) { unsigned v[4] = {vA0, vA1, vA2, vA3}; if (has_next) S.a_offsets(nxt, Rr, Cc, RP, v); *nslot = (u32x4){v[0], v[1], v[2], v[3]}; }
    PG8_ZERO_ACC();
    PG8_STAGE(PG8_SB(0, 0), cB, voffB); PG8_STAGE(PG8_SB(0, 1), cB + hstepB, voffB); PG8_STAGEA(PG8_SA(0, 0), cA, vA0, vA1); PG8_STAGEA1(PG8_SA(0, 1), cA);
    if (wr == 1) PG8_BAR;
    PG8_WAIT_V(2); PG8_BAR;
    PG8_STAGE(PG8_SB(1, 0), cB + kstep, voffB); PG8_STAGEA(PG8_SA(1, 0), cA + kstep, vA0, vA1); PG8_STAGE(PG8_SB(1, 1), cB + hstepB + kstep, voffB);
    PG8_WAIT_V(6); PG8_BAR;
    for (;;) {
        PROF_BEGIN(1);
#pragma unroll 1
        for (int t = 0; t < nt; t += 2) {
            const bool last = (t == nt - 2);
            unsigned ldsb = ldsb0; asm volatile("" : "+s"(ldsb));
            const char* a1 = cA + (size_t)(t + 1) * kstep;
            const char* a2 = last ? nA : cA + (size_t)(t + 2) * kstep; const char* b2 = last ? nB : cB + (size_t)(t + 2) * kstep;
            const char* a3 = a2 + kstep; const char* b3 = b2 + kstep;
            if constexpr (PF) { const char* pfa = (t + 4 < nt) ? cA + (size_t)(t + 4) * kstep : nA + (size_t)(t + 4 - nt) * kstep;
                asm volatile("s_mov_b32 m0, %2\n\ts_nop 0\n\tglobal_load_lds_dword %0, %1" :: "v"(voffP), "s"(pfa), "s"(ldsP) : "memory", "m0"); }
            const bool relax = (Epi::RELAX > 0) && (t == 0) && epi_ran;
            PG8_LDB(B0, 0, 0); PG8_LDB(B1, 0, 1); PG8_SCHED; PG8_LDA(At, 0, 0); PG8_STAGEA1(PG8_SA(1, 1), a1);
            if (Sched::GATHER) { if (last) { const u32x4 nv = *nslot; vA0 = nv.x; vA1 = nv.y; vA2 = nv.z; vA3 = nv.w; } }
            PG8_WAIT_VX(); PG8_WAIT_L(0); PG8_BAR; PG8_MMA(0, 0, At, B0); PG8_MMA(0, 1, At, B1); PG8_BAR; PG8_SCHED;
            if constexpr (Epi::BIAS_DMA) { if (t == 0 && has_next) E.bias_dma(nxt, xlds + 8192 + ((ui + 1) & 1) * Epi::BIAS_STRIDE, wid, lane); }
            PG8_LDA(At, 0, 1); PG8_STAGE(PG8_SB(0, 0), b2, voffB); PG8_STAGE(PG8_SB(0, 1), b2 + hstepB, voffB); PG8_STAGEA(PG8_SA(0, 0), a2, vA0, vA1);
            PG8_WAIT_VX(); PG8_WAIT_L(0); PG8_BAR; PG8_MMA(1, 0, At, B0); PG8_MMA(1, 1, At, B1); PG8_BAR; PG8_SCHED;
            PG8_LDB(B0, 1, 0); PG8_LDB(B1, 1, 1); PG8_SCHED; PG8_LDA(At, 1, 0); PG8_STAGEA1(PG8_SA(0, 1), a2);
            PG8_WAIT_VR(); PG8_WAIT_L(0); PG8_BAR; PG8_MMA(0, 0, At, B0); PG8_MMA(0, 1, At, B1); PG8_BAR; PG8_SCHED;
            PG8_LDA(At, 1, 1); PG8_STAGE(PG8_SB(1, 0), b3, voffB); PG8_STAGE(PG8_SB(1, 1), b3 + hstepB, voffB); PG8_STAGEA(PG8_SA(1, 0), a3, vA0, vA1);
            PG8_WAIT_VR(); PG8_WAIT_L(0); PG8_BAR; PG8_MMA(1, 0, At, B0); PG8_MMA(1, 1, At, B1); PG8_BAR; PG8_SCHED;
        }
        PROF_END(1); PROF_BEGIN(3);
        if (wr == 0) PG8_BAR;
        Unit nn; bool has_nn = false; unsigned gv[4] = {vA0, vA1, vA2, vA3};
        if (has_next) { has_nn = S.next(ui + 2, nn); if (Sched::GATHER) { if (has_nn) S.a_offsets(nn, Rr, Cc, RP, gv); } }
        cur.par = ui & 1;
        PROF_END(3); PROF_BEGIN(2);
        if (!cur.skip) { const int t2 = opaque((int)threadIdx.x), fr2 = t2 & 15, fq2 = (t2 >> 4) & 3; E(acc, cur, wr, wc, fr2, fq2); }
        epi_ran = !cur.skip;
        PROF_END(2);
        if (!has_next) break;
        PROF_BEGIN(3);
        cur = nxt; cA = nA; cB = nB; ++ui;
        has_next = has_nn; nxt = nn;
        if (has_next) { nA = PG8_UNI64(S.Abase(nxt)); nB = PG8_UNI64(S.Bbase(nxt)); }
        if (Sched::GATHER) { *nslot = (u32x4){gv[0], gv[1], gv[2], gv[3]}; asm volatile("" ::: "memory"); }
        PG8_ZERO_ACC();
        if (wr == 1) PG8_BAR;
        PROF_END(3);
    }
    PG8_WAIT_V(0);
    PG8_BAR;
    if constexpr (PROF) { const unsigned t0 = (unsigned)__builtin_amdgcn_s_memrealtime(); while ((unsigned)__builtin_amdgcn_s_memrealtime() - t0 < prof_acc * PROF_MULT) __builtin_amdgcn_s_sleep(8); }
#undef PROF_BEGIN
#undef PROF_END
#undef PG8_SA
#undef PG8_SB
#undef PG8_STAGE
#undef PG8_STAGEA
#undef PG8_STAGEA1
#undef PG8_GLDS
#undef PG8_UNI64
#undef PG8_LDA
#undef PG8_LD32
#undef PG8_LDB
#undef PG8_MMA
#undef PG8_ZERO_ACC
#undef PG8_WAIT_V
#undef PG8_WAIT_VR
#undef PG8_WAIT_VX
#undef PG8_WAIT_L
#undef PG8_BAR
#undef PG8_SCHED
}
}

#define XB_TMO      128
#define XB_XCNT(j)  (256  + 64 * (j))
#define XB_XSUB(j)  (1280 + 64 * (j))
#define XB_XGEN(j)  (2304 + 64 * (j))
#define XB_TOP      3328
#define XB_TOPGEN   3392
#define XCD_BAR_WORDS 3456
#define XB_SPIN_CAP (1u << 18)
__device__ __forceinline__ unsigned xb_ld(unsigned* p)              { return __hip_atomic_load(p, __ATOMIC_RELAXED, __HIP_MEMORY_SCOPE_AGENT); }
__device__ __forceinline__ unsigned xb_add(unsigned* p, unsigned v) { return __hip_atomic_fetch_add(p, v, __ATOMIC_RELAXED, __HIP_MEMORY_SCOPE_AGENT); }
__device__ __forceinline__ unsigned xb_xcc_id() { return (unsigned)__builtin_amdgcn_s_getreg((3 << 11) | 20) & 0xFu; }
#define XB_SPIN(cond, bar) do { unsigned _sp = 0; while (cond) { __builtin_amdgcn_s_sleep(1); \
    if ((++_sp & 255u) == 0u) { if (xb_ld(&(bar)[XB_TMO])) break; if (_sp > XB_SPIN_CAP) { atomicAdd(&(bar)[XB_TMO], 1u); break; } } } } while (0)
struct XcdBarrier { unsigned* bar; unsigned x; volatile LAS unsigned* st; };
__device__ __forceinline__ XcdBarrier xcd_barrier_post(unsigned* bar, volatile LAS unsigned* st) {
    XcdBarrier b; b.bar = bar; b.x = xb_xcc_id(); b.st = st;
    if (threadIdx.x == 0) (void)xb_add(&bar[XB_XCNT(b.x)], 1u);
    return b;
}
__device__ __forceinline__ void xcd_barrier_complete(unsigned* bar, unsigned x, unsigned& nloc, unsigned& nx) {
    const unsigned G = gridDim.x * gridDim.y * gridDim.z;
    unsigned sum, cnt, mine, sp = 0u;
    for (;;) {
        sum = 0u; cnt = 0u; mine = 0u;
#pragma unroll
        for (unsigned j = 0; j < 16; ++j) { const unsigned c = xb_ld(&bar[XB_XCNT(j)]); sum += c; cnt += (c > 0u) ? 1u : 0u; mine = (j == x) ? c : mine; }
        if (sum == G) break;
        __builtin_amdgcn_s_sleep(1);
        if ((++sp & 255u) == 0u) { if (xb_ld(&bar[XB_TMO])) break; if (sp > XB_SPIN_CAP) { atomicAdd(&bar[XB_TMO], 1u); break; } }
    }
    nloc = mine > 0u ? mine : 1u; nx = cnt > 0u ? cnt : 1u;
}
__device__ __forceinline__ void xcd_barrier(const XcdBarrier& b) {
    asm volatile("s_waitcnt vmcnt(0)" ::: "memory");
    __syncthreads();
    if (threadIdx.x == 0) {
        unsigned* bar = b.bar;
        __builtin_amdgcn_s_waitcnt(0);
        unsigned nloc = b.st[0], nx = b.st[1];
        if (nloc == 0u) { xcd_barrier_complete(bar, b.x, nloc, nx); b.st[0] = nloc; b.st[1] = nx; }
        const unsigned old = xb_add(&bar[XB_XSUB(b.x)], 1u);
        const unsigned gen = old / nloc;
        if (old + 1u == (gen + 1u) * nloc) {
            __builtin_amdgcn_fence(__ATOMIC_RELEASE, "agent");
            asm volatile("s_waitcnt vmcnt(0)" ::: "memory");
            const unsigned og = xb_add(&bar[XB_TOP], 1u);
            const unsigned tg = og / nx;
            if (og + 1u == (tg + 1u) * nx) xb_add(&bar[XB_TOPGEN], 1u);
            else XB_SPIN(xb_ld(&bar[XB_TOPGEN]) == tg, bar);
            __builtin_amdgcn_fence(__ATOMIC_ACQUIRE, "agent");
            xb_add(&bar[XB_XGEN(b.x)], 1u);
            asm volatile("s_waitcnt vmcnt(0)" ::: "memory");
        } else {
            XB_SPIN(xb_ld(&bar[XB_XGEN(b.x)]) == gen, bar);
            __builtin_amdgcn_fence(__ATOMIC_ACQUIRE, "agent");
            asm volatile("s_waitcnt vmcnt(0)" ::: "memory");
        }
    }
    __syncthreads();
}

struct Frame {
    LAS unsigned char* lds;
    volatile LAS unsigned* MISC;
    gu32* ctl;
    int tid, lane, wave, G, c;
    unsigned char* ws;
};
struct Args { const float* in[26]; float* out; unsigned char* ws; int ph_lo, ph_hi; };

__device__ __forceinline__ void p0_transpose_item(const float* W, int ldw, int csrc0, int k0, const float* gain, bf16* WT, int Kd, int drow0, LAS float* scr, int lane) {
    { f32x4 v[8]; const int r8 = lane >> 3, c4 = (lane & 7) * 4;
#pragma unroll
      for (int i = 0; i < 8; ++i) v[i] = *(const GAS f32x4*)(W + (size_t)(k0 + 8 * i + r8) * ldw + csrc0 + c4);
#pragma unroll
      for (int i = 0; i < 8; ++i) { const int kk = 8 * i + r8; const float g = gain ? gain[k0 + kk] : 1.0f; scr[kk * 33 + c4] = v[i][0] * g; scr[kk * 33 + c4 + 1] = v[i][1] * g; scr[kk * 33 + c4 + 2] = v[i][2] * g; scr[kk * 33 + c4 + 3] = v[i][3] * g; } }
    LDS_WAIT(); asm volatile("" ::: "memory");
    const int c = lane & 7;
#pragma unroll
    for (int j = 0; j < 4; ++j) { const int n = (lane >> 3) + 8 * j; const LAS float* s = scr + (8 * c) * 33 + n;
        u32x4 o; o.x = pk2(s[0 * 33], s[1 * 33]); o.y = pk2(s[2 * 33], s[3 * 33]); o.z = pk2(s[4 * 33], s[5 * 33]); o.w = pk2(s[6 * 33], s[7 * 33]);
        *(GAS u32x4*)(WT + (size_t)(drow0 + n) * Kd + k0 + 8 * c) = o; }
    LDS_WAIT(); asm volatile("" ::: "memory");
}

__device__ __forceinline__ void p0_transpose_item_f8(const float* W, int ldw, int csrc0, int k0, const float* gain, float scale, unsigned char* WT, int Kd, int drow0, LAS float* scr, int lane, const bool ileave = false) {
    { f32x4 v[8]; const int r8 = lane >> 3, c4 = (lane & 7) * 4;
#pragma unroll
      for (int i = 0; i < 8; ++i) v[i] = *(const GAS f32x4*)(W + (size_t)(k0 + 8 * i + r8) * ldw + csrc0 + c4);
#pragma unroll
      for (int i = 0; i < 8; ++i) { const int kk = 8 * i + r8; const float g = gain ? gain[k0 + kk] * scale : scale; scr[kk * 33 + c4] = v[i][0] * g; scr[kk * 33 + c4 + 1] = v[i][1] * g; scr[kk * 33 + c4 + 2] = v[i][2] * g; scr[kk * 33 + c4 + 3] = v[i][3] * g; } }
    LDS_WAIT(); asm volatile("" ::: "memory");
    const int c = lane & 7;
#pragma unroll
    for (int j = 0; j < 4; ++j) { const int n = (lane >> 3) + 8 * j; const LAS float* s = scr + (8 * c) * 33 + n;
        *(GAS u32x2*)(WT + (size_t)(drow0 + (ileave ? 2 * (n & ~7) + (n & 7) : n)) * Kd + k0 + 8 * c) = (u32x2){pk4_fp8(s[0 * 33], s[1 * 33], s[2 * 33], s[3 * 33]), pk4_fp8(s[4 * 33], s[5 * 33], s[6 * 33], s[7 * 33])}; }
    LDS_WAIT(); asm volatile("" ::: "memory");
}
__device__ __forceinline__ void p0_colmax_item(const float* W, int ldw, int csrc0, int k0, gu32* cmax, int lane) {
    const int r8 = lane >> 3, c4 = (lane & 7) * 4; f32x4 v[8];
#pragma unroll
    for (int i = 0; i < 8; ++i) v[i] = *(const GAS f32x4*)(W + (size_t)(k0 + 8 * i + r8) * ldw + csrc0 + c4);
    float m0 = 0.f, m1 = 0.f, m2 = 0.f, m3 = 0.f;
#pragma unroll
    for (int i = 0; i < 8; ++i) { m0 = fmaxf(m0, fabsf(v[i].x)); m1 = fmaxf(m1, fabsf(v[i].y)); m2 = fmaxf(m2, fabsf(v[i].z)); m3 = fmaxf(m3, fabsf(v[i].w)); }
#pragma unroll
    for (int o = 8; o < 64; o <<= 1) { m0 = fmaxf(m0, __shfl_xor(m0, o)); m1 = fmaxf(m1, __shfl_xor(m1, o)); m2 = fmaxf(m2, __shfl_xor(m2, o)); m3 = fmaxf(m3, __shfl_xor(m3, o)); }
    if (lane < 8) { unsigned* cm = (unsigned*)(cmax + c4);
        (void)__hip_atomic_fetch_max(cm + 0, __builtin_bit_cast(unsigned, m0), RLX_AGENT); (void)__hip_atomic_fetch_max(cm + 1, __builtin_bit_cast(unsigned, m1), RLX_AGENT);
        (void)__hip_atomic_fetch_max(cm + 2, __builtin_bit_cast(unsigned, m2), RLX_AGENT); (void)__hip_atomic_fetch_max(cm + 3, __builtin_bit_cast(unsigned, m3), RLX_AGENT); }
}
__device__ __forceinline__ void p0_transpose_item_i8(const float* W, int ldw, int csrc0, int k0, gu32* cmax, float* sbout, unsigned char* WT, int Kd, int drow0, LAS float* scr, int lane) {
    { f32x4 v[8]; const int r8 = lane >> 3, c4 = (lane & 7) * 4;
#pragma unroll
      for (int i = 0; i < 8; ++i) v[i] = *(const GAS f32x4*)(W + (size_t)(k0 + 8 * i + r8) * ldw + csrc0 + c4);
      f32x4 sc;
#pragma unroll
      for (int c = 0; c < 4; ++c) { const float mx = __builtin_bit_cast(float, __hip_atomic_load((unsigned*)(cmax + c4 + c), RLX_AGENT)); sc[c] = mx > 0.f ? 127.0f / mx : 0.f; if (k0 == 0 && r8 == 0) sbout[c4 + c] = mx * (1.0f / 127.0f); }
#pragma unroll
      for (int i = 0; i < 8; ++i) { const int kk = 8 * i + r8; scr[kk * 33 + c4] = v[i][0] * sc[0]; scr[kk * 33 + c4 + 1] = v[i][1] * sc[1]; scr[kk * 33 + c4 + 2] = v[i][2] * sc[2]; scr[kk * 33 + c4 + 3] = v[i][3] * sc[3]; } }
    LDS_WAIT(); asm volatile("" ::: "memory");
    const int c = lane & 7;
#pragma unroll
    for (int j = 0; j < 4; ++j) { const int n = (lane >> 3) + 8 * j; const LAS float* s = scr + (8 * c) * 33 + n;
        *(GAS u32x2*)(WT + (size_t)(drow0 + n) * Kd + k0 + 8 * c) = (u32x2){pk4_i8(s[0 * 33], s[1 * 33], s[2 * 33], s[3 * 33]), pk4_i8(s[4 * 33], s[5 * 33], s[6 * 33], s[7 * 33])}; }
    LDS_WAIT(); asm volatile("" ::: "memory");
}
__device__ __forceinline__ void p0_prologue(Frame& F, const Args& A) {
    LAS float* scr = (LAS float*)(F.lds + RING_OFF + F.wave * 16384);
    const int gw = F.c * NWAVES + F.wave, NGW = F.G * NWAVES, lane = opaque(F.tid) & 63;
    unsigned char* ws = F.ws;
    constexpr int I_IN = 16 * (NP / 32), I_SQ = 16 * 32, I_KV = 16 * 64, I_EXP = 16 * 32;
    constexpr int NITEMS = 2 * I_SQ + 3 * NE * I_EXP;
    gu32* cmax = F.ctl + CW_CMAX;
    for (int it = gw; it < I_IN + I_KV; it += NGW) {
        if (it < I_IN) { const int kb = it / (NP / 32), nb = it % (NP / 32), n0 = nb * 32; p0_colmax_item(A.in[3], INW, n0 + (n0 >= 1536 ? 8 : 0), kb * 64, cmax + n0, lane); }
        else { const int r = it - I_IN; p0_colmax_item(A.in[14], 2 * D, (r % 64) * 32, (r / 64) * 64, cmax + NP + (r % 64) * 32, lane); }
    }
    __builtin_amdgcn_fence(__ATOMIC_RELEASE, "agent");
    __syncthreads();
    if (F.tid == 0) (void)__hip_atomic_fetch_add((unsigned*)(F.ctl + CW_P0CNT), 1u, RLX_AGENT);
#pragma unroll 1
    for (int rep0 = 0; rep0 < P0_REP; ++rep0)
    for (int it = gw; it < NITEMS; it += NGW) {
        int r = it;
        if (r < I_SQ) { p0_transpose_item(A.in[10], D, (r % 32) * 32, (r / 32) * 64, nullptr, (bf16*)(ws + WS_WOUT), D, (r % 32) * 32, scr, lane); continue; } r -= I_SQ;
        if (r < I_SQ) { p0_transpose_item(A.in[15], D, (r % 32) * 32, (r / 32) * 64, nullptr, (bf16*)(ws + WS_WXO), D, (r % 32) * 32, scr, lane); continue; } r -= I_SQ;
        const int which = r / (NE * I_EXP); r -= which * (NE * I_EXP);
        const int e = r / I_EXP, q = r % I_EXP, kb = q / 32, nb = q % 32, n0 = nb * 32;
        if (which == 2) p0_transpose_item_f8(A.in[23] + (size_t)e * FF * D, D, n0, kb * 64, nullptr, 64.0f, ws + WS_WD, FF, e * D + n0, scr, lane);
        else { const int p = n0 >> 7, drow = e * 2048 + p * 256 + 2 * (n0 & 127) + 8 * which;
               p0_transpose_item_f8(A.in[which == 0 ? 19 : 21] + (size_t)e * D * FF, FF, n0, kb * 64, A.in[16], 64.0f, ws + WS_WGU, D, drow, scr, lane, true); }
    }
    { const float* wq = A.in[13]; const float* gx = A.in[11]; bf16* o = (bf16*)(ws + WS_WQ);
      for (int i = (F.c * NTHREADS + F.tid); i < D * D / 8; i += F.G * NTHREADS) { const f32x4 a = *(const GAS f32x4*)(wq + 8 * (size_t)i), b2 = *(const GAS f32x4*)(wq + 8 * (size_t)i + 4); const float g = gx[i >> 7] * (1.0f / 16.0f);
          *(GAS u32x4*)(o + 8 * (size_t)i) = (u32x4){pk2(a[0] * g, a[1] * g), pk2(a[2] * g, a[3] * g), pk2(b2[0] * g, b2[1] * g), pk2(b2[2] * g, b2[3] * g)}; } }
    { const float* wr = A.in[17]; const float* gm = A.in[16]; unsigned char* o = ws + WS_WR;
      for (int i = (F.c * NTHREADS + F.tid); i < 64 * 128; i += F.G * NTHREADS) { const int rho = i >> 7, ch = i & 127, e = rho & 31; unsigned pk[4];
#pragma unroll
          for (int j = 0; j < 4; ++j) { float v0 = wr[(size_t)(8 * ch + 2 * j) * NE + e] * gm[8 * ch + 2 * j], v1 = wr[(size_t)(8 * ch + 2 * j + 1) * NE + e] * gm[8 * ch + 2 * j + 1];
              const unsigned h0 = f2bf(v0), h1 = f2bf(v1); if (rho >= 32) { v0 -= bf2f(h0); v1 -= bf2f(h1); pk[j] = pk2(v0, v1); } else pk[j] = h0 | (h1 << 16); }
          *(GAS u32x4*)(o + rho * 2048 + ((ch ^ (rho & 15)) << 4)) = (u32x4){pk[0], pk[1], pk[2], pk[3]}; } }
    if (F.tid == 0) { unsigned sp = 0; while (__hip_atomic_load((unsigned*)(F.ctl + CW_P0CNT), RLX_AGENT) < (unsigned)F.G) { __builtin_amdgcn_s_sleep(2); if (++sp > (1u << 22)) break; } }
    __syncthreads();
    for (int it = gw; it < I_IN + I_KV; it += NGW) {
        if (it < I_IN) { const int kb = it / (NP / 32), nb = it % (NP / 32), n0 = nb * 32; p0_transpose_item_i8(A.in[3], INW, n0 + (n0 >= 1536 ? 8 : 0), kb * 64, cmax + n0, (float*)(ws + WS_SB) + n0, ws + WS_WIN, D, n0, scr, lane); }
        else { const int r = it - I_IN, n0 = (r % 64) * 32; p0_transpose_item_i8(A.in[14], 2 * D, n0, (r / 64) * 64, cmax + NP + n0, (float*)(ws + WS_SBKV) + n0, ws + WS_WKV, D, n0, scr, lane); }
    }
    __syncthreads();
    LAS float* wgs = (LAS float*)(F.lds + RING_OFF);
    for (int i = F.tid; i < 8 * D; i += NTHREADS) { const int k = i >> 3, j = i & 7; wgs[j * D + k] = A.in[3][(size_t)k * INW + 1536 + j]; }
    __syncthreads();
    {
        const float* x = A.in[0]; const float* gmix = A.in[2]; const float* bg = A.in[4];
        unsigned char* xn = ws + WS_R1; float* rsc = (float*)(ws + WS_SA); float* gates = (float*)(ws + WS_GATES);
        f32x4 g[4];
#pragma unroll
        for (int j = 0; j < 4; ++j) g[j] = *(const f32x4*)(gmix + 4 * lane + 256 * j);
#pragma unroll 1
        for (int repx = 0; repx < P0X_REP; ++repx)
        for (int m0 = gw; m0 < T; m0 += 2 * NGW) {
            f32x4 vv[2][4];
#pragma unroll
            for (int rr = 0; rr < 2; ++rr) { const int m = m0 + rr * NGW; const GAS f32x4* xr = (const GAS f32x4*)(x + (size_t)(m < T ? m : m0) * D) + lane;
#pragma unroll
                for (int j = 0; j < 4; ++j) vv[rr][j] = xr[64 * j]; }
#pragma unroll
            for (int rr = 0; rr < 2; ++rr) { const int mraw = m0 + rr * NGW; const bool mvalid = mraw < T; const int m = mvalid ? mraw : m0;
                f32x4 v[4]; float s = 0.f;
#pragma unroll
                for (int j = 0; j < 4; ++j) { v[j] = vv[rr][j]; s += (v[j].x * v[j].x + v[j].y * v[j].y) + (v[j].z * v[j].z + v[j].w * v[j].w); }
                const float r = rsqrtf(wave_sum(s) * (1.f / D) + EPS);
#pragma unroll
                for (int j = 0; j < 4; ++j) v[j] = v[j] * r * g[j];
                { float mx = 0.f;
#pragma unroll
                  for (int j = 0; j < 4; ++j) mx = fmaxf(fmaxf(mx, fmaxf(fabsf(v[j].x), fabsf(v[j].y))), fmaxf(fabsf(v[j].z), fabsf(v[j].w)));
                  mx = wave_max(mx); const float qs = mx > 0.f ? 127.0f / mx : 0.f;
                  GAS unsigned* o4 = (GAS unsigned*)(xn + (size_t)m * D) + lane;
                  if (mvalid) {
#pragma unroll
                  for (int j = 0; j < 4; ++j) o4[64 * j] = pk4_i8s(v[j].x, v[j].y, v[j].z, v[j].w, qs);
                  if (lane == 0) rsc[m] = mx * (1.0f / 127.0f); } }
                float gs[8];
#pragma unroll
                for (int jg = 0; jg < 8; ++jg) { float a = 0.f;
#pragma unroll
                    for (int j = 0; j < 4; ++j) { const f32x4 w = *(const LAS f32x4*)(wgs + jg * D + 4 * lane + 256 * j); a += (v[j].x * w.x + v[j].y * w.y) + (v[j].z * w.z + v[j].w * w.w); }
                    gs[jg] = a; }
                float g4[4], g2[2], g1;
                { const bool hi = (lane & 32) != 0;
#pragma unroll
                  for (int q = 0; q < 4; ++q) { const float keep = hi ? gs[4 + q] : gs[q], send = hi ? gs[q] : gs[4 + q]; g4[q] = keep + __shfl_xor(send, 32); } }
                { const bool hi = (lane & 16) != 0;
#pragma unroll
                  for (int q = 0; q < 2; ++q) { const float keep = hi ? g4[2 + q] : g4[q], send = hi ? g4[q] : g4[2 + q]; g2[q] = keep + __shfl_xor(send, 16); } }
                { const bool hi = (lane & 8) != 0; const float keep = hi ? g2[1] : g2[0], send = hi ? g2[0] : g2[1]; g1 = keep + __shfl_xor(send, 8); }
                g1 = sum8(g1);
                if ((lane & 7) == 0 && mvalid) { const int jg = lane >> 3; const float pre = g1 + bg[jg];
                    const float sc = 15.0f * tanhf(pre * (1.0f / 15.0f));
                    float o = sc;
                    if (jg >= 4) o = -log1pf(expf(-sc));
                    gates[(size_t)m * 8 + jg] = o; }
            }
        }
    }
    {
        const float* x = A.in[1]; const float* gmem = A.in[12]; unsigned char* mn = ws + WS_R3;
        f32x4 g[4];
#pragma unroll
        for (int j = 0; j < 4; ++j) g[j] = *(const f32x4*)(gmem + 4 * lane + 256 * j);
        for (int m = gw; m < TM; m += NGW) {
            const GAS f32x4* xr = (const GAS f32x4*)(x + (size_t)m * D) + lane;
            f32x4 v[4]; float s = 0.f;
#pragma unroll
            for (int j = 0; j < 4; ++j) { v[j] = xr[64 * j]; s += (v[j].x * v[j].x + v[j].y * v[j].y) + (v[j].z * v[j].z + v[j].w * v[j].w); }
            const float r = rsqrtf(wave_sum(s) * (1.f / D) + EPS);
#pragma unroll
            for (int j = 0; j < 4; ++j) v[j] = v[j] * r * g[j];
            float mx = 0.f;
#pragma unroll
            for (int j = 0; j < 4; ++j) mx = fmaxf(fmaxf(mx, fmaxf(fabsf(v[j].x), fabsf(v[j].y))), fmaxf(fabsf(v[j].z), fabsf(v[j].w)));
            mx = wave_max(mx); const float qs = mx > 0.f ? 127.0f / mx : 0.f;
            GAS unsigned* o4 = (GAS unsigned*)(mn + (size_t)m * D) + lane;
#pragma unroll
            for (int j = 0; j < 4; ++j) o4[64 * j] = pk4_i8s(v[j].x, v[j].y, v[j].z, v[j].w, qs);
            if (lane == 0) ((float*)(ws + WS_SAM))[m] = mx * (1.0f / 127.0f);
        }
    }
}

constexpr size_t TS1K = (size_t)256 * 1024 * 2;
constexpr size_t TSF8 = (size_t)256 * 1024;
#ifndef P1_WGM
#define P1_WGM 8
#endif
struct P1Order {
    static constexpr bool GATHER = false;
    int G, c; const char* ws;
    __device__ __forceinline__ bool next(int i, pg8::Unit& u) const {
        const int L = i * G + c; if (L >= 2816) return false;
        int pm, pn, aux;
        if (L < 2560) { pg8::tile_remap<10, P1_WGM>(L, 256, pm, pn); pm = 255 - pm; aux = 0; }
        else { const int Lp = L - 2560; aux = 1; pm = Lp >> 3; pn = Lp & 7; }
        u.pm = pm; u.pn = pn; u.aux = aux; u.skip = 0;
        return true;
    }
    __device__ __forceinline__ const char* Abase(const pg8::Unit& u) const { size_t o = WS_R1; if (u.aux == 1) o = WS_R3; return ws + o + (size_t)u.pm * TSF8; }
    __device__ __forceinline__ const char* Bbase(const pg8::Unit& u) const { size_t o = WS_WIN; if (u.aux == 1) o = WS_WKV; return ws + o + (size_t)u.pn * TSF8; }
    __device__ __forceinline__ void a_offsets(const pg8::Unit&, const int (&R)[2], const int (&C)[2], int RP, unsigned (&v)[4]) const {
#pragma unroll
        for (int h = 0; h < 2; ++h)
#pragma unroll
            for (int i = 0; i < 2; ++i) v[h * 2 + i] = (unsigned)((h * 128 + R[i]) * RP + C[i] * 2); }
};
struct PlainOrder {
    static constexpr bool GATHER = false;
    int G, c, nM, nN; const char *A, *Bt; int bsel; unsigned ts; int rev;
    __device__ __forceinline__ bool next(int i, pg8::Unit& u) const { const int L = i * G + c; if (L >= nM * 4) return false; int pm, pn; pg8::tile_remap<4>(L, nM, pm, pn); if (rev) pm = nM - 1 - pm; u.pm = pm; u.pn = pn; u.aux = 0; u.skip = 0; return true; }
    __device__ __forceinline__ const char* Abase(const pg8::Unit& u) const { return A + (size_t)u.pm * ts; }
    __device__ __forceinline__ const char* Bbase(const pg8::Unit& u) const { return Bt + (size_t)((u.pm >> 3) * bsel * 4 + u.pn) * ts; }
    __device__ __forceinline__ void a_offsets(const pg8::Unit&, const int (&R)[2], const int (&C)[2], int RP, unsigned (&v)[4]) const {
#pragma unroll
        for (int h = 0; h < 2; ++h)
#pragma unroll
            for (int i = 0; i < 2; ++i) v[h * 2 + i] = (unsigned)((h * 128 + R[i]) * RP + C[i] * 2); }
};
template <int WHICH> struct PreOrder {
    static constexpr bool GATHER = false;
    int first, stride, nmine; const char* ws;
    __device__ __forceinline__ bool next(int i, pg8::Unit& u) const { const int L = first + i * stride; if (i >= nmine || L >= 512) return false; u.pm = L & 3; u.pn = (L >> 2) & 3; u.aux = L >> 4; u.skip = 0; return true; }
    __device__ __forceinline__ const char* Abase(const pg8::Unit& u) const { return WHICH == 0 ? ws + WS_KM + (size_t)u.aux * 256 * 4096 + u.pn * 512 : ws + WS_WXO + (size_t)u.pm * 256 * 2048 + u.pn * 512; }
    __device__ __forceinline__ const char* Bbase(const pg8::Unit& u) const { return WHICH == 0 ? ws + WS_WQ + (size_t)u.pm * 256 * 2048 + u.pn * 512 : ws + WS_KM + (size_t)u.aux * 256 * 4096 + 2048 + u.pn * 512; }
    __device__ __forceinline__ void a_offsets(const pg8::Unit&, const int (&R)[2], const int (&C)[2], int RP, unsigned (&v)[4]) const {
#pragma unroll
        for (int h = 0; h < 2; ++h)
#pragma unroll
            for (int i = 0; i < 2; ++i) v[h * 2 + i] = (unsigned)((h * 128 + R[i]) * RP + C[i] * 2); }
};
template <bool GATH, int NN>
struct MoeOrder {
    static constexpr bool GATHER = GATH;
    int G, c, NT; const LAS int* tpre; const char* ws;
    __device__ __forceinline__ bool next(int i, pg8::Unit& u) const {
        const int L = i * G + c; if (L >= NT * NN) return false; pg8::tile_remap<NN>(L, NT, u.pm, u.pn);
        if (!GATH) u.pm = NT - 1 - u.pm;
        u.aux = __builtin_amdgcn_readfirstlane((int)((const LAS unsigned char*)tpre + 11264)[u.pm]); u.skip = 0; return true; }
    __device__ __forceinline__ const char* Abase(const pg8::Unit& u) const { if (GATH) return ws + WS_XQ; return ws + WS_H2 + (size_t)u.pm * TSF8; }
    __device__ __forceinline__ const char* Bbase(const pg8::Unit& u) const { return ws + (GATH ? WS_WGU : WS_WD) + (size_t)(u.aux * NN + u.pn) * TSF8; }
    __device__ __forceinline__ void a_offsets(const pg8::Unit& u, const int (&R)[2], const int (&C)[2], int RP, unsigned (&v)[4]) const {
        if (GATH) { const int base = (u.pm - tpre[u.aux]) * 256, cnt = tpre[40 + u.aux]; const int* lpid = (const int*)(ws + WS_LPID);
#pragma unroll
            for (int h = 0; h < 2; ++h)
#pragma unroll
                for (int i = 0; i < 2; ++i) { const int pos = base + h * 128 + R[i]; const int pid = lpid[u.aux * LISTCAP + (pos < cnt ? pos : 0)]; v[h * 2 + i] = (unsigned)((pid >> 2) * RP + C[i] * 2); }
        } else {
#pragma unroll
            for (int h = 0; h < 2; ++h)
#pragma unroll
                for (int i = 0; i < 2; ++i) v[h * 2 + i] = (unsigned)((h * 128 + R[i]) * RP + C[i] * 2); } }
};

#ifndef STAGGER_TICKS
#define STAGGER_TICKS 0
#endif
#ifndef EPI_TWICE_P1
#define EPI_TWICE_P1 false
#endif
#ifndef P7_REP
#define P7_REP 1
#endif
#ifndef P2_PROBE
#define P2_PROBE 0
#endif
#ifndef KTWICE_MASK
#define KTWICE_MASK 0
#endif
template <class Base, bool TW> struct Twice : Base {
    __device__ __forceinline__ bool next(int i, pg8::Unit& u) const { if (!TW) { const bool r = Base::next(i, u); u.skip = 0; return r; } const bool r = Base::next(i >> 1, u); u.skip = !(i & 1); return r; }
};
struct EpiP1 {
    static constexpr int NST = 16; static constexpr int RELAX = RELAX_P1; static constexpr bool TWICE = EPI_TWICE_P1; static constexpr bool BIAS_DMA = true; static constexpr int BIAS_STRIDE = 2048;
    static constexpr bool PERM = true;
    unsigned char* ws; LAS unsigned char* btab;
    __device__ __forceinline__ void bias_dma(const pg8::Unit& u, LAS unsigned char* tab, int wid, int lane) const {
        size_t so = WS_SA, co = WS_SB; if (u.aux == 1) { so = WS_SAM; co = WS_SBKV; }
        const float* src = (const float*)(ws + co) + u.pn * 256 + wid * 64; if (wid >= 4) src = (const float*)(ws + so) + u.pm * 256 + (wid - 4) * 64;
        const float* srcu = (const float*)((((unsigned long long)(unsigned)__builtin_amdgcn_readfirstlane((int)((unsigned long long)src >> 32))) << 32) | (unsigned long long)(unsigned)__builtin_amdgcn_readfirstlane((int)(unsigned)(unsigned long long)src));
        const unsigned la = (unsigned)__builtin_amdgcn_readfirstlane((int)(unsigned)(size_t)tab) + (unsigned)wid * 256u; const unsigned vo = (unsigned)lane * 4u;
        asm volatile("s_mov_b32 m0, %2\n\ts_nop 0\n\tglobal_load_lds_dword %0, %1" :: "v"(vo), "s"(srcu), "s"(la) : "memory", "m0"); }
    __device__ __forceinline__ void operator()(const f32x4 (&acc)[2][2][4][2], const pg8::Unit& u, int wr, int wc, int fr, int fq) const {
        const int row0 = u.pm * 256 + wr * 64 + fr, col0 = u.pn * 256 + wc * 64 + 16 * fq;
        size_t bo = WS_PROJ; int ld = NP; if (u.aux == 1) { bo = WS_KM; ld = 2 * D; }
        bf16* base = (bf16*)(ws + bo);
        const bool act = (u.aux == 0 && u.pn >= 6);
        f32x4 cb[2][2]; float ra[2][4];
        { const LAS float* sb = (const LAS float*)(btab + u.par * 2048) + wc * 64 + 16 * fq; const LAS float* sa = (const LAS float*)(btab + u.par * 2048 + 1024) + wr * 64 + fr;
#pragma unroll
          for (int bj = 0; bj < 2; ++bj) { cb[bj][0] = *(const LAS f32x4*)(sb + bj * 8); cb[bj][1] = *(const LAS f32x4*)(sb + bj * 8 + 4); }
#pragma unroll
          for (int ai = 0; ai < 2; ++ai)
#pragma unroll
              for (int m = 0; m < 4; ++m) ra[ai][m] = sa[ai * 128 + m * 16]; }
#if NOISE_PROBE
        float nss = 0.f;
#pragma unroll
        for (int ai = 0; ai < 2; ++ai)
#pragma unroll
            for (int bj = 0; bj < 2; ++bj)
#pragma unroll
                for (int m = 0; m < 4; ++m)
#pragma unroll
                    for (int n = 0; n < 2; ++n) { const f32x4 a = acc[ai][bj][m][n]; nss += (a[0] * a[0] + a[1] * a[1]) + (a[2] * a[2] + a[3] * a[3]); }
        const float nsc = sqrtf(nss * (1.0f / 128.0f)) * (NOISE_PROBE * 0.0001f * 3.4641016f) * (1.0f / 16777216.0f);
#endif
#pragma unroll
        for (int ai = 0; ai < 2; ++ai)
#pragma unroll
            for (int m = 0; m < 4; ++m) { bf16* rowp = base + (size_t)(row0 + ai * 128 + m * 16) * ld + col0;
#pragma unroll
                for (int bj = 0; bj < 2; ++bj) { f32x4 v0 = __builtin_convertvector(__builtin_bit_cast(pg8::i32x4, acc[ai][bj][m][0]), f32x4) * (cb[bj][0] * ra[ai][m]), v1 = __builtin_convertvector(__builtin_bit_cast(pg8::i32x4, acc[ai][bj][m][1]), f32x4) * (cb[bj][1] * ra[ai][m]);
#if NOISE_PROBE
                    { const unsigned idx0 = (unsigned)((row0 + ai * 128 + m * 16) * 4096 + col0 + bj * 8) + (u.aux ? 0x40000000u : 0u);
#pragma unroll
                      for (int j = 0; j < 8; ++j) { unsigned h = (idx0 + j) * 0x9E3779B1u; h ^= h >> 15; h *= 0x85EBCA77u; h ^= h >> 13; h *= 0xC2B2AE3Du; h ^= h >> 16;
                          const float un = (float)(int)(h >> 8) - 8388608.0f; if (j < 4) v0[j] += nsc * un; else v1[j - 4] += nsc * un; } }
#endif
                    if (act) { const f32x2 a = gelu_tanh2((f32x2){v0[0], v0[1]}), b2 = gelu_tanh2((f32x2){v0[2], v0[3]}), c2 = gelu_tanh2((f32x2){v1[0], v1[1]}), d2 = gelu_tanh2((f32x2){v1[2], v1[3]});
                        v0 = (f32x4){a.x, a.y, b2.x, b2.y}; v1 = (f32x4){c2.x, c2.y, d2.x, d2.y}; }
                    u32x4 w; w.x = cvt_pk_bf16(v0[0], v0[1]); w.y = cvt_pk_bf16(v0[2], v0[3]); w.z = cvt_pk_bf16(v1[0], v1[1]); w.w = cvt_pk_bf16(v1[2], v1[3]);
                    *(u32x4*)(rowp + bj * 8) = w; } }
    }
};
template <bool BASE_F32> struct EpiResid {
    static constexpr bool PERM = true; static constexpr int NST = 24; static constexpr int RELAX = 0; static constexpr bool TWICE = false; static constexpr bool BIAS_DMA = false;
    const void* base; bf16* out; float* ssq; unsigned char* q8;
    __device__ __forceinline__ void operator()(const f32x4 (&acc)[2][2][4][2], const pg8::Unit& u, int wr, int wc, int fr, int fq) const {
        const int row0 = u.pm * 256 + wr * 64 + fr, col0 = u.pn * 256 + wc * 64 + 16 * fq;
#pragma unroll
        for (int ai = 0; ai < 2; ++ai) {
            f32x4 b0[4][2], b1[4][2];
#pragma unroll
            for (int m = 0; m < 4; ++m)
#pragma unroll
                for (int bj = 0; bj < 2; ++bj) { const size_t off = (size_t)(row0 + ai * 128 + m * 16) * D + col0 + bj * 8;
                    if (BASE_F32) { b0[m][bj] = *(const f32x4*)((const float*)base + off); b1[m][bj] = *(const f32x4*)((const float*)base + off + 4); }
                    else { const u32x4 w = *(const u32x4*)((const bf16*)base + off); b0[m][bj] = (f32x4){bflo(w.x), bfhi(w.x), bflo(w.y), bfhi(w.y)}; b1[m][bj] = (f32x4){bflo(w.z), bfhi(w.z), bflo(w.w), bfhi(w.w)}; } }
            asm volatile("" ::: "memory");
#pragma unroll
            for (int m = 0; m < 4; ++m) { const int row = row0 + ai * 128 + m * 16; float ss = 0.f;
                u32x4 q;
#pragma unroll
                for (int bj = 0; bj < 2; ++bj) { const size_t off = (size_t)row * D + col0 + bj * 8;
                    const float asc = BASE_F32 ? 1.0f : (1.0f / 256.0f);
                    const f32x4 v0 = acc[ai][bj][m][0] * asc + b0[m][bj], v1 = acc[ai][bj][m][1] * asc + b1[m][bj];
                    ss += (v0[0] * v0[0] + v0[1] * v0[1]) + (v0[2] * v0[2] + v0[3] * v0[3]) + (v1[0] * v1[0] + v1[1] * v1[1]) + (v1[2] * v1[2] + v1[3] * v1[3]);
                    u32x4 w; w.x = cvt_pk_bf16(v0[0], v0[1]); w.y = cvt_pk_bf16(v0[2], v0[3]); w.z = cvt_pk_bf16(v1[0], v1[1]); w.w = cvt_pk_bf16(v1[2], v1[3]);
                    *(u32x4*)(out + off) = w;
                    if (BASE_F32) { const unsigned qa = pk4_fp8(v0[0], v0[1], v0[2], v0[3]), qb = pk4_fp8(v1[0], v1[1], v1[2], v1[3]); if (bj == 0) { q.x = qa; q.y = qb; } else { q.z = qa; q.w = qb; } } }
                if (BASE_F32) *(u32x4*)(q8 + (size_t)row * D + col0) = q;
                ss += __shfl_xor(ss, 16); ss += __shfl_xor(ss, 32);
                if (fq == 0) ssq[(size_t)row * 16 + u.pn * 4 + wc] = ss; }
        }
    }
};
__device__ __forceinline__ float row_rms_from_ssq(const float* ssq, int row) {
    const f32x4* p = (const f32x4*)(ssq + (size_t)row * 16); const f32x4 a = p[0], b = p[1], c = p[2], d = p[3];
    const float s = (((a[0] + a[1]) + (a[2] + a[3])) + ((b[0] + b[1]) + (b[2] + b[3]))) + (((c[0] + c[1]) + (c[2] + c[3])) + ((d[0] + d[1]) + (d[2] + d[3])));
    return rsqrtf(s * (1.0f / D) + EPS);
}
template <int WHICH> struct EpiPre {
    static constexpr bool PERM = true; static constexpr int NST = 16; static constexpr int RELAX = 0; static constexpr bool TWICE = false; static constexpr bool BIAS_DMA = false;
    unsigned char* out;
    __device__ __forceinline__ void operator()(const f32x4 (&acc)[2][2][4][2], const pg8::Unit& u, int wr, int wc, int fr, int fq) const {
        const int rt = WHICH == 0 ? u.pn : u.pm, ct = WHICH == 0 ? u.pm : u.pn; const float sc = WHICH == 0 ? 64.0f : 1.0f;
        unsigned char* base = out + ((size_t)u.aux * 1024 + rt * 256 + wr * 64 + fr) * 1024 + ct * 256 + wc * 64 + 16 * fq;
#pragma unroll
        for (int ai = 0; ai < 2; ++ai)
#pragma unroll
            for (int m = 0; m < 4; ++m)
            { const f32x4 v0 = acc[ai][0][m][0] * sc, v1 = acc[ai][0][m][1] * sc, v2 = acc[ai][1][m][0] * sc, v3 = acc[ai][1][m][1] * sc;
                    *(u32x4*)(base + (size_t)(ai * 128 + m * 16) * 1024) = (u32x4){pk4_fp8(v0[0], v0[1], v0[2], v0[3]), pk4_fp8(v1[0], v1[1], v1[2], v1[3]), pk4_fp8(v2[0], v2[1], v2[2], v2[3]), pk4_fp8(v3[0], v3[1], v3[2], v3[3])}; }
    }
};
struct EpiSoftmax {
    static constexpr bool PERM = true; static constexpr int NST = 16; static constexpr int RELAX = 0; static constexpr bool TWICE = false; static constexpr bool BIAS_DMA = false;
    unsigned char* out; const float* ssq; LAS float* xch;
    __device__ __forceinline__ void operator()(f32x4 (&acc)[2][2][4][2], const pg8::Unit& u, int wr, int wc, int fr, int fq) const {
        const int row0 = u.pm * 256 + wr * 64 + fr, col0 = u.pn * 256 + wc * 64 + 16 * fq;
#pragma unroll
        for (int ai = 0; ai < 2; ++ai)
#pragma unroll
            for (int m = 0; m < 4; ++m) { if (m & 1) asm volatile("" ::: "memory");
                const float r = row_rms_from_ssq(ssq, row0 + ai * 128 + m * 16) * (1.4426950408889634f / 64.0f);
                float mm = -3.0e38f;
#pragma unroll
                for (int bj = 0; bj < 2; ++bj)
#pragma unroll
                    for (int n = 0; n < 2; ++n) { acc[ai][bj][m][n] = acc[ai][bj][m][n] * r; const f32x4 v = acc[ai][bj][m][n]; mm = fmaxf(fmaxf(fmaxf(mm, v[0]), fmaxf(v[1], v[2])), v[3]); }
                mm = fmaxf(mm, __shfl_xor(mm, 16)); mm = fmaxf(mm, __shfl_xor(mm, 32));
                if (fq == 0) xch[(ai * 128 + wr * 64 + m * 16 + fr) * 4 + wc] = mm; }
        asm volatile("s_waitcnt lgkmcnt(0)" ::: "memory"); __builtin_amdgcn_s_barrier(); asm volatile("" ::: "memory");
#pragma unroll
        for (int ai = 0; ai < 2; ++ai)
#pragma unroll
            for (int m = 0; m < 4; ++m) { const int rl = ai * 128 + wr * 64 + m * 16 + fr; const f32x4 q = *(const LAS f32x4*)(xch + rl * 4); const float M = fmaxf(fmaxf(q[0], q[1]), fmaxf(q[2], q[3]));
                float sm = 0.f;
#pragma unroll
                for (int bj = 0; bj < 2; ++bj)
#pragma unroll
                    for (int n = 0; n < 2; ++n) { f32x4 v = acc[ai][bj][m][n];
#pragma unroll
                        for (int j = 0; j < 4; ++j) { v[j] = __builtin_amdgcn_exp2f(v[j] - M); sm += v[j]; }
                        acc[ai][bj][m][n] = v; }
                sm += __shfl_xor(sm, 16); sm += __shfl_xor(sm, 32);
                if (fq == 0) xch[1024 + rl * 4 + wc] = sm; }
        asm volatile("s_waitcnt lgkmcnt(0)" ::: "memory"); __builtin_amdgcn_s_barrier(); asm volatile("" ::: "memory");
#pragma unroll
        for (int ai = 0; ai < 2; ++ai)
#pragma unroll
            for (int m = 0; m < 4; ++m) { const int rl = ai * 128 + wr * 64 + m * 16 + fr; const f32x4 q = *(const LAS f32x4*)(xch + 1024 + rl * 4); const float inv = 256.0f / ((q[0] + q[1]) + (q[2] + q[3]));
                { const f32x4 v0 = acc[ai][0][m][0] * inv, v1 = acc[ai][0][m][1] * inv, v2 = acc[ai][1][m][0] * inv, v3 = acc[ai][1][m][1] * inv;
                    *(u32x4*)(out + (size_t)(row0 + ai * 128 + m * 16) * D + col0) = (u32x4){pk4_fp8(v0[0], v0[1], v0[2], v0[3]), pk4_fp8(v1[0], v1[1], v1[2], v1[3]), pk4_fp8(v2[0], v2[1], v2[2], v2[3]), pk4_fp8(v3[0], v3[1], v3[2], v3[3])}; } }
    }
};
struct EpiG1 {
    static constexpr bool PERM = true; static constexpr int NST = 8; static constexpr int RELAX = 0; static constexpr bool TWICE = false; static constexpr bool BIAS_DMA = false;
    unsigned char* ws; const float* bgate; const float* bup;
    static __device__ __forceinline__ f32x2 act2(f32x2 g, f32x2 u) {
        g.x = __builtin_amdgcn_fmed3f(g.x, -24.0f, 7.0f); g.y = __builtin_amdgcn_fmed3f(g.y, -24.0f, 7.0f);
        u.x = __builtin_amdgcn_fmed3f(u.x, -7.0f, 7.0f); u.y = __builtin_amdgcn_fmed3f(u.y, -7.0f, 7.0f);
        f32x2 z = g * (-1.702f * 1.4426950408889634f);
        f32x2 d; d.x = __builtin_amdgcn_exp2f(z.x); d.y = __builtin_amdgcn_exp2f(z.y);
        d = d + 1.0f;
        const float r = __builtin_amdgcn_rcpf(d.x * d.y);
        f32x2 sg; sg.x = r * d.y; sg.y = r * d.x;
        return (u + 1.0f) * (g * sg);
    }
    __device__ __forceinline__ void operator()(const f32x4 (&acc)[2][2][4][2], const pg8::Unit& u, int wr, int wc, int fr, int fq) const {
        const int e = u.aux;
        unsigned char* Ht = ws + WS_H2 + (size_t)u.pm * TSF8;
        const int hc = u.pn * 128 + wc * 32 + 8 * fq;
        const f32x4 bg0 = *(const f32x4*)(bgate + e * FF + hc), bg1 = *(const f32x4*)(bgate + e * FF + hc + 4);
        const f32x4 bu0 = *(const f32x4*)(bup + e * FF + hc), bu1 = *(const f32x4*)(bup + e * FF + hc + 4);
#pragma unroll
        for (int ai = 0; ai < 2; ++ai)
#pragma unroll
            for (int m = 0; m < 4; ++m) { const int rl = ai * 128 + wr * 64 + m * 16 + fr;
                const f32x4 g0 = acc[ai][0][m][0] * (1.0f / 64.0f) + bg0, g1 = acc[ai][0][m][1] * (1.0f / 64.0f) + bg1, u0 = acc[ai][1][m][0] * (1.0f / 64.0f) + bu0, u1 = acc[ai][1][m][1] * (1.0f / 64.0f) + bu1;
                const f32x2 h0 = act2((f32x2){g0[0], g0[1]}, (f32x2){u0[0], u0[1]}), h1 = act2((f32x2){g0[2], g0[3]}, (f32x2){u0[2], u0[3]});
                const f32x2 h2 = act2((f32x2){g1[0], g1[1]}, (f32x2){u1[0], u1[1]}), h3 = act2((f32x2){g1[2], g1[3]}, (f32x2){u1[2], u1[3]});
                *(u32x2*)(Ht + (size_t)rl * FF + hc) = (u32x2){pk4_fp8(h0.x, h0.y, h1.x, h1.y), pk4_fp8(h2.x, h2.y, h3.x, h3.y)}; }
    }
};
struct EpiG2 {
    static constexpr bool PERM = true; static constexpr int NST = 16; static constexpr int RELAX = 0; static constexpr bool TWICE = false; static constexpr bool BIAS_DMA = true; static constexpr int BIAS_STRIDE = 1024;
    unsigned char* ws; const float* bdown; LAS unsigned char* btab;
    __device__ __forceinline__ void bias_dma(const pg8::Unit& u, LAS unsigned char* tab, int wid, int lane) const {
        if (wid < 4) { const float* src = bdown + u.aux * D + u.pn * 256 + wid * 64;
            const float* srcu = (const float*)((((unsigned long long)(unsigned)__builtin_amdgcn_readfirstlane((int)((unsigned long long)src >> 32))) << 32) | (unsigned long long)(unsigned)__builtin_amdgcn_readfirstlane((int)(unsigned)(unsigned long long)src));
            const unsigned la = (unsigned)__builtin_amdgcn_readfirstlane((int)(unsigned)(size_t)tab) + (unsigned)wid * 256u; const unsigned vo = (unsigned)lane * 4u;
            asm volatile("s_mov_b32 m0, %2\n\ts_nop 0\n\tglobal_load_lds_dword %0, %1" :: "v"(vo), "s"(srcu), "s"(la) : "memory", "m0"); } }
    __device__ __forceinline__ void operator()(const f32x4 (&acc)[2][2][4][2], const pg8::Unit& u, int wr, int wc, int fr, int fq) const {
        const int col0 = u.pn * 256 + wc * 64 + 16 * fq;
        unsigned char* Yt = ws + WS_Y + (size_t)u.pm * TSF8;
        f32x4 bd[2][2];
#pragma unroll
        for (int bj = 0; bj < 2; ++bj) { const LAS float* bt = (const LAS float*)(btab + u.par * 1024) + wc * 64 + 16 * fq + bj * 8; bd[bj][0] = *(const LAS f32x4*)bt; bd[bj][1] = *(const LAS f32x4*)(bt + 4); }
#pragma unroll
        for (int ai = 0; ai < 2; ++ai)
#pragma unroll
            for (int m = 0; m < 4; ++m) { const int rl = ai * 128 + wr * 64 + m * 16 + fr;
                { const f32x4 v0 = acc[ai][0][m][0] * (1.0f / 64.0f) + bd[0][0], v1 = acc[ai][0][m][1] * (1.0f / 64.0f) + bd[0][1], v2 = acc[ai][1][m][0] * (1.0f / 64.0f) + bd[1][0], v3 = acc[ai][1][m][1] * (1.0f / 64.0f) + bd[1][1];
                    *(u32x4*)(Yt + (size_t)rl * D + col0) = (u32x4){pk4_fp8(v0[0], v0[1], v0[2], v0[3]), pk4_fp8(v1[0], v1[1], v1[2], v1[3]), pk4_fp8(v2[0], v2[1], v2[2], v2[3]), pk4_fp8(v3[0], v3[1], v3[2], v3[3])}; } }
    }
};


__device__ __forceinline__ void ld16_to_lds(LAS bf16* dst, const bf16* src) { *(LAS u32x4*)dst = *(const GAS u32x4*)src; }

__device__ __forceinline__ void p2_mlstm_chain_simple(Frame& F, const Args& A, int ch) {
    const int b = ch >> 2, h = ch & 3, tid = F.tid, t = tid >> 2, p = tid & 3;
    const bf16* proj = (const bf16*)(F.ws + WS_PROJ); const float* gates = (const float*)(F.ws + WS_GATES); bf16* ycat = (bf16*)(F.ws + WS_R2);
    const float* ghead = A.in[5];
    LAS bf16* qs = (LAS bf16*)(F.lds + 0); LAS bf16* ks = (LAS bf16*)(F.lds + 16384); LAS bf16* vs = (LAS bf16*)(F.lds + 32768);
    LAS float* Cs = (LAS float*)(F.lds + 65536); LAS float* ns = (LAS float*)(F.lds + 98304);
    LAS float* ibs = ns + 64; LAS float* fbs = ibs + 128; LAS float* As = fbs + 128; LAS float* Mts = As + 128; LAS float* bcs = Mts + 128; LAS float* wks = bcs + 128; LAS float* scal = wks + 128;
    for (int i = tid; i < 128 * 64; i += NTHREADS) Cs[i] = 0.f;
    if (tid < 64) ns[tid] = 0.f;
    float mstate = 0.f;
    for (int c = 0; c < 16; ++c) {
        const int tg0 = b * SEQ + c * 128;
        __syncthreads();
#pragma unroll
        for (int j = 0; j < 2; ++j) { const int i = tid + 512 * j, row = i >> 3, part = i & 7; const bf16* src = proj + (size_t)(tg0 + row) * NP + h * 64 + part * 8;
            ld16_to_lds(qs + row * 64 + part * 8, src); ld16_to_lds(ks + row * 64 + part * 8, src + 256); }
#pragma unroll
        for (int j = 0; j < 4; ++j) { const int i = tid + 512 * j, row = i >> 4, part = i & 15; ld16_to_lds(vs + row * 128 + part * 8, proj + (size_t)(tg0 + row) * NP + 512 + h * 128 + part * 8); }
        if (tid < 128) { ibs[tid] = gates[(size_t)(tg0 + tid) * 8 + h]; fbs[tid] = gates[(size_t)(tg0 + tid) * 8 + 4 + h]; }
        __syncthreads();
        if (tid == 0) { float bs = 0.f, pm = -3.0e38f;
            for (int s = 0; s < 128; ++s) { bs += fbs[s]; bcs[s] = bs; const float a = ibs[s] - bs; As[s] = a; pm = fmaxf(pm, a); Mts[s] = fmaxf(mstate, pm); }
            scal[0] = fmaxf(mstate, pm); scal[1] = bs; }
        __syncthreads();
        const float Mnew = scal[0], bL = scal[1];
        if (tid < 128) wks[tid] = expf(As[tid] - Mnew);
        {
            const float Mt = Mts[t];
            float qd[16];
#pragma unroll
            for (int j = 0; j < 16; ++j) qd[j] = bf2f(qs[t * 64 + 16 * p + j]) * 0.125f;
            float acc[32]; float den = 0.f;
#pragma unroll
            for (int j = 0; j < 32; ++j) acc[j] = 0.f;
            for (int s = 0; s <= t; ++s) {
                float dot = 0.f;
#pragma unroll
                for (int j = 0; j < 16; ++j) dot += qd[j] * bf2f(ks[s * 64 + 16 * p + j]);
                dot += __shfl_xor(dot, 1); dot += __shfl_xor(dot, 2);
                const float val = dot * expf(As[s] - Mt);
                den += val;
#pragma unroll
                for (int j = 0; j < 32; ++j) acc[j] += val * bf2f(vs[s * 128 + 32 * p + j]);
            }
            const float winter = expf(mstate - Mt);
            float acc2[32]; float nq = 0.f;
#pragma unroll
            for (int j = 0; j < 32; ++j) acc2[j] = 0.f;
            for (int d = 0; d < 64; d += 4) {
                float q4[4];
#pragma unroll
                for (int e = 0; e < 4; ++e) q4[e] = bf2f(qs[t * 64 + d + e]) * 0.125f;
#pragma unroll
                for (int j = 0; j < 32; ++j) { const f32x4 c4 = *(const LAS f32x4*)(Cs + (32 * p + j) * 64 + d); acc2[j] += (c4[0] * q4[0] + c4[1] * q4[1]) + (c4[2] * q4[2] + c4[3] * q4[3]); }
                const f32x4 n4 = *(const LAS f32x4*)(ns + d); nq += (n4[0] * q4[0] + n4[1] * q4[1]) + (n4[2] * q4[2] + n4[3] * q4[3]);
            }
            den += winter * nq;
            const float dn = fmaxf(fabsf(den), expf(-(bcs[t] + Mt)));
            const float inv = 1.0f / dn; float ss = 0.f;
#pragma unroll
            for (int j = 0; j < 32; ++j) { acc[j] = (acc[j] + winter * acc2[j]) * inv; ss += acc[j] * acc[j]; }
            ss += __shfl_xor(ss, 1); ss += __shfl_xor(ss, 2);
            const float r = rsqrtf(ss * (1.0f / 128.0f) + EPS);
            const bf16* og = proj + (size_t)(tg0 + t) * NP + 1024 + h * 128 + 32 * p; bf16* yo = ycat + (size_t)(tg0 + t) * D + h * 128 + 32 * p; const float* gh = ghead + h * 128 + 32 * p;
#pragma unroll
            for (int j8 = 0; j8 < 4; ++j8) { const u32x4 ow = *(const GAS u32x4*)(og + j8 * 8); const unsigned oww[4] = {ow.x, ow.y, ow.z, ow.w}; unsigned res[4];
#pragma unroll
                for (int e = 0; e < 4; ++e) { const int j = j8 * 8 + 2 * e; const float o0 = bflo(oww[e]), o1 = bfhi(oww[e]);
                    const float y0 = acc[j] * r * gh[j] * (1.0f / (1.0f + expf(-o0))), y1 = acc[j + 1] * r * gh[j + 1] * (1.0f / (1.0f + expf(-o1))); res[e] = pk2(y0, y1); }
                *(GAS u32x4*)(yo + j8 * 8) = (u32x4){res[0], res[1], res[2], res[3]}; }
        }
        __syncthreads();
        {
            const float decay = expf(mstate - Mnew); const int v = tid >> 2, d0 = 16 * (tid & 3);
            float cn[16];
#pragma unroll
            for (int j = 0; j < 16; ++j) cn[j] = decay * Cs[v * 64 + d0 + j];
            for (int s = 0; s < 128; ++s) { const float wv = wks[s] * bf2f(vs[s * 128 + v]);
#pragma unroll
                for (int j = 0; j < 16; ++j) cn[j] += wv * bf2f(ks[s * 64 + d0 + j]); }
#pragma unroll
            for (int j = 0; j < 16; ++j) Cs[v * 64 + d0 + j] = cn[j];
            if (tid < 64) { float a = decay * ns[tid]; for (int s = 0; s < 128; ++s) a += wks[s] * bf2f(ks[s * 64 + tid]); ns[tid] = a; }
            mstate = bL + Mnew;
        }
    }
    __syncthreads();
}

__device__ __forceinline__ void p2_gmlp_unit_simple(Frame& F, const Args& A, int u) {
    const int b = u >> 6, c = (u >> 2) & 15, g = u & 3, tid = F.tid, t = tid >> 2, p = tid & 3, tg0 = b * SEQ + c * 128;
    const bf16* proj = (const bf16*)(F.ws + WS_PROJ); bf16* ycat = (bf16*)(F.ws + WS_R2);
    const float* wsp = A.in[6] + (size_t)g * 128 * 128; const float* bsp = A.in[7] + g * 128; const float* gv = A.in[8] + g * 128; const float* go = A.in[9] + g * 128;
    LAS float* zs = (LAS float*)(F.lds + 0);
    __syncthreads();
    {
        const bf16* src = proj + (size_t)(tg0 + t) * NP + 2048 + g * 128 + 32 * p; float z[32]; float ss = 0.f;
#pragma unroll
        for (int j8 = 0; j8 < 4; ++j8) { const u32x4 w = *(const GAS u32x4*)(src + j8 * 8); const unsigned ww[4] = {w.x, w.y, w.z, w.w};
#pragma unroll
            for (int e = 0; e < 4; ++e) { z[j8 * 8 + 2 * e] = bflo(ww[e]); z[j8 * 8 + 2 * e + 1] = bfhi(ww[e]); } }
#pragma unroll
        for (int j = 0; j < 32; ++j) ss += z[j] * z[j];
        ss += __shfl_xor(ss, 1); ss += __shfl_xor(ss, 2);
        const float r = rsqrtf(ss * (1.0f / 128.0f) + EPS);
#pragma unroll
        for (int j = 0; j < 32; ++j) zs[t * 128 + 32 * p + j] = z[j] * r * gv[32 * p + j];
    }
    __syncthreads();
    {
        float acc[32];
#pragma unroll
        for (int j = 0; j < 32; ++j) acc[j] = 0.f;
        for (int s = 0; s <= t; ++s) { const float w = wsp[t * 128 + s];
#pragma unroll
            for (int j = 0; j < 32; ++j) acc[j] += w * zs[s * 128 + 32 * p + j]; }
        const float bias = bsp[t];
        const bf16* us = proj + (size_t)(tg0 + t) * NP + 1536 + g * 128 + 32 * p; float ss = 0.f;
#pragma unroll
        for (int j8 = 0; j8 < 4; ++j8) { const u32x4 w = *(const GAS u32x4*)(us + j8 * 8); const unsigned ww[4] = {w.x, w.y, w.z, w.w};
#pragma unroll
            for (int e = 0; e < 4; ++e) { const int j = j8 * 8 + 2 * e; acc[j] = bflo(ww[e]) * (acc[j] + bias); acc[j + 1] = bfhi(ww[e]) * (acc[j + 1] + bias); ss += acc[j] * acc[j] + acc[j + 1] * acc[j + 1]; } }
        ss += __shfl_xor(ss, 1); ss += __shfl_xor(ss, 2);
        const float r = rsqrtf(ss * (1.0f / 128.0f) + EPS);
        bf16* yo = ycat + (size_t)(tg0 + t) * D + 512 + g * 128 + 32 * p;
#pragma unroll
        for (int j8 = 0; j8 < 4; ++j8) { unsigned res[4];
#pragma unroll
            for (int e = 0; e < 4; ++e) { const int j = j8 * 8 + 2 * e; res[e] = pk2(acc[j] * r * go[32 * p + j], acc[j + 1] * r * go[32 * p + j + 1]); }
            *(GAS u32x4*)(yo + j8 * 8) = (u32x4){res[0], res[1], res[2], res[3]}; }
    }
}

__device__ __forceinline__ void p5_attn_unit_simple(Frame& F, int u) {
    const int b = u >> 7, h = (u >> 5) & 3, qt = u & 31, tid = F.tid, ql = tid >> 3, p = tid & 7;
    const bf16* Q = (const bf16*)(F.ws + WS_R2); const bf16* Km = (const bf16*)(F.ws + WS_KM); const bf16* Vt = (const bf16*)(F.ws + WS_VT); bf16* O = (bf16*)(F.ws + WS_R3);
    LAS bf16* Ks = (LAS bf16*)(F.lds + 0); LAS bf16* Vs = (LAS bf16*)(F.lds + 32768);
    const size_t tq = (size_t)b * SEQ + qt * 64 + ql;
    float qf[32], acc[32];
    { const bf16* src = Q + tq * D + h * 256 + 32 * p;
#pragma unroll
      for (int j8 = 0; j8 < 4; ++j8) { const u32x4 w = *(const GAS u32x4*)(src + j8 * 8); const unsigned ww[4] = {w.x, w.y, w.z, w.w};
#pragma unroll
          for (int e = 0; e < 4; ++e) { qf[j8 * 8 + 2 * e] = bflo(ww[e]); qf[j8 * 8 + 2 * e + 1] = bfhi(ww[e]); } } }
#pragma unroll
    for (int j = 0; j < 32; ++j) acc[j] = 0.f;
    float mrun = -1.0e30f, l = 0.f;
    for (int kt = 0; kt < 4; ++kt) {
        __syncthreads();
#pragma unroll
        for (int j = 0; j < 4; ++j) { const int i = tid + 512 * j, row = i >> 5, part = i & 31; ld16_to_lds(Ks + row * 256 + part * 8, Km + (size_t)(b * 256 + kt * 64 + row) * D + h * 256 + part * 8); }
#pragma unroll
        for (int j = 0; j < 4; ++j) { const int i = tid + 512 * j, d = i >> 3, part = i & 7; const u32x4 w = *(const GAS u32x4*)(Vt + (size_t)(h * 256 + d) * TM + b * 256 + kt * 64 + part * 8); const unsigned ww[4] = {w.x, w.y, w.z, w.w};
#pragma unroll
            for (int e = 0; e < 4; ++e) { Vs[(part * 8 + 2 * e) * 256 + d] = (bf16)(ww[e] & 0xffffu); Vs[(part * 8 + 2 * e + 1) * 256 + d] = (bf16)(ww[e] >> 16); } }
        __syncthreads();
        for (int mb = 0; mb < 8; ++mb) {
            float s8[8]; float mx = mrun;
#pragma unroll
            for (int e = 0; e < 8; ++e) { const int m = mb * 8 + e; float dot = 0.f;
#pragma unroll
                for (int j8 = 0; j8 < 4; ++j8) { const u32x4 w = *(const LAS u32x4*)(Ks + m * 256 + 32 * p + j8 * 8); const unsigned ww[4] = {w.x, w.y, w.z, w.w};
#pragma unroll
                    for (int q = 0; q < 4; ++q) dot += qf[j8 * 8 + 2 * q] * bflo(ww[q]) + qf[j8 * 8 + 2 * q + 1] * bfhi(ww[q]); }
                dot += __shfl_xor(dot, 1); dot += __shfl_xor(dot, 2); dot += __shfl_xor(dot, 4); s8[e] = dot; mx = fmaxf(mx, dot); }
            const float corr = expf(mrun - mx); mrun = mx; l *= corr;
#pragma unroll
            for (int j = 0; j < 32; ++j) acc[j] *= corr;
#pragma unroll
            for (int e = 0; e < 8; ++e) { const int m = mb * 8 + e; const float pe = expf(s8[e] - mx); l += pe;
#pragma unroll
                for (int j8 = 0; j8 < 4; ++j8) { const u32x4 w = *(const LAS u32x4*)(Vs + m * 256 + 32 * p + j8 * 8); const unsigned ww[4] = {w.x, w.y, w.z, w.w};
#pragma unroll
                    for (int q = 0; q < 4; ++q) { acc[j8 * 8 + 2 * q] += pe * bflo(ww[q]); acc[j8 * 8 + 2 * q + 1] += pe * bfhi(ww[q]); } } }
        }
    }
    const float inv = 1.0f / l; bf16* dst = O + tq * D + h * 256 + 32 * p;
#pragma unroll
    for (int j8 = 0; j8 < 4; ++j8) { u32x4 w; w.x = pk2(acc[j8 * 8] * inv, acc[j8 * 8 + 1] * inv); w.y = pk2(acc[j8 * 8 + 2] * inv, acc[j8 * 8 + 3] * inv); w.z = pk2(acc[j8 * 8 + 4] * inv, acc[j8 * 8 + 5] * inv); w.w = pk2(acc[j8 * 8 + 6] * inv, acc[j8 * 8 + 7] * inv);
        *(GAS u32x4*)(dst + j8 * 8) = w; }
}

constexpr int ML_QS = 0, ML_KS = 18432, ML_VS = 34816, ML_CT = 67584, ML_NS = 83968, ML_WK = 84480, ML_A = 86016, ML_M = ML_A + 8192, ML_LF = ML_M + 8192, ML_MC = ML_LF + 8192;
typedef short s16x4 __attribute__((ext_vector_type(4)));
__device__ __forceinline__ int swzf(int r) { return (r & 3) | ((((r >> 2) ^ (r >> 3)) & 1) << 2); }
__device__ __forceinline__ int swzg(int r) { return ((r >> 1) & 1) | (((r >> 3) & 1) << 1); }
__device__ __forceinline__ int offV(int r, int c) { return 256 * r + 32 * ((c >> 4) ^ swzf(r)) + 2 * (c & 15); }
__device__ __forceinline__ int offK(int r, int c) { return 128 * r + 32 * ((c >> 4) ^ swzg(r)) + 2 * (c & 15); }
__device__ __forceinline__ bf16x8 tr_frag_V(const LAS unsigned char* base, int rA, int rB, int cb, int gi) {
    const int q = gi >> 2, p4 = (gi & 3) * 4;
    const s16x4 x = __builtin_bit_cast(s16x4, __builtin_amdgcn_ds_read_tr16_b64_v4i16((LAS s16x4*)(base + offV(rA + q, 16 * cb + p4))));
    const s16x4 y = __builtin_bit_cast(s16x4, __builtin_amdgcn_ds_read_tr16_b64_v4i16((LAS s16x4*)(base + offV(rB + q, 16 * cb + p4))));
    return __builtin_shufflevector(x, y, 0, 1, 2, 3, 4, 5, 6, 7);
}
__device__ __forceinline__ bf16x8 tr_frag_K(const LAS unsigned char* base, int rA, int rB, int cb, int gi) {
    const int q = gi >> 2, p4 = (gi & 3) * 4;
    const s16x4 x = __builtin_bit_cast(s16x4, __builtin_amdgcn_ds_read_tr16_b64_v4i16((LAS s16x4*)(base + offK(rA + q, 16 * cb + p4))));
    const s16x4 y = __builtin_bit_cast(s16x4, __builtin_amdgcn_ds_read_tr16_b64_v4i16((LAS s16x4*)(base + offK(rB + q, 16 * cb + p4))));
    return __builtin_shufflevector(x, y, 0, 1, 2, 3, 4, 5, 6, 7);
}
__device__ __forceinline__ bf16x8 scale_frag(bf16x8 f, float sc) {
    const u32x4 w = __builtin_bit_cast(u32x4, f);
    return __builtin_bit_cast(bf16x8, (u32x4){cvt_pk_bf16(bflo(w.x) * sc, bfhi(w.x) * sc), cvt_pk_bf16(bflo(w.y) * sc, bfhi(w.y) * sc), cvt_pk_bf16(bflo(w.z) * sc, bfhi(w.z) * sc), cvt_pk_bf16(bflo(w.w) * sc, bfhi(w.w) * sc)});
}
__device__ __forceinline__ bf16x8 scale_frag8(bf16x8 f, f32x4 s0, f32x4 s1) {
    const u32x4 w = __builtin_bit_cast(u32x4, f);
    return __builtin_bit_cast(bf16x8, (u32x4){cvt_pk_bf16(bflo(w.x) * s0[0], bfhi(w.x) * s0[1]), cvt_pk_bf16(bflo(w.y) * s0[2], bfhi(w.y) * s0[3]), cvt_pk_bf16(bflo(w.z) * s1[0], bfhi(w.z) * s1[1]), cvt_pk_bf16(bflo(w.w) * s1[2], bfhi(w.w) * s1[3])});
}
__device__ __forceinline__ void p2_mlstm_chain(Frame& F, const Args& A, int ch) {
    const int b = ch >> 2, h = ch & 3, tid = opaque(F.tid), lane = tid & 63, w = F.wave, tl = lane & 15, fq = lane >> 4;
    const bf16* proj = (const bf16*)(F.ws + WS_PROJ); const float* gates = (const float*)(F.ws + WS_GATES); bf16* ycat = (bf16*)(F.ws + WS_R2);
    const float* ghead = A.in[5] + h * 128;
    LAS unsigned char* L = F.lds;
    LAS float* sA = (LAS float*)(L + ML_A); LAS float* sM = (LAS float*)(L + ML_M); LAS float* sLF = (LAS float*)(L + ML_LF); LAS float* sMC = (LAS float*)(L + ML_MC);
    LAS float* ns = (LAS float*)(L + ML_NS); LAS float* sWK = (LAS float*)(L + ML_WK);
    __syncthreads();
    {
#pragma unroll
      for (int cc = 0; cc < 2; ++cc) { const int c = 2 * w + cc, p0 = c * 128 + 2 * lane; const size_t gi = ((size_t)b * SEQ + p0) * 8;
          const float i0 = gates[gi + h], f0 = gates[gi + 4 + h], i1 = gates[gi + 8 + h], f1 = gates[gi + 12 + h];
          float sc = f0 + f1;
#pragma unroll
          for (int o = 1; o < 64; o <<= 1) { const float t = __shfl_up(sc, o); if (lane >= o) sc += t; }
          const float b1 = sc, b0 = sc - f1, a0 = i0 - b0, a1 = i1 - b1;
          float pm = fmaxf(a0, a1);
#pragma unroll
          for (int o = 1; o < 64; o <<= 1) { const float t = __shfl_up(pm, o); if (lane >= o) pm = fmaxf(pm, t); }
          float pe = __shfl_up(pm, 1); if (lane == 0) pe = -3.0e38f;
          sA[p0] = a0; sA[p0 + 1] = a1; sLF[p0] = b0; sLF[p0 + 1] = b1; sM[p0] = fmaxf(pe, a0); sM[p0 + 1] = pm; }
      __syncthreads();
      if (tid == 0) { float m = 0.f; for (int c = 0; c < 16; ++c) { sMC[c] = m; const float Mn = fmaxf(m, sM[c * 128 + 127]); sMC[32 + c] = Mn; m = sLF[c * 128 + 127] + Mn; } sMC[16] = m; }
      __syncthreads();
#pragma unroll
      for (int j = 0; j < 4; ++j) { const int p = tid + 512 * j; const float Mt = fmaxf(sMC[p >> 7], sM[p]); sM[p] = Mt; sLF[p] = -(sLF[p] + Mt); }
      for (int i = tid; i < 64 * 256 / 4; i += NTHREADS) ((LAS unsigned*)(L + ML_CT))[i] = 0u;
      if (tid < 64) ns[tid] = 0.f;
      __syncthreads(); }
    f32x4 Cst[4]; f32x4 Nst = (f32x4){0.f, 0.f, 0.f, 0.f};
#pragma unroll
    for (int i = 0; i < 4; ++i) Cst[i] = (f32x4){0.f, 0.f, 0.f, 0.f};
    u32x4 qreg[2], kreg[2], vreg[4];
    { const size_t tg0 = (size_t)b * SEQ;
#pragma unroll
      for (int j = 0; j < 2; ++j) { const int idx = tid + 512 * j, row = idx >> 3, part = idx & 7; const bf16* src = proj + (tg0 + row) * NP + h * 64 + part * 8; qreg[j] = *(const GAS u32x4*)src; kreg[j] = *(const GAS u32x4*)(src + 256); }
#pragma unroll
      for (int j = 0; j < 4; ++j) { const int idx = tid + 512 * j, row = idx >> 4, part = idx & 15; vreg[j] = *(const GAS u32x4*)(proj + (tg0 + row) * NP + 512 + h * 128 + part * 8); } }
#pragma unroll 1
    for (int c = 0; c < 16; ++c) {
        const size_t tg0 = (size_t)b * SEQ + c * 128; const int t = 16 * w + tl;
#pragma unroll
        for (int j = 0; j < 2; ++j) { const int idx = tid + 512 * j, row = idx >> 3, part = idx & 7; *(LAS u32x4*)(L + ML_QS + row * 144 + part * 16) = qreg[j];
            *(LAS u32x4*)(L + ML_KS + 128 * row + 32 * ((part >> 1) ^ swzg(row)) + 16 * (part & 1)) = kreg[j]; }
#pragma unroll
        for (int j = 0; j < 4; ++j) { const int idx = tid + 512 * j, row = idx >> 4, part = idx & 15; *(LAS u32x4*)(L + ML_VS + 256 * row + 32 * ((part >> 1) ^ swzf(row)) + 16 * (part & 1)) = vreg[j]; }
        const float mc = sMC[c], Mn = sMC[32 + c], Mt = sM[c * 128 + t], lf = sLF[c * 128 + t];
        if (tid < 128) sWK[tid] = __builtin_amdgcn_exp2f((sA[c * 128 + tid] - Mn) * 1.4426950408889634f);
        __syncthreads();
        if (c < 15) { const size_t tn = tg0 + 128;
#pragma unroll
            for (int j = 0; j < 2; ++j) { const int idx = tid + 512 * j, row = idx >> 3, part = idx & 7; const bf16* src = proj + (tn + row) * NP + h * 64 + part * 8; qreg[j] = *(const GAS u32x4*)src; kreg[j] = *(const GAS u32x4*)(src + 256); }
#pragma unroll
            for (int j = 0; j < 4; ++j) { const int idx = tid + 512 * j, row = idx >> 4, part = idx & 15; vreg[j] = *(const GAS u32x4*)(proj + (tn + row) * NP + 512 + h * 128 + part * 8); } }
        u32x2 og[8];
#pragma unroll
        for (int vb = 0; vb < 8; ++vb) og[vb] = *(const GAS u32x2*)(proj + (tg0 + t) * NP + 1024 + h * 128 + 16 * vb + 4 * fq);
        bf16x8 qf[2];
#pragma unroll
        for (int ds = 0; ds < 2; ++ds) qf[ds] = *(const LAS bf16x8*)(L + ML_QS + t * 144 + ds * 64 + fq * 16);
        unsigned sfr[4][4];
#pragma unroll
        for (int i = 0; i < 4; ++i)
#pragma unroll
            for (int j = 0; j < 4; ++j) sfr[i][j] = 0u;
        float den = 0.f;
#pragma unroll
        for (int sb = 0; sb < 8; ++sb) {
            if (sb <= w) {
                f32x4 G = (f32x4){0.f, 0.f, 0.f, 0.f}; const int sr = 16 * sb + tl;
#pragma unroll
                for (int ds = 0; ds < 2; ++ds) { const bf16x8 a = *(const LAS bf16x8*)(L + ML_KS + 128 * sr + 32 * ((2 * ds + (fq >> 1)) ^ swzg(sr)) + 16 * (fq & 1)); G = __builtin_amdgcn_mfma_f32_16x16x32_bf16(a, qf[ds], G, 0, 0, 0); }
                const f32x4 as = *(const LAS f32x4*)(sA + c * 128 + 16 * sb + 4 * fq);
                float sw[4];
#pragma unroll
                for (int r = 0; r < 4; ++r) { const int s = 16 * sb + 4 * fq + r; float wg = __builtin_amdgcn_exp2f((as[r] - Mt) * 1.4426950408889634f) * 0.125f; if (s > t) wg = 0.f; sw[r] = G[r] * wg; den += sw[r]; }
                sfr[sb >> 1][(sb & 1) * 2] = cvt_pk_bf16(sw[0], sw[1]); sfr[sb >> 1][(sb & 1) * 2 + 1] = cvt_pk_bf16(sw[2], sw[3]);
            }
        }
        den += __shfl_xor(den, 16); den += __shfl_xor(den, 32);
        const float winter = __builtin_amdgcn_exp2f((mc - Mt) * 1.4426950408889634f);
        { float nq = 0.f;
#pragma unroll
          for (int ds = 0; ds < 2; ++ds) { const u32x4 qw = __builtin_bit_cast(u32x4, qf[ds]); const f32x4 n0 = *(const LAS f32x4*)(ns + ds * 32 + fq * 8), n1 = *(const LAS f32x4*)(ns + ds * 32 + fq * 8 + 4);
              nq += (bflo(qw.x) * n0[0] + bfhi(qw.x) * n0[1]) + (bflo(qw.y) * n0[2] + bfhi(qw.y) * n0[3]) + (bflo(qw.z) * n1[0] + bfhi(qw.z) * n1[1]) + (bflo(qw.w) * n1[2] + bfhi(qw.w) * n1[3]); }
          nq += __shfl_xor(nq, 16); nq += __shfl_xor(nq, 32);
          den += winter * nq * 0.125f; }
        f32x4 acc[8];
#pragma unroll
        for (int vb = 0; vb < 8; ++vb) acc[vb] = (f32x4){0.f, 0.f, 0.f, 0.f};
        { bf16x8 qw[2]; qw[0] = scale_frag(qf[0], winter * 0.125f); qw[1] = scale_frag(qf[1], winter * 0.125f);
#pragma unroll
          for (int vb = 0; vb < 8; ++vb)
#pragma unroll
              for (int ds = 0; ds < 2; ++ds) { const bf16x8 a = tr_frag_V(L + ML_CT, 32 * ds + 8 * fq, 32 * ds + 8 * fq + 4, vb, tl); acc[vb] = __builtin_amdgcn_mfma_f32_16x16x32_bf16(a, qw[ds], acc[vb], 0, 0, 0); } }
#pragma unroll
        for (int st = 0; st < 4; ++st) {
            if (2 * st <= w) {
                const bf16x8 bfr = __builtin_bit_cast(bf16x8, (u32x4){sfr[st][0], sfr[st][1], sfr[st][2], sfr[st][3]});
#pragma unroll
                for (int vb = 0; vb < 8; ++vb) { const bf16x8 a = tr_frag_V(L + ML_VS, 32 * st + 4 * fq, 32 * st + 16 + 4 * fq, vb, tl); acc[vb] = __builtin_amdgcn_mfma_f32_16x16x32_bf16(a, bfr, acc[vb], 0, 0, 0); }
            }
        }
        { const float inv = 1.0f / fmaxf(fabsf(den), __builtin_amdgcn_exp2f(lf * 1.4426950408889634f)); float ss = 0.f;
#pragma unroll
          for (int vb = 0; vb < 8; ++vb) { acc[vb] = acc[vb] * inv; ss += (acc[vb][0] * acc[vb][0] + acc[vb][1] * acc[vb][1]) + (acc[vb][2] * acc[vb][2] + acc[vb][3] * acc[vb][3]); }
          ss += __shfl_xor(ss, 16); ss += __shfl_xor(ss, 32);
          const float r = rsqrtf(ss * (1.0f / 128.0f) + EPS);
          bf16* yo = ycat + (tg0 + t) * D + h * 128 + 4 * fq;
#pragma unroll
          for (int vb = 0; vb < 8; ++vb) { const f32x4 gh = *(const f32x4*)(ghead + 16 * vb + 4 * fq);
              const float y0 = acc[vb][0] * r * gh[0] * sigmoidf_fast(bflo(og[vb].x)), y1 = acc[vb][1] * r * gh[1] * sigmoidf_fast(bfhi(og[vb].x));
              const float y2 = acc[vb][2] * r * gh[2] * sigmoidf_fast(bflo(og[vb].y)), y3 = acc[vb][3] * r * gh[3] * sigmoidf_fast(bfhi(og[vb].y));
              *(GAS u32x2*)(yo + 16 * vb) = (u32x2){cvt_pk_bf16(y0, y1), cvt_pk_bf16(y2, y3)}; } }
        { const float decay = __builtin_amdgcn_exp2f((mc - Mn) * 1.4426950408889634f);
#pragma unroll
          for (int db = 0; db < 4; ++db) Cst[db] = Cst[db] * decay;
          Nst = Nst * decay;
#pragma unroll
          for (int st = 0; st < 4; ++st) { const f32x4 k0 = *(const LAS f32x4*)(sWK + 32 * st + 8 * fq), k1 = *(const LAS f32x4*)(sWK + 32 * st + 8 * fq + 4);
              const bf16x8 a = scale_frag8(tr_frag_V(L + ML_VS, 32 * st + 8 * fq, 32 * st + 8 * fq + 4, w, tl), k0, k1);
              const u32x4 wkp = (u32x4){cvt_pk_bf16(k0[0], k0[1]), cvt_pk_bf16(k0[2], k0[3]), cvt_pk_bf16(k1[0], k1[1]), cvt_pk_bf16(k1[2], k1[3])};
              const bf16x8 an = __builtin_bit_cast(bf16x8, tl == 0 ? wkp : (u32x4){0u, 0u, 0u, 0u});
#pragma unroll
              for (int db = 0; db < 4; ++db) { const bf16x8 bb = tr_frag_K(L + ML_KS, 32 * st + 8 * fq, 32 * st + 8 * fq + 4, db, tl); Cst[db] = __builtin_amdgcn_mfma_f32_16x16x32_bf16(a, bb, Cst[db], 0, 0, 0);
                  if (db == w) Nst = __builtin_amdgcn_mfma_f32_16x16x32_bf16(an, bb, Nst, 0, 0, 0); } } }
        __syncthreads();
#pragma unroll
        for (int db = 0; db < 4; ++db) { const int d = 16 * db + tl; *(LAS u32x2*)(L + ML_CT + 256 * d + 32 * (w ^ swzf(d)) + 8 * fq) = (u32x2){cvt_pk_bf16(Cst[db][0], Cst[db][1]), cvt_pk_bf16(Cst[db][2], Cst[db][3])}; }
        if (w < 4 && fq == 0) ns[16 * w + tl] = Nst[0];
    }
    __syncthreads();
}
constexpr int GM_WB = 0, GM_ZS = 34816;
__device__ __forceinline__ void p2_gmlp_setup(Frame& F, const Args& A, int g) {
    const int tid = opaque(F.tid), t = tid >> 2, s0 = (tid & 3) * 32; const float* src = A.in[6] + ((size_t)g * 128 + t) * 128 + s0;
    __syncthreads();
#pragma unroll
    for (int j = 0; j < 4; ++j) { const f32x4 a = *(const f32x4*)(src + 8 * j), bq = *(const f32x4*)(src + 8 * j + 4); float v[8] = {a[0], a[1], a[2], a[3], bq[0], bq[1], bq[2], bq[3]};
#pragma unroll
        for (int e = 0; e < 8; ++e) if (s0 + 8 * j + e > t) v[e] = 0.f;
        *(LAS u32x4*)(F.lds + GM_WB + t * 272 + (s0 + 8 * j) * 2) = (u32x4){pk2(v[0], v[1]), pk2(v[2], v[3]), pk2(v[4], v[5]), pk2(v[6], v[7])}; }
    __syncthreads();
}
__device__ __forceinline__ void p2_gmlp_unit(Frame& F, const Args& A, int b, int c, int g, u32x4 (&zreg)[4], u32x2 (&ugn)[8], bool has_next, int nb, int nc, const f32x4 (&gvr)[8], const f32x4 (&gor)[8], const float bias) {
    const int tid = opaque(F.tid), lane = tid & 63, w = F.wave, tl = lane & 15, fq = lane >> 4; const size_t tg0 = (size_t)b * SEQ + c * 128;
    const bf16* proj = (const bf16*)(F.ws + WS_PROJ); bf16* ycat = (bf16*)(F.ws + WS_R2);
    LAS unsigned char* L = F.lds;
    {
        const int s = tid >> 2, p = tid & 3; float z[32]; float ss = 0.f;
#pragma unroll
        for (int j8 = 0; j8 < 4; ++j8) { const unsigned wv[4] = {zreg[j8].x, zreg[j8].y, zreg[j8].z, zreg[j8].w};
#pragma unroll
            for (int e = 0; e < 4; ++e) { z[j8 * 8 + 2 * e] = bflo(wv[e]); z[j8 * 8 + 2 * e + 1] = bfhi(wv[e]); } }
#pragma unroll
        for (int j = 0; j < 32; ++j) ss += z[j] * z[j];
        ss += __shfl_xor(ss, 1); ss += __shfl_xor(ss, 2);
        const float r = rsqrtf(ss * (1.0f / 128.0f) + EPS);
#pragma unroll
        for (int j8 = 0; j8 < 4; ++j8) { const int pp = 4 * p + j8; const f32x4 g0 = gvr[2 * j8], g1 = gvr[2 * j8 + 1];
            *(LAS u32x4*)(L + GM_ZS + 256 * s + 32 * ((pp >> 1) ^ swzf(s)) + 16 * (pp & 1)) = (u32x4){cvt_pk_bf16(z[j8 * 8] * r * g0[0], z[j8 * 8 + 1] * r * g0[1]), cvt_pk_bf16(z[j8 * 8 + 2] * r * g0[2], z[j8 * 8 + 3] * r * g0[3]),
                cvt_pk_bf16(z[j8 * 8 + 4] * r * g1[0], z[j8 * 8 + 5] * r * g1[1]), cvt_pk_bf16(z[j8 * 8 + 6] * r * g1[2], z[j8 * 8 + 7] * r * g1[3])}; }
    }
    const int t = 16 * w + tl;
    u32x2 ug[8];
#pragma unroll
    for (int db = 0; db < 8; ++db) ug[db] = ugn[db];
    __syncthreads();
    if (has_next) { const size_t tn = (size_t)nb * SEQ + nc * 128; const int s = tid >> 2, p = tid & 3;
#pragma unroll
        for (int j8 = 0; j8 < 4; ++j8) zreg[j8] = *(const GAS u32x4*)(proj + (tn + s) * NP + 2048 + g * 128 + 32 * p + j8 * 8);
#pragma unroll
        for (int db = 0; db < 8; ++db) ugn[db] = *(const GAS u32x2*)(proj + (tn + t) * NP + 1536 + g * 128 + 16 * db + 4 * fq); }
    f32x4 acc[8];
#pragma unroll
    for (int db = 0; db < 8; ++db) acc[db] = (f32x4){0.f, 0.f, 0.f, 0.f};
#pragma unroll
    for (int st = 0; st < 4; ++st) {
        if (2 * st <= w) { const bf16x8 bfr = *(const LAS bf16x8*)(L + GM_WB + t * 272 + (32 * st + 8 * fq) * 2);
#pragma unroll
            for (int db = 0; db < 8; ++db) { const bf16x8 a = tr_frag_V(L + GM_ZS, 32 * st + 8 * fq, 32 * st + 8 * fq + 4, db, tl); acc[db] = __builtin_amdgcn_mfma_f32_16x16x32_bf16(a, bfr, acc[db], 0, 0, 0); } }
    }
    float ss = 0.f;
#pragma unroll
    for (int db = 0; db < 8; ++db) { acc[db][0] = bflo(ug[db].x) * (acc[db][0] + bias); acc[db][1] = bfhi(ug[db].x) * (acc[db][1] + bias); acc[db][2] = bflo(ug[db].y) * (acc[db][2] + bias); acc[db][3] = bfhi(ug[db].y) * (acc[db][3] + bias);
        ss += (acc[db][0] * acc[db][0] + acc[db][1] * acc[db][1]) + (acc[db][2] * acc[db][2] + acc[db][3] * acc[db][3]); }
    ss += __shfl_xor(ss, 16); ss += __shfl_xor(ss, 32);
    const float r = rsqrtf(ss * (1.0f / 128.0f) + EPS);
    bf16* yo = ycat + (tg0 + t) * D + 512 + g * 128 + 4 * fq;
#pragma unroll
    for (int db = 0; db < 8; ++db) { const f32x4 gg = gor[db];
        *(GAS u32x2*)(yo + 16 * db) = (u32x2){cvt_pk_bf16(acc[db][0] * r * gg[0], acc[db][1] * r * gg[1]), cvt_pk_bf16(acc[db][2] * r * gg[2], acc[db][3] * r * gg[3])}; }
    __syncthreads();
}

constexpr int ATT_KROW = 528, ATT_VROW = 136, ATT_BUF = 34816;
__device__ __forceinline__ void att_load_tile(int i, int b, int h, int tid, const bf16* Km, const bf16* Vt, u32x4 (&r)[4]) {
    if (i < 4) {
#pragma unroll
        for (int j = 0; j < 4; ++j) { const int idx = tid + 512 * j, row = idx >> 5, c = idx & 31; r[j] = *(const GAS u32x4*)(Km + (size_t)(b * 256 + i * 64 + row) * D + h * 256 + c * 8); }
    } else {
#pragma unroll
        for (int j = 0; j < 4; ++j) { const int idx = tid + 512 * j, d = idx >> 3, c = idx & 7; r[j] = *(const GAS u32x4*)(Vt + (size_t)(h * 256 + d) * TM + b * 256 + (i - 4) * 64 + c * 8); }
    }
}
__device__ __forceinline__ void att_store_tile(int i, int tid, LAS unsigned char* buf, const u32x4 (&r)[4]) {
    if (i < 4) {
#pragma unroll
        for (int j = 0; j < 4; ++j) { const int idx = tid + 512 * j, row = idx >> 5, c = idx & 31; *(LAS u32x4*)(buf + row * ATT_KROW + c * 16) = r[j]; }
    } else {
#pragma unroll
        for (int j = 0; j < 4; ++j) { const int idx = tid + 512 * j, d = idx >> 3, c = idx & 7; LAS u32x2* dp = (LAS u32x2*)(buf + d * ATT_VROW + c * 16); dp[0] = (u32x2){r[j].x, r[j].y}; dp[1] = (u32x2){r[j].z, r[j].w}; }
    }
}
__device__ __forceinline__ void p5_attn_unit(Frame& F, int u) {
    const int b = u >> 6, h = (u >> 4) & 3, qt = u & 15, tid = opaque(F.tid), lane = tid & 63, w = F.wave, ql = lane & 15, fq = lane >> 4;
    const bf16* Q = (const bf16*)(F.ws + WS_R2); const bf16* Km = (const bf16*)(F.ws + WS_KM); const bf16* Vt = (const bf16*)(F.ws + WS_VT); bf16* O = (bf16*)(F.ws + WS_R3);
    const size_t tq = (size_t)b * SEQ + qt * 128 + w * 16 + ql;
    bf16x8 qf[8];
#pragma unroll
    for (int ds = 0; ds < 8; ++ds) qf[ds] = *(const GAS bf16x8*)(Q + tq * D + h * 256 + 32 * ds + 8 * fq);
    f32x4 S[16];
#pragma unroll
    for (int i = 0; i < 16; ++i) S[i] = (f32x4){0.f, 0.f, 0.f, 0.f};
    u32x4 pre[4];
    __syncthreads();
    att_load_tile(0, b, h, tid, Km, Vt, pre); att_store_tile(0, tid, F.lds, pre);
    __syncthreads();
#pragma unroll
    for (int kt = 0; kt < 4; ++kt) {
        LAS unsigned char* buf = F.lds + (kt & 1) * ATT_BUF;
        att_load_tile(kt + 1, b, h, tid, Km, Vt, pre);
#pragma unroll
        for (int kb = 0; kb < 4; ++kb)
#pragma unroll
            for (int ds = 0; ds < 8; ++ds) { const bf16x8 a = *(const LAS bf16x8*)(buf + (kb * 16 + ql) * ATT_KROW + (32 * ds + 8 * fq) * 2);
                S[kt * 4 + kb] = __builtin_amdgcn_mfma_f32_16x16x32_bf16(a, qf[ds], S[kt * 4 + kb], 0, 0, 0); }
        att_store_tile(kt + 1, tid, F.lds + ((kt + 1) & 1) * ATT_BUF, pre);
        __syncthreads();
    }
    float mx = -3.0e38f;
#pragma unroll
    for (int i = 0; i < 16; ++i) mx = fmaxf(fmaxf(fmaxf(mx, S[i][0]), fmaxf(S[i][1], S[i][2])), S[i][3]);
    mx = fmaxf(mx, __shfl_xor(mx, 16)); mx = fmaxf(mx, __shfl_xor(mx, 32));
    float l = 0.f; bf16x8 pf[8];
#pragma unroll
    for (int st = 0; st < 8; ++st) { float e[8];
#pragma unroll
        for (int j = 0; j < 4; ++j) { e[j] = __builtin_amdgcn_exp2f((S[2 * st][j] - mx) * 1.4426950408889634f); e[4 + j] = __builtin_amdgcn_exp2f((S[2 * st + 1][j] - mx) * 1.4426950408889634f); }
#pragma unroll
        for (int j = 0; j < 8; ++j) l += e[j];
        const u32x4 pk = (u32x4){cvt_pk_bf16(e[0], e[1]), cvt_pk_bf16(e[2], e[3]), cvt_pk_bf16(e[4], e[5]), cvt_pk_bf16(e[6], e[7])};
        pf[st] = __builtin_bit_cast(bf16x8, pk); }
    l += __shfl_xor(l, 16); l += __shfl_xor(l, 32);
    f32x4 Oa[16];
#pragma unroll
    for (int i = 0; i < 16; ++i) Oa[i] = (f32x4){0.f, 0.f, 0.f, 0.f};
#pragma unroll
    for (int vt = 0; vt < 4; ++vt) {
        LAS unsigned char* buf = F.lds + (vt & 1) * ATT_BUF;
        if (vt < 3) att_load_tile(5 + vt, b, h, tid, Km, Vt, pre);
#pragma unroll
        for (int db = 0; db < 16; ++db)
#pragma unroll
            for (int s2 = 0; s2 < 2; ++s2) { const LAS unsigned char* ap = buf + (db * 16 + ql) * ATT_VROW + (32 * s2 + 4 * fq) * 2;
                const u32x2 a0 = *(const LAS u32x2*)ap, a1 = *(const LAS u32x2*)(ap + 32);
                const bf16x8 a = __builtin_bit_cast(bf16x8, (u32x4){a0.x, a0.y, a1.x, a1.y});
                Oa[db] = __builtin_amdgcn_mfma_f32_16x16x32_bf16(a, pf[vt * 2 + s2], Oa[db], 0, 0, 0); }
        if (vt < 3) { att_store_tile(5 + vt, tid, F.lds + ((vt + 1) & 1) * ATT_BUF, pre); __syncthreads(); }
    }
    const float inv = 1.0f / l; bf16* dst = O + tq * D + h * 256 + 4 * fq;
#pragma unroll
    for (int db = 0; db < 16; ++db) *(GAS u32x2*)(dst + 16 * db) = (u32x2){cvt_pk_bf16(Oa[db][0] * inv, Oa[db][1] * inv), cvt_pk_bf16(Oa[db][2] * inv, Oa[db][3] * inv)};
}

__device__ __forceinline__ void p7_router(Frame& F, const Args& A) {
    const int tid = opaque(F.tid), lane = tid & 63, w = F.wave, tl = lane & 15, fq = lane >> 4;
    const bf16* x2b = (const bf16*)(F.ws + WS_R2); const float* ssq2 = (const float*)(F.ws + WS_SSQ2);
    const float* brt = A.in[18]; int* lpid = (int*)(F.ws + WS_LPID); int* pinf = (int*)(F.ws + WS_PINF); float* pwt = (float*)(F.ws + WS_PWT); unsigned char* xq = F.ws + WS_XQ;
    LAS unsigned char* Wt = F.lds;
    LAS int* hist = (LAS int*)(F.lds + LDS_X_OFF); LAS int* basee = hist + 32; LAS int* pinfo = basee + 32; LAS float* pw = (LAS float*)(pinfo + 1024);
    { const unsigned char* src = F.ws + WS_WR; for (int i = tid; i < 131072 / 16; i += NTHREADS) ((LAS u32x4*)Wt)[i] = ((const GAS u32x4*)src)[i]; }
    if (tid < 32) hist[tid] = 0;
    __syncthreads();
    float bias[8];
#pragma unroll
    for (int j = 0; j < 8; ++j) bias[j] = brt[16 * (j >> 2) + 4 * fq + (j & 3)];
    for (int chunk = F.c; chunk < T / 256; chunk += F.G) {
        const int t0 = chunk * 256 + 32 * w + tl;
        const float r0 = row_rms_from_ssq(ssq2, t0), r1 = row_rms_from_ssq(ssq2, t0 + 16);
        f32x4 acc[4][2];
#pragma unroll
        for (int rb = 0; rb < 4; ++rb) { acc[rb][0] = (f32x4){0.f, 0.f, 0.f, 0.f}; acc[rb][1] = (f32x4){0.f, 0.f, 0.f, 0.f}; }
        const bf16* xr0 = x2b + (size_t)t0 * D + 8 * fq; const bf16* xr1 = xr0 + 16 * D;
        unsigned char* xo0 = xq + (size_t)t0 * D + 8 * fq; unsigned char* xo1 = xo0 + 16 * D;
        u32x4 b0 = *(const GAS u32x4*)xr0, b1 = *(const GAS u32x4*)xr1;
#pragma unroll 2
        for (int ks = 0; ks < 32; ++ks) {
            const u32x4 c0 = b0, c1 = b1;
            if (ks < 31) { b0 = *(const GAS u32x4*)(xr0 + 32 * (ks + 1)); b1 = *(const GAS u32x4*)(xr1 + 32 * (ks + 1)); }
            *(GAS u32x2*)(xo0 + 32 * ks) = (u32x2){pk4_fp8(bflo(c0.x) * r0, bfhi(c0.x) * r0, bflo(c0.y) * r0, bfhi(c0.y) * r0), pk4_fp8(bflo(c0.z) * r0, bfhi(c0.z) * r0, bflo(c0.w) * r0, bfhi(c0.w) * r0)};
            *(GAS u32x2*)(xo1 + 32 * ks) = (u32x2){pk4_fp8(bflo(c1.x) * r1, bfhi(c1.x) * r1, bflo(c1.y) * r1, bfhi(c1.y) * r1), pk4_fp8(bflo(c1.z) * r1, bfhi(c1.z) * r1, bflo(c1.w) * r1, bfhi(c1.w) * r1)};
            const bf16x8 f0 = __builtin_bit_cast(bf16x8, c0), f1 = __builtin_bit_cast(bf16x8, c1);
#pragma unroll
            for (int rb = 0; rb < 4; ++rb) { const int rho = 16 * rb + tl; const bf16x8 a = *(const LAS bf16x8*)(Wt + rho * 2048 + (((4 * ks + fq) ^ tl) << 4));
                acc[rb][0] = __builtin_amdgcn_mfma_f32_16x16x32_bf16(a, f0, acc[rb][0], 0, 0, 0); acc[rb][1] = __builtin_amdgcn_mfma_f32_16x16x32_bf16(a, f1, acc[rb][1], 0, 0, 0); }
        }
#pragma unroll
        for (int tb = 0; tb < 2; ++tb) {
            const float r = tb ? r1 : r0; float v[8];
#pragma unroll
            for (int j = 0; j < 8; ++j) v[j] = (acc[j >> 2][tb][j & 3] + acc[2 + (j >> 2)][tb][j & 3]) * r + bias[j];
            int idx[4]; float val[4];
#pragma unroll
            for (int k = 0; k < 4; ++k) {
                float best = v[0]; int bi = 4 * fq;
#pragma unroll
                for (int j = 1; j < 8; ++j) { const int e = 16 * (j >> 2) + 4 * fq + (j & 3); const bool gt = v[j] > best; best = gt ? v[j] : best; bi = gt ? e : bi; }
#pragma unroll
                for (int o = 16; o <= 32; o <<= 1) { const float ob = __shfl_xor(best, o); const int oi = __shfl_xor(bi, o); const bool take = (ob > best) || (ob == best && oi < bi); best = take ? ob : best; bi = take ? oi : bi; }
#pragma unroll
                for (int j = 0; j < 8; ++j) { const int e = 16 * (j >> 2) + 4 * fq + (j & 3); v[j] = (e == bi) ? -3.0e38f : v[j]; }
                idx[k] = bi; val[k] = best; }
            float ex[4], sum = 0.f;
#pragma unroll
            for (int k = 0; k < 4; ++k) { ex[k] = expf(val[k] - val[0]); sum += ex[k]; }
            const float inv = 1.0f / sum;
            if (fq == 0) { const int tloc = 32 * w + 16 * tb + tl;
#pragma unroll
                for (int k = 0; k < 4; ++k) { const int rank = __hip_atomic_fetch_add(hist + idx[k], 1, __ATOMIC_RELAXED, __HIP_MEMORY_SCOPE_WORKGROUP); pinfo[tloc * 4 + k] = idx[k] | (rank << 5); pw[tloc * 4 + k] = ex[k] * inv; } }
        }
        __syncthreads();
        if (tid < 32) { basee[tid] = (int)__hip_atomic_fetch_add((unsigned*)(F.ctl + CW_CNT + tid), (unsigned)hist[tid], RLX_AGENT); hist[tid] = 0; }
        __syncthreads();
#pragma unroll
        for (int j = 0; j < 2; ++j) { const int i = tid + 512 * j, info = pinfo[i], e = info & 31, pos = basee[e] + (info >> 5); lpid[(size_t)e * LISTCAP + pos] = chunk * 1024 + i; pinf[chunk * 1024 + i] = e | (pos << 5); pwt[chunk * 1024 + i] = pw[i]; }
        __syncthreads();
    }
}
__device__ __forceinline__ int moe_tables(Frame& F, LAS int*& tpre, LAS int*& cnts) {
    tpre = (LAS int*)(F.lds + LDS_X_OFF); cnts = tpre + 40;
    __syncthreads();
    if (F.tid < 32) cnts[F.tid] = (int)__hip_atomic_load((unsigned*)(F.ctl + CW_CNT + F.tid), RLX_AGENT);
    __syncthreads();
    if (F.tid == 0) { int s = 0; for (int e = 0; e < 32; ++e) { tpre[e] = s; s += (cnts[e] + 255) >> 8; } tpre[32] = s; }
    __syncthreads();
    { LAS unsigned char* t2e = (LAS unsigned char*)tpre + 11264;
      for (int i = F.tid; i < MAXTILES; i += NTHREADS) { int e = 0; for (int j = 1; j < NE; ++j) e += (tpre[j] <= i) ? 1 : 0; t2e[i] = (unsigned char)e; } }
    __syncthreads();
    return __builtin_amdgcn_readfirstlane(tpre[32]);
}
__device__ __forceinline__ void p10_final(Frame& F, const Args& A) {
    LAS int *tpre, *cnts; (void)moe_tables(F, tpre, cnts);
    const int gw = F.c * NWAVES + F.wave, NGW = F.G * NWAVES, lane = opaque(F.tid) & 63;
    const bf16* x2b = (const bf16*)(F.ws + WS_R2); const unsigned char* Y = F.ws + WS_Y; const float* gf = A.in[25]; float* out = A.out;
    const int* pinf = (const int*)(F.ws + WS_PINF); const float* pwt = (const float*)(F.ws + WS_PWT);
    f32x4 g[4];
#pragma unroll
    for (int hh = 0; hh < 2; ++hh) { g[2 * hh] = *(const f32x4*)(gf + 512 * hh + 8 * lane); g[2 * hh + 1] = *(const f32x4*)(gf + 512 * hh + 8 * lane + 4); }
#pragma unroll 1
    for (int rep10 = 0; rep10 < P10_REP; ++rep10)
    for (int t = gw; t < T; t += NGW) {
        float v[16];
        const int4 pi = *(const int4*)(pinf + 4 * t); const f32x4 pw4 = *(const f32x4*)(pwt + 4 * t);
        const int pinfo4[4] = {pi.x, pi.y, pi.z, pi.w};
#pragma unroll
        for (int hh = 0; hh < 2; ++hh) { const u32x4 w = *(const GAS u32x4*)(x2b + (size_t)t * D + 512 * hh + 8 * lane); const unsigned ww[4] = {w.x, w.y, w.z, w.w};
#pragma unroll
            for (int e = 0; e < 4; ++e) { v[8 * hh + 2 * e] = bflo(ww[e]); v[8 * hh + 2 * e + 1] = bfhi(ww[e]); } }
#pragma unroll
        for (int k = 0; k < 4; ++k) { const int e = pinfo4[k] & 31, pos = pinfo4[k] >> 5; const size_t row = (size_t)tpre[e] * 256 + pos; const float wk = pw4[k];
#pragma unroll
            for (int hh = 0; hh < 2; ++hh) { const u32x2 w = *(const GAS u32x2*)(Y + row * D + 512 * hh + 8 * lane);
                const f32x2 a0 = __builtin_amdgcn_cvt_pk_f32_fp8((int)w.x, false), a1 = __builtin_amdgcn_cvt_pk_f32_fp8((int)w.x, true), a2 = __builtin_amdgcn_cvt_pk_f32_fp8((int)w.y, false), a3 = __builtin_amdgcn_cvt_pk_f32_fp8((int)w.y, true);
                v[8 * hh] += wk * a0[0]; v[8 * hh + 1] += wk * a0[1]; v[8 * hh + 2] += wk * a1[0]; v[8 * hh + 3] += wk * a1[1]; v[8 * hh + 4] += wk * a2[0]; v[8 * hh + 5] += wk * a2[1]; v[8 * hh + 6] += wk * a3[0]; v[8 * hh + 7] += wk * a3[1]; } }
        float s = 0.f;
#pragma unroll
        for (int j = 0; j < 16; ++j) s += v[j] * v[j];
        const float r = rsqrtf(wave_sum(s) * (1.0f / D) + EPS);
#pragma unroll
        for (int hh = 0; hh < 2; ++hh) { float* o = out + (size_t)t * D + 512 * hh + 8 * lane;
            *(GAS f32x4*)o = (f32x4){v[8 * hh] * r * g[2 * hh][0], v[8 * hh + 1] * r * g[2 * hh][1], v[8 * hh + 2] * r * g[2 * hh][2], v[8 * hh + 3] * r * g[2 * hh][3]};
            *(GAS f32x4*)(o + 4) = (f32x4){v[8 * hh + 4] * r * g[2 * hh + 1][0], v[8 * hh + 5] * r * g[2 * hh + 1][1], v[8 * hh + 6] * r * g[2 * hh + 1][2], v[8 * hh + 7] * r * g[2 * hh + 1][3]}; }
    }
}

constexpr int NPHASES = 11;
__global__ void __launch_bounds__(NTHREADS, 2) fwd_kernel(Args args) {
    extern __shared__ __attribute__((aligned(16))) unsigned char lds_raw[];
    Frame F;
    F.lds = (LAS unsigned char*)lds_raw;
    F.MISC = (volatile LAS unsigned*)(F.lds + MISC_OFF);
    F.tid = threadIdx.x; F.lane = F.tid & 63; F.wave = __builtin_amdgcn_readfirstlane(F.tid >> 6);
    F.G = gridDim.x; F.c = blockIdx.x; F.ws = args.ws; F.ctl = (gu32*)(args.ws + WS_CTL);
    for (int u = F.tid; u < 1024 / 4; u += NTHREADS) ((LAS unsigned*)(F.lds + LDSCTL_OFF))[u] = 0u;
    __syncthreads();
    const int lo = args.ph_lo, hi = args.ph_hi;
    XcdBarrier bar; bar.bar = (unsigned*)(F.ctl + CW_BAR); bar.x = 0; bar.st = nullptr;
    if (hi - lo > 1) bar = xcd_barrier_post((unsigned*)(F.ctl + CW_BAR), F.MISC + 8);
#ifndef PH_MASK
#define PH_MASK 0x7ff
#endif
#define IN(k) (((PH_MASK >> (k)) & 1) && lo <= (k) && (k) < hi)
#define SEAM(k) do { if (IN(k) && IN((k) == 4 ? 6 : (k) + 1)) xcd_barrier(bar); } while (0)
#ifndef REPEAT_MASK
#define REPEAT_MASK 0
#endif
#define REPS(k) ((((REPEAT_MASK) >> (k)) & 1) ? 2 : 1)
#define REP_BEGIN(k) for (int rep_ = 0; rep_ < REPS(k); ++rep_) {
#define REP_END(k) if (rep_ + 1 < REPS(k)) xcd_barrier(bar); }
    unsigned char* ws = args.ws;
    if (IN(0)) { REP_BEGIN(0) p0_prologue(F, args); REP_END(0) SEAM(0); }
    if (IN(1)) { REP_BEGIN(1)
        Twice<P1Order, (KTWICE_MASK >> 1) & 1> S{{F.G, F.c, (const char*)ws}};
        EpiP1 E{ws, F.lds + LDS_G_OFF + 8192};
        pg8::gemm_phase<EpiP1, Twice<P1Order, (KTWICE_MASK >> 1) & 1>, false, false, true, 1>(F.lds + RING_OFF, F.lds + LDS_G_OFF, D, D, 8, S, E, 0);
        REP_END(1)
        SEAM(1);
    }
    if (IN(2)) { REP_BEGIN(2)
        unsigned p2acc = 0, p2t0 = 0;
#define P2B(sel) do { if (PROF_PH == 2 && PROF_SEL == (sel)) p2t0 = (unsigned)__builtin_amdgcn_s_memrealtime(); } while (0)
#define P2E(sel) do { if (PROF_PH == 2 && PROF_SEL == (sel)) p2acc += (unsigned)__builtin_amdgcn_s_memrealtime() - p2t0; } while (0)
        if (F.G == 256) {
            if (F.c < 128) { P2B(1); p2_mlstm_chain(F, args, F.c); if (P2_PROBE == 1) p2_mlstm_chain(F, args, F.c); P2E(1); }
            else { P2B(2); const int g = F.c & 3, wi = (F.c - 128) >> 2; p2_gmlp_setup(F, args, g);
                   u32x4 zreg[4]; f32x4 gvr[8], gor[8]; float gbias;
                   { const int tid = F.tid, p = tid & 3, lane = tid & 63, fq = lane >> 4, tl = lane & 15; const float* gv = args.in[8] + g * 128; const float* go = args.in[9] + g * 128;
#pragma unroll
                     for (int j8 = 0; j8 < 4; ++j8) { gvr[2 * j8] = *(const f32x4*)(gv + 8 * (4 * p + j8)); gvr[2 * j8 + 1] = *(const f32x4*)(gv + 8 * (4 * p + j8) + 4); }
#pragma unroll
                     for (int db = 0; db < 8; ++db) gor[db] = *(const f32x4*)(go + 16 * db + 4 * fq);
                     gbias = args.in[7][g * 128 + 16 * F.wave + tl]; }
                   u32x2 ugn[8];
                   { const int tid = F.tid, lane = tid & 63, fq = lane >> 4, tl = lane & 15; const size_t t0 = (size_t)(wi >> 4) * SEQ + (wi & 15) * 128 + 16 * F.wave + tl;
#pragma unroll
                     for (int db = 0; db < 8; ++db) ugn[db] = *(const GAS u32x2*)((const bf16*)(ws + WS_PROJ) + t0 * NP + 1536 + g * 128 + 16 * db + 4 * fq); }
                   { const int tid = F.tid, s = tid >> 2, p = tid & 3; const size_t t0 = (size_t)(wi >> 4) * SEQ + (wi & 15) * 128;
#pragma unroll
                     for (int j8 = 0; j8 < 4; ++j8) zreg[j8] = *(const GAS u32x4*)((const bf16*)(ws + WS_PROJ) + (t0 + s) * NP + 2048 + g * 128 + 32 * p + j8 * 8); }
#pragma unroll 1
                   for (int rp = 0; rp < (P2_PROBE == 2 ? 2 : 1); ++rp)
#pragma unroll 1
                   for (int pi = wi; pi < BATCH * 16; pi += 32) { int pn = pi + 32; if (P2_PROBE == 2 && rp == 0 && pn >= BATCH * 16) pn = wi; p2_gmlp_unit(F, args, pi >> 4, pi & 15, g, zreg, ugn, pn < BATCH * 16, pn >> 4, pn & 15, gvr, gor, gbias); } P2E(2); }
        } else {
            for (int ch = F.c; ch < BATCH * 4; ch += F.G) p2_mlstm_chain_simple(F, args, ch);
            for (int u = (F.c + F.G - (128 % F.G)) % F.G; u < BATCH * 16 * 4; u += F.G) p2_gmlp_unit_simple(F, args, u);
        }
        P2B(3);
        const bool split = (F.G == 256), chainwg = split && F.c < 128; const int jw = F.c & 127;
        { PreOrder<0> S{split ? jw : F.c, split ? 128 : F.G, split ? (chainwg ? 0 : 4) : 512, (const char*)ws}; EpiPre<0> E{(unsigned char*)args.out};
          pg8::gemm_phase<EpiPre<0>, PreOrder<0>>(F.lds + RING_OFF, F.lds + LDS_G_OFF, 4096, 2048, 4, S, E, 0); }
        { PreOrder<1> S{split ? (chainwg ? 384 + jw : jw) : F.c, split ? 128 : F.G, split ? (chainwg ? 1 : 3) : 512, (const char*)ws}; EpiPre<1> E{(unsigned char*)args.out + (size_t)BATCH * 1024 * 1024};
          pg8::gemm_phase<EpiPre<1>, PreOrder<1>>(F.lds + RING_OFF, F.lds + LDS_G_OFF, 2048, 4096, 4, S, E, 0); }
        P2E(3);
        if (PROF_PH == 2) { const unsigned t0 = (unsigned)__builtin_amdgcn_s_memrealtime(); while ((unsigned)__builtin_amdgcn_s_memrealtime() - t0 < p2acc * PROF_MULT) __builtin_amdgcn_s_sleep(8); }
#undef P2B
#undef P2E
        REP_END(2)
        SEAM(2);
    }
    if (IN(3)) { REP_BEGIN(3)
        PlainOrder S{F.G, F.c, T / 256, 4, (const char*)(ws + WS_R2), (const char*)(ws + WS_WOUT), 0, (unsigned)TS1K, 1};
        EpiResid<true> E{(const void*)args.in[0], (bf16*)(ws + WS_R1), (float*)(ws + WS_SSQ1), ws + WS_X1Q};
        pg8::gemm_phase<EpiResid<true>, PlainOrder, false, false, false, 3>(F.lds + RING_OFF, F.lds + LDS_G_OFF, D * 2, D * 2, 16, S, E, 0);
        REP_END(3)
        SEAM(3);
    }
    if (IN(4)) { REP_BEGIN(4)
        PlainOrder S{F.G, F.c, T / 256, 4, (const char*)(ws + WS_X1Q), (const char*)args.out, 1, (unsigned)TSF8, 0};
        EpiSoftmax E{ws + WS_R3, (const float*)(ws + WS_SSQ1), (LAS float*)(F.lds + LDS_G_OFF)};
        pg8::gemm_phase<EpiSoftmax, PlainOrder, true, false, false, 4>(F.lds + RING_OFF, F.lds + LDS_G_OFF, D, D, 8, S, E, 0);
        REP_END(4)
        SEAM(4);
    }
    if (IN(6)) { REP_BEGIN(6)
        PlainOrder S{F.G, F.c, T / 256, 4, (const char*)(ws + WS_R3), (const char*)((const unsigned char*)args.out + (size_t)BATCH * 1024 * 1024), 1, (unsigned)TSF8, 1};
        EpiResid<false> E{(const void*)(ws + WS_R1), (bf16*)(ws + WS_R2), (float*)(ws + WS_SSQ2), nullptr};
        pg8::gemm_phase<EpiResid<false>, PlainOrder, true, false, false, 6>(F.lds + RING_OFF, F.lds + LDS_G_OFF, D, D, 8, S, E, 0);
        REP_END(6)
        SEAM(6);
    }
    if (IN(7)) { p7_router(F, args); SEAM(7); }
    if (IN(8)) { REP_BEGIN(8)
        LAS int *tpre, *cnts; const int NT = moe_tables(F, tpre, cnts);
        Twice<MoeOrder<true, 8>, (KTWICE_MASK >> 8) & 1> S{{F.G, F.c, NT, tpre, (const char*)ws}};
        EpiG1 E{ws, args.in[20], args.in[22]};
        pg8::gemm_phase<EpiG1, Twice<MoeOrder<true, 8>, (KTWICE_MASK >> 8) & 1>, true, false, false, 8>(F.lds + RING_OFF, F.lds + LDS_G_OFF, D, D, 8, S, E, 0);
        REP_END(8)
        SEAM(8);
    }
    if (IN(9)) { REP_BEGIN(9)
        LAS int *tpre, *cnts; const int NT = moe_tables(F, tpre, cnts);
        MoeOrder<false, 4> S{F.G, F.c, NT, tpre, (const char*)ws};
        EpiG2 E{ws, args.in[24], F.lds + LDS_G_OFF + 8192};
        pg8::gemm_phase<EpiG2, MoeOrder<false, 4>, true, false, false, 9>(F.lds + RING_OFF, F.lds + LDS_G_OFF, FF, FF, 8, S, E, 0);
        REP_END(9)
        SEAM(9);
    }
    if (IN(10)) { REP_BEGIN(10) p10_final(F, args); REP_END(10) }
#undef IN
#undef SEAM
}

extern "C" void kernel_launch(void* const* d_in, const int* in_sizes, int n_in, void* d_out, int out_size, void* d_ws, size_t ws_size, hipStream_t stream) {
    static int grid = 0;
    if (grid == 0) {
        if (n_in != 26 || in_sizes[0] != T * D || out_size != T * D || ws_size < WS_END) { fprintf(stderr, "kernel_launch: unexpected shapes (n_in %d, in0 %d, out %d, ws %zu)\n", n_in, n_in > 0 ? in_sizes[0] : -1, out_size, ws_size); grid = -1; return; }
        int dev = 0, cus = 0, per_cu = 0;
        if (hipGetDevice(&dev) != hipSuccess || hipDeviceGetAttribute(&cus, hipDeviceAttributeMultiprocessorCount, dev) != hipSuccess) { grid = -1; return; }
        if (hipFuncSetAttribute((const void*)fwd_kernel, hipFuncAttributeMaxDynamicSharedMemorySize, LDS_BYTES) != hipSuccess) { fprintf(stderr, "kernel_launch: hipFuncSetAttribute failed\n"); grid = -1; return; }
        if (hipOccupancyMaxActiveBlocksPerMultiprocessor(&per_cu, (const void*)fwd_kernel, NTHREADS, LDS_BYTES) != hipSuccess || per_cu < 1) { fprintf(stderr, "kernel_launch: occupancy query says %d\n", per_cu); }
        (void)hipGetLastError();
        grid = cus;
    }
    if (grid < 0) return;
    (void)hipMemsetAsync((char*)d_ws + WS_CTL, 0, CTL_ZERO_BYTES, stream);
    Args a{};
    for (int i = 0; i < 26; ++i) a.in[i] = (const float*)d_in[i];
    a.out = (float*)d_out; a.ws = (unsigned char*)d_ws;
#if MK_PER_PHASE
    for (int ph = 0; ph < NPHASES; ++ph) { a.ph_lo = ph; a.ph_hi = ph + 1; hipLaunchKernelGGL(fwd_kernel, dim3(grid), dim3(NTHREADS), LDS_BYTES, stream, a); }
#else
    a.ph_lo = 0; a.ph_hi = NPHASES; hipLaunchKernelGGL(fwd_kernel, dim3(grid), dim3(NTHREADS), LDS_BYTES, stream, a);
#endif
}
```
